# Optimizing an MI355X kernel written in HIP

```python
import math
import jax
import jax.numpy as jnp
from jax import lax
import numpy as np

D_MODEL = 1024
BATCH = 8
SEQ = 2048
DEPTH = 4

CHUNK = 64
N_META = 16
RMS_EPS = 1e-6
F32 = jnp.float32

N_AB_LAYERS = (DEPTH + 1) // 2
N_C_LAYERS = DEPTH // 2

S5_WIDTH = D_MODEL // 2
S5_GROUP = 16
S5_GROUPS = S5_WIDTH // S5_GROUP
S5_STATE = 64
S5_DT_MIN = 1e-3
S5_DT_MAX = 1e-1

LRU_WIDTH = D_MODEL // 2
LRU_HEADS = 8
LRU_HEAD_DIM = LRU_WIDTH // LRU_HEADS
LRU_CONV = 4
LRU_C = 8.0

AB_IN = S5_WIDTH + 2 * LRU_WIDTH
AB_MIX = S5_WIDTH + LRU_WIDTH

RWKV_HEAD = 64
RWKV_HEADS = D_MODEL // RWKV_HEAD
DECAY_LORA = 64
AAA_LORA = 64
MV_LORA = 32
GATE_LORA = 128
LNX_EPS = 64e-5

N_GROUPS = 4
EXPERTS_PER_GROUP = 4
N_EXPERTS = N_GROUPS * EXPERTS_PER_GROUP
TOP_K_IN_GROUP = 2
D_EXPERT = 512

kernel_name = 'hybrid_s5_rglru_rwkv7_hmoe_encoder'


def _rmsnorm(x, g):
    xf = x.astype(F32)
    return xf * lax.rsqrt(jnp.mean(xf * xf, axis=-1, keepdims=True) + RMS_EPS) * g.astype(F32)


def _linear_combine(left, right):
    a1, b1 = left
    a2, b2 = right
    return (a2 * a1, a2 * b1 + b2)


def _complex_linear_combine(left, right):
    a1r, a1i, b1r, b1i = left
    a2r, a2i, b2r, b2i = right
    return (a2r * a1r - a2i * a1i, a2r * a1i + a2i * a1r,
            a2r * b1r - a2i * b1i + b2r, a2r * b1i + a2i * b1r + b2i)


def _s5_mixer(u, lam_re, lam_im, log_dt, b_re, b_im, c_re, c_im, d_skip, w_glu, b_glu):
    bsz, L, _ = u.shape
    ug = u.reshape(bsz, L, S5_GROUPS, S5_GROUP)
    lr = lam_re.astype(F32)
    li = lam_im.astype(F32)
    dt = jnp.exp(log_dt.astype(F32))[:, None]
    mag = jnp.exp(lr * dt)
    abar_r = mag * jnp.cos(li * dt)
    abar_i = mag * jnp.sin(li * dt)
    den = lr * lr + li * li
    zr = ((abar_r - 1.0) * lr + abar_i * li) / den
    zi = (abar_i * lr - (abar_r - 1.0) * li) / den
    bbar_r = zr[..., None] * b_re - zi[..., None] * b_im
    bbar_i = zr[..., None] * b_im + zi[..., None] * b_re
    bu_r = jnp.einsum('blgh,gph->blgp', ug, bbar_r)
    bu_i = jnp.einsum('blgh,gph->blgp', ug, bbar_i)
    a_r = jnp.broadcast_to(abar_r, (1, L, S5_GROUPS, S5_STATE))
    a_i = jnp.broadcast_to(abar_i, (1, L, S5_GROUPS, S5_STATE))
    _, _, x_r, x_i = lax.associative_scan(_complex_linear_combine, (a_r, a_i, bu_r, bu_i), axis=1)
    y = (jnp.einsum('blgp,ghp->blgh', x_r, c_re) - jnp.einsum('blgp,ghp->blgh', x_i, c_im)
         + d_skip * ug)
    y = jax.nn.gelu(y.reshape(bsz, L, S5_WIDTH))
    return y * jax.nn.sigmoid(y @ w_glu + b_glu)


def _rglru_mixer(gate_in, rec_in, conv_w, conv_b, w_a, b_a, w_x, b_x, lam):
    bsz, L, _ = rec_in.shape
    xc = lax.conv_general_dilated(rec_in.astype(F32), conv_w.astype(F32)[:, None, :],
                                  window_strides=(1,), padding=[(LRU_CONV - 1, 0)],
                                  dimension_numbers=('NWC', 'WIO', 'NWC'),
                                  feature_group_count=LRU_WIDTH) + conv_b
    xh = xc.reshape(bsz, L, LRU_HEADS, LRU_HEAD_DIM)
    r = jax.nn.sigmoid(jnp.einsum('blhi,hij->blhj', xh, w_a) + b_a).reshape(bsz, L, LRU_WIDTH)
    i = jax.nn.sigmoid(jnp.einsum('blhi,hij->blhj', xh, w_x) + b_x).reshape(bsz, L, LRU_WIDTH)
    log_a = -LRU_C * r * jax.nn.softplus(-lam.astype(F32))
    a = jnp.exp(log_a)
    b = jnp.sqrt(-jnp.expm1(2.0 * log_a)) * (i * xc)
    _, h = lax.associative_scan(_linear_combine, (a, b), axis=1)
    return jax.nn.gelu(gate_in) * h


def _s5_rglru_layer(hn, w_in, w_out, norm_a, norm_b,
                    lam_re, lam_im, log_dt, b_re, b_im, c_re, c_im, d_skip, w_glu, b_glu,
                    conv_w, conv_b, w_a, b_a, w_x, b_x, lam):
    z = hn @ w_in
    u = z[..., :S5_WIDTH]
    gate = z[..., S5_WIDTH:S5_WIDTH + LRU_WIDTH]
    rec = z[..., S5_WIDTH + LRU_WIDTH:]
    ya = _rmsnorm(_s5_mixer(u, lam_re, lam_im, log_dt, b_re, b_im, c_re, c_im, d_skip,
                            w_glu, b_glu), norm_a)
    yb = _rmsnorm(_rglru_mixer(gate, rec, conv_w, conv_b, w_a, b_a, w_x, b_x, lam), norm_b)
    return jnp.concatenate([ya, yb], axis=-1) @ w_out


def _rwkv7_mixer(x, v_first, v_res, mu, w_r, w_k, w_v, w_o, w0, w_l1, w_l2,
                 a0, a_l1, a_l2, g_l1, g_l2, k_k, k_a, r_k, lnx_w, lnx_b):
    bsz, L, D = x.shape
    xx = jnp.pad(x, ((0, 0), (1, 0), (0, 0)))[:, :-1] - x
    xr, xw, xk, xv, xa, xg = [x + xx * mu[j] for j in range(6)]
    r = xr @ w_r
    k = xk @ w_k
    v = xv @ w_v
    w_log = -jax.nn.softplus(-(w0 + jnp.tanh(xw @ w_l1) @ w_l2)) - 0.5
    if v_first is None:
        v_first = v
    else:
        v0, v_l1, v_l2 = v_res
        v = v + (v_first - v) * jax.nn.sigmoid(v0 + (xv @ v_l1) @ v_l2)
    a = jax.nn.sigmoid(a0 + (xa @ a_l1) @ a_l2)
    g = jax.nn.sigmoid(xg @ g_l1) @ g_l2

    def heads(t):
        return t.reshape(bsz, L, RWKV_HEADS, RWKV_HEAD)

    kk = heads(k * k_k)
    kk = kk / jnp.maximum(jnp.sqrt(jnp.sum(kk * kk, axis=-1, keepdims=True)), 1e-12)
    k = k * (1.0 + (a - 1.0) * k_a)
    rh, kh, vh, ah = heads(r), heads(k), heads(v), heads(a)
    decay = jnp.exp(-jnp.exp(heads(w_log)))

    def tm(t):
        return jnp.swapaxes(t, 0, 1)

    def step(S, inp):
        r_t, w_t, k_t, v_t, a_t, b_t = inp
        sa = jnp.einsum('bhij,bhj->bhi', S, a_t)
        S = (S * w_t[:, :, None, :] + sa[..., None] * b_t[:, :, None, :]
             + v_t[..., None] * k_t[:, :, None, :])
        return S, jnp.einsum('bhij,bhj->bhi', S, r_t)

    S0 = jnp.zeros((bsz, RWKV_HEADS, RWKV_HEAD, RWKV_HEAD), F32)
    _, y = lax.scan(step, S0, (tm(rh), tm(decay), tm(kh), tm(vh), tm(-kk), tm(kk * ah)))
    y = tm(y)
    mean = jnp.mean(y, axis=-1, keepdims=True)
    var = jnp.mean(jnp.square(y - mean), axis=-1, keepdims=True)
    y = ((y - mean) * lax.rsqrt(var + LNX_EPS)).reshape(bsz, L, D) * lnx_w + lnx_b
    bonus = (jnp.sum(rh * kh * r_k, axis=-1, keepdims=True) * vh).reshape(bsz, L, D)
    return ((y + bonus) * g) @ w_o, v_first


def _hier_moe(x, wr_g, br_g, wr_e, br_e, w_gate, w_up, w_down):
    bsz, L, D = x.shape
    t = x.reshape(-1, D)
    lg = (t @ wr_g + br_g).astype(F32)
    pg = jax.nn.softmax(lg, axis=-1)
    g_idx = jnp.argmax(lg, axis=-1)
    pg_sel = jnp.max(pg, axis=-1, keepdims=True)
    le = (t @ wr_e + br_e).astype(F32).reshape(-1, N_GROUPS, EXPERTS_PER_GROUP)
    le = jnp.einsum('tge,tg->te', le, jax.nn.one_hot(g_idx, N_GROUPS, dtype=F32))
    top_v, top_i = lax.top_k(le, TOP_K_IN_GROUP)
    gate = jax.nn.softmax(top_v, axis=-1) * pg_sel
    eid = g_idx[:, None] * EXPERTS_PER_GROUP + top_i
    cw = jnp.sum(jax.nn.one_hot(eid, N_EXPERTS, dtype=F32) * gate[..., None], axis=1)
    out = jnp.zeros_like(t)
    for grp in range(N_GROUPS):
        sl = slice(grp * EXPERTS_PER_GROUP, (grp + 1) * EXPERTS_PER_GROUP)
        hid = (jax.nn.silu(jnp.einsum('td,edf->tef', t, w_gate[sl]))
               * jnp.einsum('td,edf->tef', t, w_up[sl]))
        out = out + jnp.einsum('tef,efd->td', hid * cw[:, sl, None], w_down[sl])
    return out.reshape(bsz, L, D)


def setup_inputs(seed: int = 0) -> dict:
    key = jax.random.key(seed)
    ks = iter(jax.random.split(key, 64))
    D = D_MODEL
    nab, nc = N_AB_LAYERS, N_C_LAYERS

    def nrm(shape, scale):
        return scale * jax.random.normal(next(ks), shape, F32)

    def unif(shape, lo, hi):
        return jax.random.uniform(next(ks), shape, F32, lo, hi)

    lam_im0 = math.pi * jnp.arange(S5_STATE, dtype=F32)
    ramp = jnp.linspace(0.0, 1.0, D, dtype=F32) ** 0.85
    inp = {}
    inp['x'] = nrm((BATCH, SEQ, D), 1.0)
    inp['meta_tokens'] = nrm((N_META, D), 1.0)
    inp['norm_mix'] = 1.0 + nrm((DEPTH, D), 0.02)
    inp['norm_ffn'] = 1.0 + nrm((DEPTH, D), 0.02)
    inp['norm_final'] = 1.0 + nrm((D,), 0.02)
    inp['ab_w_in'] = nrm((nab, D, AB_IN), D ** -0.5)
    inp['ab_w_out'] = nrm((nab, AB_MIX, D), AB_MIX ** -0.5)
    inp['ab_norm_a'] = 1.0 + nrm((nab, S5_WIDTH), 0.02)
    inp['ab_norm_b'] = 1.0 + nrm((nab, LRU_WIDTH), 0.02)
    inp['s5_lam_re'] = -0.5 + nrm((nab, S5_GROUPS, S5_STATE), 0.01)
    inp['s5_lam_im'] = lam_im0 + nrm((nab, S5_GROUPS, S5_STATE), 0.01)
    inp['s5_log_dt'] = unif((nab, S5_GROUPS), math.log(S5_DT_MIN), math.log(S5_DT_MAX))
    inp['s5_b_re'] = nrm((nab, S5_GROUPS, S5_STATE, S5_GROUP), (2 * S5_GROUP) ** -0.5)
    inp['s5_b_im'] = nrm((nab, S5_GROUPS, S5_STATE, S5_GROUP), (2 * S5_GROUP) ** -0.5)
    inp['s5_c_re'] = nrm((nab, S5_GROUPS, S5_GROUP, S5_STATE), S5_STATE ** -0.5)
    inp['s5_c_im'] = nrm((nab, S5_GROUPS, S5_GROUP, S5_STATE), S5_STATE ** -0.5)
    inp['s5_d'] = nrm((nab, S5_GROUPS, S5_GROUP), 1.0)
    inp['s5_w_glu'] = nrm((nab, S5_WIDTH, S5_WIDTH), S5_WIDTH ** -0.5)
    inp['s5_b_glu'] = nrm((nab, S5_WIDTH), 0.01)
    inp['lru_conv_w'] = nrm((nab, LRU_CONV, LRU_WIDTH), LRU_CONV ** -0.5)
    inp['lru_conv_b'] = nrm((nab, LRU_WIDTH), 0.01)
    inp['lru_w_a'] = nrm((nab, LRU_HEADS, LRU_HEAD_DIM, LRU_HEAD_DIM), LRU_HEAD_DIM ** -0.5)
    inp['lru_b_a'] = nrm((nab, LRU_HEADS, LRU_HEAD_DIM), 0.01)
    inp['lru_w_x'] = nrm((nab, LRU_HEADS, LRU_HEAD_DIM, LRU_HEAD_DIM), LRU_HEAD_DIM ** -0.5)
    inp['lru_b_x'] = nrm((nab, LRU_HEADS, LRU_HEAD_DIM), 0.01)
    s = unif((nab, LRU_WIDTH), 0.9, 0.999) ** (1.0 / LRU_C)
    inp['lru_lam'] = jnp.log(s) - jnp.log1p(-s)
    inp['rw_mu'] = unif((nc, 6, D), 0.0, 1.0)
    inp['rw_w_r'] = nrm((nc, D, D), D ** -0.5)
    inp['rw_w_k'] = nrm((nc, D, D), D ** -0.5)
    inp['rw_w_v'] = nrm((nc, D, D), D ** -0.5)
    inp['rw_w_o'] = nrm((nc, D, D), D ** -0.5)
    inp['rw_w0'] = -6.0 + 5.0 * ramp + 0.5 + nrm((nc, D), 0.01)
    inp['rw_w_l1'] = nrm((nc, D, DECAY_LORA), D ** -0.5)
    inp['rw_w_l2'] = nrm((nc, DECAY_LORA, D), 0.5 * DECAY_LORA ** -0.5)
    inp['rw_a0'] = nrm((nc, D), 0.01)
    inp['rw_a_l1'] = nrm((nc, D, AAA_LORA), D ** -0.5)
    inp['rw_a_l2'] = nrm((nc, AAA_LORA, D), 0.5 * AAA_LORA ** -0.5)
    inp['rw_v0'] = 1.0 + nrm((max(nc - 1, 0), D), 0.01)
    inp['rw_v_l1'] = nrm((max(nc - 1, 0), D, MV_LORA), D ** -0.5)
    inp['rw_v_l2'] = nrm((max(nc - 1, 0), MV_LORA, D), 0.5 * MV_LORA ** -0.5)
    inp['rw_g_l1'] = nrm((nc, D, GATE_LORA), D ** -0.5)
    inp['rw_g_l2'] = nrm((nc, GATE_LORA, D), GATE_LORA ** -0.5)
    inp['rw_k_k'] = 0.85 + nrm((nc, D), 0.01)
    inp['rw_k_a'] = 1.0 + nrm((nc, D), 0.01)
    inp['rw_r_k'] = nrm((nc, RWKV_HEADS, RWKV_HEAD), 0.1)
    inp['rw_lnx_w'] = 1.0 + nrm((nc, D), 0.02)
    inp['rw_lnx_b'] = nrm((nc, D), 0.01)
    inp['moe_router_g'] = nrm((DEPTH, D, N_GROUPS), D ** -0.5)
    inp['moe_router_g_b'] = nrm((DEPTH, N_GROUPS), 0.01)
    inp['moe_router_e'] = nrm((DEPTH, D, N_EXPERTS), D ** -0.5)
    inp['moe_router_e_b'] = nrm((DEPTH, N_EXPERTS), 0.01)
    inp['moe_w_gate'] = nrm((DEPTH, N_EXPERTS, D, D_EXPERT), D ** -0.5)
    inp['moe_w_up'] = nrm((DEPTH, N_EXPERTS, D, D_EXPERT), D ** -0.5)
    inp['moe_w_down'] = nrm((DEPTH, N_EXPERTS, D_EXPERT, D), D_EXPERT ** -0.5)
    return inp


def reference(x, meta_tokens, norm_mix, norm_ffn, norm_final,
              ab_w_in, ab_w_out, ab_norm_a, ab_norm_b,
              s5_lam_re, s5_lam_im, s5_log_dt, s5_b_re, s5_b_im, s5_c_re, s5_c_im, s5_d,
              s5_w_glu, s5_b_glu,
              lru_conv_w, lru_conv_b, lru_w_a, lru_b_a, lru_w_x, lru_b_x, lru_lam,
              rw_mu, rw_w_r, rw_w_k, rw_w_v, rw_w_o, rw_w0, rw_w_l1, rw_w_l2,
              rw_a0, rw_a_l1, rw_a_l2, rw_v0, rw_v_l1, rw_v_l2, rw_g_l1, rw_g_l2,
              rw_k_k, rw_k_a, rw_r_k, rw_lnx_w, rw_lnx_b,
              moe_router_g, moe_router_g_b, moe_router_e, moe_router_e_b,
              moe_w_gate, moe_w_up, moe_w_down):
    bsz = x.shape[0]
    meta = jnp.broadcast_to(meta_tokens.astype(F32)[None], (bsz, N_META, D_MODEL))
    h = jnp.concatenate([meta, x.astype(F32)], axis=1)
    v_first = None
    for layer in range(DEPTH):
        hn = _rmsnorm(h, norm_mix[layer])
        j = layer // 2
        if layer % 2 == 0:
            mix = _s5_rglru_layer(hn, ab_w_in[j], ab_w_out[j], ab_norm_a[j], ab_norm_b[j],
                                  s5_lam_re[j], s5_lam_im[j], s5_log_dt[j], s5_b_re[j], s5_b_im[j],
                                  s5_c_re[j], s5_c_im[j], s5_d[j], s5_w_glu[j], s5_b_glu[j],
                                  lru_conv_w[j], lru_conv_b[j], lru_w_a[j], lru_b_a[j],
                                  lru_w_x[j], lru_b_x[j], lru_lam[j])
        else:
            v_res = (rw_v0[j - 1], rw_v_l1[j - 1], rw_v_l2[j - 1]) if j > 0 else None
            mix, v_first = _rwkv7_mixer(hn, v_first, v_res, rw_mu[j], rw_w_r[j], rw_w_k[j],
                                        rw_w_v[j], rw_w_o[j], rw_w0[j], rw_w_l1[j], rw_w_l2[j],
                                        rw_a0[j], rw_a_l1[j], rw_a_l2[j], rw_g_l1[j], rw_g_l2[j],
                                        rw_k_k[j], rw_k_a[j], rw_r_k[j], rw_lnx_w[j], rw_lnx_b[j])
        h = h + mix
        h = h + _hier_moe(_rmsnorm(h, norm_ffn[layer]), moe_router_g[layer], moe_router_g_b[layer],
                          moe_router_e[layer], moe_router_e_b[layer], moe_w_gate[layer],
                          moe_w_up[layer], moe_w_down[layer])
    return _rmsnorm(h, norm_final)[:, N_META:].astype(x.dtype)
```

```cpp
#include <hip/hip_runtime.h>
#include <cstdio>
#include <cstdint>
namespace nv {
constexpr int D = 1024, B = 8, SEQ = 2048, NMETA = 16, L = SEQ + NMETA, T = B * L;
constexpr float RMS_EPS = 1e-6f;

__device__ __forceinline__ float gelu_tanh(float x) { const float c = 0.7978845608028654f; return 0.5f * x * (1.f + tanhf(c * (x + 0.044715f * x * x * x))); }
__device__ __forceinline__ float sigmoidf_(float x) { return 1.f / (1.f + expf(-x)); }
__device__ __forceinline__ float softplusf_(float x) { return x > 20.f ? x : log1pf(expf(x)); }

__global__ void k_build_h(const float* __restrict__ x, const float* __restrict__ meta, float* __restrict__ h) {
    const size_t i = (size_t)blockIdx.x * blockDim.x + threadIdx.x; if (i >= (size_t)T * D) return;
    const int d = (int)(i % D); const size_t row = i / D; const int b = (int)(row / L), t = (int)(row % L);
    h[i] = t < NMETA ? meta[t * D + d] : x[((size_t)b * SEQ + (t - NMETA)) * D + d];
}
__global__ void k_rmsnorm(const float* __restrict__ in, int ldi, const float* __restrict__ g, float* __restrict__ out, int ldo, int n) {
    __shared__ float red[256];
    const float* r = in + (size_t)blockIdx.x * ldi; float s = 0.f;
    for (int i = threadIdx.x; i < n; i += 256) s += r[i] * r[i];
    red[threadIdx.x] = s; __syncthreads();
    for (int o = 128; o > 0; o >>= 1) { if (threadIdx.x < o) red[threadIdx.x] += red[threadIdx.x + o]; __syncthreads(); }
    const float rs = rsqrtf(red[0] / n + RMS_EPS);
    float* w = out + (size_t)blockIdx.x * ldo;
    for (int i = threadIdx.x; i < n; i += 256) w[i] = r[i] * rs * g[i];
}
__global__ __launch_bounds__(256) void k_gemm(const float* __restrict__ A, int lda, const float* __restrict__ Bm, int ldb, float* __restrict__ C, int ldc, int M, int N, int K, int accum) {
    __shared__ float As[16][68]; __shared__ float Bs[16][68];
    const int tx = threadIdx.x & 15, ty = threadIdx.x >> 4, m0 = blockIdx.y * 64, n0 = blockIdx.x * 64;
    float acc[4][4];
#pragma unroll
    for (int i = 0; i < 4; ++i)
#pragma unroll
        for (int j = 0; j < 4; ++j) acc[i][j] = 0.f;
    for (int k0 = 0; k0 < K; k0 += 16) {
#pragma unroll
        for (int q = 0; q < 4; ++q) { const int i = threadIdx.x + q * 256; const int r = i >> 4, c = i & 15; const int gm = m0 + r; As[c][r] = gm < M ? A[(size_t)gm * lda + k0 + c] : 0.f; }
#pragma unroll
        for (int q = 0; q < 4; ++q) { const int i = threadIdx.x + q * 256; const int r = i >> 6, c = i & 63; const int gn = n0 + c; Bs[r][c] = gn < N ? Bm[(size_t)(k0 + r) * ldb + gn] : 0.f; }
        __syncthreads();
#pragma unroll
        for (int k = 0; k < 16; ++k) {
            float a[4], b[4];
#pragma unroll
            for (int i = 0; i < 4; ++i) { a[i] = As[k][ty * 4 + i]; b[i] = Bs[k][tx * 4 + i]; }
#pragma unroll
            for (int i = 0; i < 4; ++i)
#pragma unroll
                for (int j = 0; j < 4; ++j) acc[i][j] += a[i] * b[j];
        }
        __syncthreads();
    }
#pragma unroll
    for (int i = 0; i < 4; ++i) { const int gm = m0 + ty * 4 + i; if (gm >= M) continue;
#pragma unroll
        for (int j = 0; j < 4; ++j) { const int gn = n0 + tx * 4 + j; if (gn >= N) continue; float* p = C + (size_t)gm * ldc + gn; *p = accum ? (*p + acc[i][j]) : acc[i][j]; } }
}
__global__ __launch_bounds__(64) void k_s5(const float* __restrict__ z, int ldz, const float* __restrict__ lam_re, const float* __restrict__ lam_im, const float* __restrict__ log_dt,
                                            const float* __restrict__ b_re, const float* __restrict__ b_im, const float* __restrict__ c_re, const float* __restrict__ c_im, const float* __restrict__ dsk,
                                            float* __restrict__ ys, int nL) {
    const int g = blockIdx.x, p = threadIdx.x;
    __shared__ float su[16], sxr[64], sxi[64];
    const float lr = lam_re[g * 64 + p], li = lam_im[g * 64 + p], dt = expf(log_dt[g]);
    const float mag = expf(lr * dt), ar = mag * cosf(li * dt), ai = mag * sinf(li * dt), den = lr * lr + li * li;
    const float zr = ((ar - 1.f) * lr + ai * li) / den, zi = (ai * lr - (ar - 1.f) * li) / den;
    float bbr[16], bbi[16];
#pragma unroll
    for (int h = 0; h < 16; ++h) { const float br = b_re[(g * 64 + p) * 16 + h], bi = b_im[(g * 64 + p) * 16 + h]; bbr[h] = zr * br - zi * bi; bbi[h] = zr * bi + zi * br; }
    float xr = 0.f, xi = 0.f;
    for (int t = 0; t < nL; ++t) {
        if (p < 16) su[p] = z[(size_t)t * ldz + g * 16 + p];
        __syncthreads();
        float bur = 0.f, bui = 0.f;
#pragma unroll
        for (int h = 0; h < 16; ++h) { bur += su[h] * bbr[h]; bui += su[h] * bbi[h]; }
        const float nr = ar * xr - ai * xi + bur, ni = ar * xi + ai * xr + bui; xr = nr; xi = ni;
        sxr[p] = xr; sxi[p] = xi;
        __syncthreads();
        if (p < 16) { float y = 0.f; for (int q = 0; q < 64; ++q) y += sxr[q] * c_re[(g * 16 + p) * 64 + q] - sxi[q] * c_im[(g * 16 + p) * 64 + q];
            y += dsk[g * 16 + p] * su[p]; ys[(size_t)t * 512 + g * 16 + p] = gelu_tanh(y); }
        __syncthreads();
    }
}
__global__ void k_glu(float* __restrict__ ys, const float* __restrict__ glu, const float* __restrict__ bglu, int n) {
    const int i = blockIdx.x * blockDim.x + threadIdx.x; if (i >= n) return; ys[i] = ys[i] * sigmoidf_(glu[i] + bglu[i % 512]);
}
__global__ void k_lru_conv(const float* __restrict__ z, int ldz, const float* __restrict__ cw, const float* __restrict__ cb, float* __restrict__ xc, int nL) {
    const int i = blockIdx.x * blockDim.x + threadIdx.x; if (i >= nL * 512) return; const int t = i / 512, c = i % 512; float s = cb[c];
    for (int k = 0; k < 4; ++k) { const int tt = t - 3 + k; if (tt >= 0) s += z[(size_t)tt * ldz + 1024 + c] * cw[k * 512 + c]; }
    xc[i] = s;
}
__global__ void k_lru_gates(const float* __restrict__ xc, const float* __restrict__ wa, const float* __restrict__ ba, const float* __restrict__ wx, const float* __restrict__ bx,
                            const float* __restrict__ lam, float* __restrict__ av, float* __restrict__ bv, int nL) {
    const int i = blockIdx.x * blockDim.x + threadIdx.x; if (i >= nL * 512) return; const int t = i / 512, c = i % 512, hd = c / 64, j = c % 64;
    float r = ba[c], ig = bx[c];
    for (int q = 0; q < 64; ++q) { const float x = xc[(size_t)t * 512 + hd * 64 + q]; r += x * wa[(hd * 64 + q) * 64 + j]; ig += x * wx[(hd * 64 + q) * 64 + j]; }
    r = sigmoidf_(r); ig = sigmoidf_(ig);
    const float log_a = -8.0f * r * softplusf_(-lam[c]);
    av[i] = expf(log_a); bv[i] = sqrtf(-expm1f(2.f * log_a)) * (ig * xc[i]);
}
__global__ void k_lru_scan(const float* __restrict__ av, const float* __restrict__ bv, const float* __restrict__ z, int ldz, float* __restrict__ out, int nL) {
    const int c = blockIdx.x * blockDim.x + threadIdx.x; if (c >= 512) return; float h = 0.f;
    for (int t = 0; t < nL; ++t) { h = av[(size_t)t * 512 + c] * h + bv[(size_t)t * 512 + c]; out[(size_t)t * 512 + c] = gelu_tanh(z[(size_t)t * ldz + 512 + c]) * h; }
}
__global__ void k_shiftmix(const float* __restrict__ hn, const float* __restrict__ mu, float* __restrict__ xs, int nL) {
    const int i = blockIdx.x * blockDim.x + threadIdx.x; if (i >= nL * D) return; const int t = i / D, d = i % D;
    const float x = hn[i], xp = t > 0 ? hn[i - D] : 0.f; xs[i] = x + (xp - x) * mu[d];
}
__global__ void k_act(float* __restrict__ p, int n, int kind) { const int i = blockIdx.x * blockDim.x + threadIdx.x; if (i >= n) return; p[i] = kind == 0 ? tanhf(p[i]) : sigmoidf_(p[i]); }
__global__ __launch_bounds__(64) void k_rw_prep(const float* __restrict__ k, float* __restrict__ v, const float* __restrict__ wpre, const float* __restrict__ apre, const float* __restrict__ vgpre,
                                                 float* __restrict__ vfirst, const float* __restrict__ w0, const float* __restrict__ a0, const float* __restrict__ v0, const float* __restrict__ k_k, const float* __restrict__ k_a,
                                                 float* __restrict__ wdec, float* __restrict__ k2, float* __restrict__ a2, float* __restrict__ b2, int first_layer) {
    const int t = blockIdx.x / 16, hd = blockIdx.x % 16, j = threadIdx.x, c = hd * 64 + j; const size_t i = (size_t)t * D + c;
    __shared__ float red[64];
    const float kr = k[i]; const float kk = kr * k_k[c];
    red[j] = kk * kk; __syncthreads();
    for (int o = 32; o > 0; o >>= 1) { if (j < o) red[j] += red[j + o]; __syncthreads(); }
    const float nrm = fmaxf(sqrtf(red[0]), 1e-12f); const float kkn = kk / nrm;
    const float a = sigmoidf_(a0[c] + apre[i]);
    const float wl = -softplusf_(-(w0[c] + wpre[i])) - 0.5f;
    wdec[i] = expf(-expf(wl));
    k2[i] = kr * (1.f + (a - 1.f) * k_a[c]);
    a2[i] = -kkn; b2[i] = kkn * a;
    if (first_layer) vfirst[i] = v[i]; else { const float vv = v[i]; v[i] = vv + (vfirst[i] - vv) * sigmoidf_(v0[c] + vgpre[i]); }
}
__global__ __launch_bounds__(64) void k_rw_scan(const float* __restrict__ r, const float* __restrict__ w, const float* __restrict__ k, const float* __restrict__ v, const float* __restrict__ a, const float* __restrict__ b,
                                                 float* __restrict__ y, int nL) {
    const int hd = blockIdx.x, i = threadIdx.x;
    __shared__ float sr[64], sw[64], sk[64], sa[64], sb[64];
    float S[64];
#pragma unroll
    for (int j = 0; j < 64; ++j) S[j] = 0.f;
    for (int t = 0; t < nL; ++t) {
        const size_t o = (size_t)t * D + hd * 64 + i;
        sr[i] = r[o]; sw[i] = w[o]; sk[i] = k[o]; sa[i] = a[o]; sb[i] = b[o]; const float vi = v[o];
        __syncthreads();
        float s = 0.f;
#pragma unroll
        for (int j = 0; j < 64; ++j) s += S[j] * sa[j];
        float yy = 0.f;
#pragma unroll
        for (int j = 0; j < 64; ++j) { S[j] = S[j] * sw[j] + s * sb[j] + vi * sk[j]; yy += S[j] * sr[j]; }
        y[o] = yy;
        __syncthreads();
    }
}
__global__ __launch_bounds__(64) void k_rw_post(const float* __restrict__ y, const float* __restrict__ r, const float* __restrict__ k2, const float* __restrict__ v, const float* __restrict__ g,
                                                 const float* __restrict__ r_k, const float* __restrict__ lnw, const float* __restrict__ lnb, float* __restrict__ out) {
    const int t = blockIdx.x / 16, hd = blockIdx.x % 16, j = threadIdx.x, c = hd * 64 + j; const size_t i = (size_t)t * D + c;
    __shared__ float red[64];
    const float yv = y[i];
    red[j] = yv; __syncthreads();
    for (int o = 32; o > 0; o >>= 1) { if (j < o) red[j] += red[j + o]; __syncthreads(); }
    const float mean = red[0] / 64.f; __syncthreads();
    const float dv = yv - mean; red[j] = dv * dv; __syncthreads();
    for (int o = 32; o > 0; o >>= 1) { if (j < o) red[j] += red[j + o]; __syncthreads(); }
    const float var = red[0] / 64.f; __syncthreads();
    red[j] = r[i] * k2[i] * r_k[c]; __syncthreads();
    for (int o = 32; o > 0; o >>= 1) { if (j < o) red[j] += red[j + o]; __syncthreads(); }
    const float bonus = red[0] * v[i];
    out[i] = (dv * rsqrtf(var + 64e-5f) * lnw[c] + lnb[c] + bonus) * g[i];
}
__global__ __launch_bounds__(64) void k_router(const float* __restrict__ xn, const float* __restrict__ wg, const float* __restrict__ bg, const float* __restrict__ we, const float* __restrict__ be, int* __restrict__ eid, float* __restrict__ gate) {
    const int t = blockIdx.x, l = threadIdx.x; const float* x = xn + (size_t)t * D;
    float acc[20];
#pragma unroll
    for (int q = 0; q < 20; ++q) acc[q] = 0.f;
    for (int d = l; d < D; d += 64) { const float xv = x[d];
#pragma unroll
        for (int q = 0; q < 4; ++q) acc[q] += xv * wg[d * 4 + q];
#pragma unroll
        for (int q = 0; q < 16; ++q) acc[4 + q] += xv * we[d * 16 + q]; }
#pragma unroll
    for (int q = 0; q < 20; ++q) { float s = acc[q];
#pragma unroll
        for (int o = 32; o > 0; o >>= 1) s += __shfl_xor(s, o);
        acc[q] = s; }
    if (l == 0) {
        float lg[4]; int gi = 0; float mx = -3.0e38f;
#pragma unroll
        for (int q = 0; q < 4; ++q) { lg[q] = acc[q] + bg[q]; if (lg[q] > mx) { mx = lg[q]; gi = q; } }
        float den = 0.f;
#pragma unroll
        for (int q = 0; q < 4; ++q) den += expf(lg[q] - mx);
        const float pg = 1.f / den;
        float le[4];
#pragma unroll
        for (int q = 0; q < 4; ++q) { float s = 0.f;
#pragma unroll
            for (int gq = 0; gq < 4; ++gq) s = (gq == gi) ? (acc[4 + gq * 4 + q] + be[gq * 4 + q]) : s;
            le[q] = s; }
        int i1 = 0; float v1 = le[0];
#pragma unroll
        for (int q = 1; q < 4; ++q) if (le[q] > v1) { v1 = le[q]; i1 = q; }
        int i2 = -1; float v2 = -3.0e38f;
#pragma unroll
        for (int q = 0; q < 4; ++q) if (q != i1 && le[q] > v2) { v2 = le[q]; i2 = q; }
        const float e2 = expf(v2 - v1), s1 = 1.f / (1.f + e2), s2 = e2 / (1.f + e2);
        eid[t * 2] = gi * 4 + i1; eid[t * 2 + 1] = gi * 4 + i2; gate[t * 2] = s1 * pg; gate[t * 2 + 1] = s2 * pg;
    }
}
__global__ __launch_bounds__(256) void k_experts(const float* __restrict__ xn, const int* __restrict__ eid, const float* __restrict__ gate, const float* __restrict__ wgt, const float* __restrict__ wup, const float* __restrict__ wdn, float* __restrict__ h) {
    const int t = blockIdx.x, tid = threadIdx.x;
    __shared__ float sx[1024]; __shared__ float sh[512];
    for (int d = tid; d < D; d += 256) sx[d] = xn[(size_t)t * D + d];
    float out[4] = {0.f, 0.f, 0.f, 0.f};
    __syncthreads();
    for (int kx = 0; kx < 2; ++kx) {
        const int e = eid[t * 2 + kx]; const float gw = gate[t * 2 + kx];
        const float* G = wgt + (size_t)e * D * 512; const float* U = wup + (size_t)e * D * 512; const float* Dn = wdn + (size_t)e * 512 * D;
        float g0 = 0.f, g1 = 0.f, u0 = 0.f, u1 = 0.f;
        for (int d = 0; d < D; ++d) { const float xv = sx[d]; g0 += xv * G[(size_t)d * 512 + tid]; g1 += xv * G[(size_t)d * 512 + tid + 256]; u0 += xv * U[(size_t)d * 512 + tid]; u1 += xv * U[(size_t)d * 512 + tid + 256]; }
        __syncthreads();
        sh[tid] = g0 * sigmoidf_(g0) * u0 * gw; sh[tid + 256] = g1 * sigmoidf_(g1) * u1 * gw;
        __syncthreads();
        for (int f = 0; f < 512; ++f) { const float hv = sh[f];
#pragma unroll
            for (int q = 0; q < 4; ++q) out[q] += hv * Dn[(size_t)f * D + tid + q * 256]; }
    }
#pragma unroll
    for (int q = 0; q < 4; ++q) h[(size_t)t * D + tid + q * 256] += out[q];
}
__global__ void k_final(const float* __restrict__ h, const float* __restrict__ g, float* __restrict__ out) {
    __shared__ float red[256];
    const int b = blockIdx.x / SEQ, s = blockIdx.x % SEQ; const float* r = h + ((size_t)b * L + NMETA + s) * D; float acc = 0.f;
    for (int i = threadIdx.x; i < D; i += 256) acc += r[i] * r[i];
    red[threadIdx.x] = acc; __syncthreads();
    for (int o = 128; o > 0; o >>= 1) { if (threadIdx.x < o) red[threadIdx.x] += red[threadIdx.x + o]; __syncthreads(); }
    const float rs = rsqrtf(red[0] / D + RMS_EPS);
    for (int i = threadIdx.x; i < D; i += 256) out[(size_t)blockIdx.x * D + i] = r[i] * rs * g[i];
}

struct Tmp { float* t[12]; float* small[3]; int* eid; float* gate; };
static void gemm(hipStream_t st, const float* A, int lda, const float* Bm, int ldb, float* C, int ldc, int M, int N, int K, int accum) {
    dim3 grid((N + 63) / 64, (M + 63) / 64); k_gemm<<<grid, 256, 0, st>>>(A, lda, Bm, ldb, C, ldc, M, N, K, accum);
}
static inline int cdiv(int a, int b) { return (a + b - 1) / b; }

static void ab_layer(hipStream_t st, void* const* in, int layer, float* hb, const Tmp& W) {
    const int j = layer / 2; auto F = [&](int i) { return (const float*)in[i]; };
    float *hn = W.t[0], *z = W.t[1], *ys = W.t[2], *glu = W.t[3], *cat = W.t[4], *xc = W.t[5], *av = W.t[6], *bv = W.t[7], *lo = W.t[8];
    k_rmsnorm<<<L, 256, 0, st>>>(hb, D, F(2) + layer * D, hn, D, D);
    gemm(st, hn, D, F(5) + (size_t)j * D * 1536, 1536, z, 1536, L, 1536, D, 0);
    k_s5<<<32, 64, 0, st>>>(z, 1536, F(9) + j * 2048, F(10) + j * 2048, F(11) + j * 32, F(12) + j * 32768, F(13) + j * 32768, F(14) + j * 32768, F(15) + j * 32768, F(16) + j * 512, ys, L);
    gemm(st, ys, 512, F(17) + (size_t)j * 512 * 512, 512, glu, 512, L, 512, 512, 0);
    k_glu<<<cdiv(L * 512, 256), 256, 0, st>>>(ys, glu, F(18) + j * 512, L * 512);
    k_rmsnorm<<<L, 256, 0, st>>>(ys, 512, F(7) + j * 512, cat, D, 512);
    k_lru_conv<<<cdiv(L * 512, 256), 256, 0, st>>>(z, 1536, F(19) + j * 2048, F(20) + j * 512, xc, L);
    k_lru_gates<<<cdiv(L * 512, 256), 256, 0, st>>>(xc, F(21) + j * 32768, F(22) + j * 512, F(23) + j * 32768, F(24) + j * 512, F(25) + j * 512, av, bv, L);
    k_lru_scan<<<2, 256, 0, st>>>(av, bv, z, 1536, lo, L);
    k_rmsnorm<<<L, 256, 0, st>>>(lo, 512, F(8) + j * 512, cat + 512, D, 512);
    gemm(st, cat, D, F(6) + (size_t)j * D * D, D, hb, D, L, D, D, 1);
}
static void rw_layer(hipStream_t st, void* const* in, int layer, float* hb, float* vfb, const Tmp& W) {
    const int j = layer / 2; auto F = [&](int i) { return (const float*)in[i]; };
    float *hn = W.t[0], *xs = W.t[1], *r = W.t[2], *k = W.t[3], *v = W.t[4], *wpre = W.t[5], *apre = W.t[6], *vg = W.t[7], *g = W.t[8], *wdec = W.t[9], *k2 = W.t[10], *a2 = W.t[11];
    float *b2 = W.t[1]  , *y = W.t[5]  , *yo = W.t[6]  ;
    const float* mu = F(26) + (size_t)j * 6 * D; const int nb = cdiv(L * D, 256);
    k_rmsnorm<<<L, 256, 0, st>>>(hb, D, F(2) + layer * D, hn, D, D);
    k_shiftmix<<<nb, 256, 0, st>>>(hn, mu + 0 * D, xs, L); gemm(st, xs, D, F(27) + (size_t)j * D * D, D, r, D, L, D, D, 0);
    k_shiftmix<<<nb, 256, 0, st>>>(hn, mu + 1 * D, xs, L); gemm(st, xs, D, F(32) + (size_t)j * D * 64, 64, W.small[0], 64, L, 64, D, 0);
    k_act<<<cdiv(L * 64, 256), 256, 0, st>>>(W.small[0], L * 64, 0); gemm(st, W.small[0], 64, F(33) + (size_t)j * 64 * D, D, wpre, D, L, D, 64, 0);
    k_shiftmix<<<nb, 256, 0, st>>>(hn, mu + 2 * D, xs, L); gemm(st, xs, D, F(28) + (size_t)j * D * D, D, k, D, L, D, D, 0);
    k_shiftmix<<<nb, 256, 0, st>>>(hn, mu + 3 * D, xs, L); gemm(st, xs, D, F(29) + (size_t)j * D * D, D, v, D, L, D, D, 0);
    if (j > 0) { gemm(st, xs, D, F(38) + (size_t)(j - 1) * D * 32, 32, W.small[1], 32, L, 32, D, 0); gemm(st, W.small[1], 32, F(39) + (size_t)(j - 1) * 32 * D, D, vg, D, L, D, 32, 0); }
    k_shiftmix<<<nb, 256, 0, st>>>(hn, mu + 4 * D, xs, L); gemm(st, xs, D, F(35) + (size_t)j * D * 64, 64, W.small[0], 64, L, 64, D, 0);
    gemm(st, W.small[0], 64, F(36) + (size_t)j * 64 * D, D, apre, D, L, D, 64, 0);
    k_shiftmix<<<nb, 256, 0, st>>>(hn, mu + 5 * D, xs, L); gemm(st, xs, D, F(40) + (size_t)j * D * 128, 128, W.small[2], 128, L, 128, D, 0);
    k_act<<<cdiv(L * 128, 256), 256, 0, st>>>(W.small[2], L * 128, 1); gemm(st, W.small[2], 128, F(41) + (size_t)j * 128 * D, D, g, D, L, D, 128, 0);
    k_rw_prep<<<L * 16, 64, 0, st>>>(k, v, wpre, apre, vg, vfb, F(31) + j * D, F(34) + j * D, j > 0 ? F(37) + (j - 1) * D : nullptr, F(42) + j * D, F(43) + j * D, wdec, k2, a2, b2, j == 0 ? 1 : 0);
    k_rw_scan<<<16, 64, 0, st>>>(r, wdec, k2, v, a2, b2, y, L);
    k_rw_post<<<L * 16, 64, 0, st>>>(y, r, k2, v, g, F(44) + j * D, F(45) + j * D, F(46) + j * D, yo);
    gemm(st, yo, D, F(30) + (size_t)j * D * D, D, hb, D, L, D, D, 1);
}
static void moe_layer(hipStream_t st, void* const* in, int layer, float* hb, const Tmp& W) {
    auto F = [&](int i) { return (const float*)in[i]; }; float* hn = W.t[0];
    k_rmsnorm<<<L, 256, 0, st>>>(hb, D, F(3) + layer * D, hn, D, D);
    k_router<<<L, 64, 0, st>>>(hn, F(47) + (size_t)layer * D * 4, F(48) + layer * 4, F(49) + (size_t)layer * D * 16, F(50) + layer * 16, W.eid, W.gate);
    const size_t eo = (size_t)layer * 16 * D * 512;
    k_experts<<<L, 256, 0, st>>>(hn, W.eid, W.gate, F(51) + eo, F(52) + eo, F(53) + eo, hb);
}
}
extern "C" void kernel_launch(void* const* d_in, const int* in_sizes, int n_in, void* d_out, int out_size, void* d_ws, size_t ws_size, hipStream_t stream) {
    using namespace nv;
    float* ws = (float*)d_ws;
    float* h = ws; ws += (size_t)T * D;
    float* vf = ws; ws += (size_t)T * D;
    Tmp W;
    for (int i = 0; i < 12; ++i) { W.t[i] = ws; ws += (size_t)L * 1536; }
    for (int i = 0; i < 3; ++i) { W.small[i] = ws; ws += (size_t)L * 128; }
    W.eid = (int*)ws; ws += (size_t)L * 2; W.gate = ws; ws += (size_t)L * 2;
    if ((size_t)((char*)ws - (char*)d_ws) > ws_size) { fprintf(stderr, "workspace too small\n"); return; }
    k_build_h<<<cdiv(T * D, 256), 256, 0, stream>>>((const float*)d_in[0], (const float*)d_in[1], h);
    for (int layer = 0; layer < 4; ++layer)
        for (int b = 0; b < B; ++b) {
            float* hb = h + (size_t)b * L * D; float* vfb = vf + (size_t)b * L * D;
            if (layer % 2 == 0) ab_layer(stream, d_in, layer, hb, W); else rw_layer(stream, d_in, layer, hb, vfb, W);
            moe_layer(stream, d_in, layer, hb, W);
        }
    k_final<<<B * SEQ, 256, 0, stream>>>(h, (const float*)d_in[4], (float*)d_out);
}
```

```cpp
#include <hip/hip_runtime.h>
#include <cstdio>
#include <cstdint>
#define GAS __attribute__((address_space(1)))
#define LAS __attribute__((address_space(3)))
typedef unsigned short bf16;
typedef unsigned v4u __attribute__((ext_vector_type(4)));
typedef unsigned v2u __attribute__((ext_vector_type(2)));
typedef float f32x4 __attribute__((ext_vector_type(4)));
typedef float f32x2 __attribute__((ext_vector_type(2)));
typedef short bf16x8 __attribute__((ext_vector_type(8)));
#define LDS_WAIT() asm volatile("s_waitcnt lgkmcnt(0)" ::: "memory")
#define PHASE_IDS() int tid = threadIdx.x; asm volatile("" : "+v"(tid)); const int lane = tid & 63; const int wave = __builtin_amdgcn_readfirstlane(tid >> 6); (void)lane; (void)wave; unsigned char* wsl = F.ws; asm volatile("" : "+s"(wsl))
#define VM_WAIT() asm volatile("s_waitcnt vmcnt(0)" ::: "memory")

namespace fk {
constexpr int D = 1024, NB = 8, SEQ = 2048, NMETA = 16, L = SEQ + NMETA, PRE = 16, LP = L + PRE, TP = NB * LP;
constexpr int NWAVES = 8, NT = 512;
constexpr float RMS_EPS = 1e-6f;
static_assert(TP % 256 == 0, "row padding");
constexpr int MOE_ROWS = 37120;
constexpr int LISTCAP = TP;

constexpr size_t MiB = 1u << 20;
constexpr size_t WS_CTL = 0, CTL_ZERO_BYTES = 1 * MiB;
constexpr size_t WS_WMIX = 1 * MiB;
constexpr size_t WS_WMOE = 51 * MiB;
constexpr size_t WS_H = 99 * MiB;
constexpr size_t WS_VF = 164 * MiB;
constexpr size_t WS_O = WS_VF + (size_t)TP * D * 2;
constexpr size_t WS_ACT = WS_O + (size_t)TP * 2 * D * 2;
constexpr size_t WS_END = 512 * MiB;
constexpr size_t ACT_BYTES = WS_END - WS_ACT;
constexpr size_t A_XN = 0;
constexpr size_t A_HID = A_XN + (size_t)TP * D * 2;
constexpr size_t A_LIST = A_HID + (size_t)MOE_ROWS * 512 * 2;
constexpr size_t A_LISTW = A_LIST + (size_t)16 * LISTCAP * 4;
constexpr size_t A_LISTD = A_LISTW + (size_t)16 * LISTCAP * 4;
constexpr size_t A_MOE_END = A_LISTD + (size_t)16 * LISTCAP * 4;
static_assert(A_MOE_END <= ACT_BYTES, "MoE activations fit");
constexpr int CW_BAR = 4096;
constexpr int CW_CNT = 131072;

__device__ __forceinline__ unsigned f2bf(float f) { unsigned u = __builtin_bit_cast(unsigned, f); return (u + 0x7fffu + ((u >> 16) & 1u)) >> 16; }
__device__ __forceinline__ unsigned pk2(float lo, float hi) { return f2bf(lo) | (f2bf(hi) << 16); }
__device__ __forceinline__ float bf2f(unsigned b) { return __builtin_bit_cast(float, b << 16); }
__device__ __forceinline__ float bflo(unsigned w) { return __builtin_bit_cast(float, w << 16); }
__device__ __forceinline__ float bfhi(unsigned w) { return __builtin_bit_cast(float, w & 0xffff0000u); }
__device__ __forceinline__ float wave_sum(float v) {
#pragma unroll
    for (int o = 1; o < 64; o <<= 1) v += __shfl_xor(v, o);
    return v;
}
__device__ __forceinline__ float sigmoid_f(float x) { return 1.f / (1.f + __expf(-x)); }
__device__ __forceinline__ float gelu_tanh_f(float x) { const float u = 0.7978845608028654f * (x + 0.044715f * x * x * x); return x * sigmoid_f(2.f * u); }

#define XB_TMO      128
#define XB_XCNT(j)  (256  + 64 * (j))
#define XB_XSUB(j)  (1280 + 64 * (j))
#define XB_XGEN(j)  (2304 + 64 * (j))
#define XB_TOP      3328
#define XB_TOPGEN   3392
#define XCD_BAR_WORDS 3456
#define XB_SPIN_CAP (1u << 18)
__device__ __forceinline__ unsigned xb_ld(unsigned* p)              { return __hip_atomic_load(p, __ATOMIC_RELAXED, __HIP_MEMORY_SCOPE_AGENT); }
__device__ __forceinline__ unsigned xb_add(unsigned* p, unsigned v) { return __hip_atomic_fetch_add(p, v, __ATOMIC_RELAXED, __HIP_MEMORY_SCOPE_AGENT); }
__device__ __forceinline__ unsigned xb_xcc_id() { return (unsigned)__builtin_amdgcn_s_getreg((3 << 11) | 20) & 0xFu; }
#define XB_SPIN(cond, bar) do { unsigned _sp = 0; while (cond) { __builtin_amdgcn_s_sleep(1); \
    if ((++_sp & 255u) == 0u) { if (xb_ld(&(bar)[XB_TMO])) break; if (_sp > XB_SPIN_CAP) { atomicAdd(&(bar)[XB_TMO], 1u); break; } } } } while (0)
struct XcdBarrier { unsigned* bar; unsigned x; volatile LAS unsigned* st; };
__device__ __forceinline__ XcdBarrier xcd_barrier_post(unsigned* bar, volatile LAS unsigned* st) {
    XcdBarrier b; b.bar = bar; b.x = xb_xcc_id(); b.st = st;
    if (threadIdx.x == 0) (void)xb_add(&bar[XB_XCNT(b.x)], 1u);
    return b;
}
__device__ __forceinline__ void xcd_barrier_complete(unsigned* bar, unsigned x, unsigned& nloc, unsigned& nx) {
    const unsigned G = gridDim.x * gridDim.y * gridDim.z;
    unsigned sum, cnt, mine, sp = 0u;
    for (;;) {
        sum = 0u; cnt = 0u; mine = 0u;
#pragma unroll
        for (unsigned j = 0; j < 16; ++j) { const unsigned c = xb_ld(&bar[XB_XCNT(j)]); sum += c; cnt += (c > 0u) ? 1u : 0u; mine = (j == x) ? c : mine; }
        if (sum == G) break;
        __builtin_amdgcn_s_sleep(1);
        if ((++sp & 255u) == 0u) { if (xb_ld(&bar[XB_TMO])) break; if (sp > XB_SPIN_CAP) { atomicAdd(&bar[XB_TMO], 1u); break; } }
    }
    nloc = mine > 0u ? mine : 1u; nx = cnt > 0u ? cnt : 1u;
}
__device__ __forceinline__ void xcd_barrier(const XcdBarrier& b) {
    asm volatile("s_waitcnt vmcnt(0)" ::: "memory");
    __syncthreads();
    if (threadIdx.x == 0) {
        unsigned* bar = b.bar;
        __builtin_amdgcn_s_waitcnt(0);
        unsigned nloc = b.st[0], nx = b.st[1];
        if (nloc == 0u) { xcd_barrier_complete(bar, b.x, nloc, nx); b.st[0] = nloc; b.st[1] = nx; }
        const unsigned old = xb_add(&bar[XB_XSUB(b.x)], 1u);
        const unsigned gen = old / nloc;
        if (old + 1u == (gen + 1u) * nloc) {
            __builtin_amdgcn_fence(__ATOMIC_RELEASE, "agent");
            asm volatile("s_waitcnt vmcnt(0)" ::: "memory");
            const unsigned og = xb_add(&bar[XB_TOP], 1u);
            const unsigned tg = og / nx;
            if (og + 1u == (tg + 1u) * nx) xb_add(&bar[XB_TOPGEN], 1u);
            else XB_SPIN(xb_ld(&bar[XB_TOPGEN]) == tg, bar);
            __builtin_amdgcn_fence(__ATOMIC_ACQUIRE, "agent");
            xb_add(&bar[XB_XGEN(b.x)], 1u);
            asm volatile("s_waitcnt vmcnt(0)" ::: "memory");
        } else {
            XB_SPIN(xb_ld(&bar[XB_XGEN(b.x)]) == gen, bar);
            __builtin_amdgcn_fence(__ATOMIC_ACQUIRE, "agent");
            asm volatile("s_waitcnt vmcnt(0)" ::: "memory");
        }
    }
    __syncthreads();
}

constexpr int BM = 256, BK = 64, HALF = 128, HTB = HALF * BK * 2, STAGE_BYTES = 8 * HTB;
__host__ __device__ __forceinline__ int lds_byte(int r, int c) { const int st = (r >> 4) * 2 + (c >> 5), rr = r & 15, cc = c & 31, ob = rr * 64 + cc * 2; return st * 1024 + (ob ^ (((ob >> 9) & 1) << 5)); }
__host__ __device__ __forceinline__ void stage_rc(int b, int& R, int& C) { const int st = b / 1024, sb = b % 1024, swz = sb ^ (((sb >> 9) & 1) << 5); R = (st >> 1) * 16 + swz / 64; C = (st & 1) * 32 + (swz % 64) / 2; }
__host__ __device__ __forceinline__ int perm32(int rho) { const int n = rho >> 4, i = rho & 15; return 8 * (i >> 2) + 4 * n + (i & 3); }

struct Unit {
    const char* A;
    const char* B;
    const int* rows;
    int nvalid;
    int lda2, ldb2;
    int nt;
    int pm, pn, x0, x1;
};
template <bool GATHER> struct AOff { unsigned v[GATHER ? 4 : 1]; };
template <bool GATHER> __device__ __forceinline__ void unit_rows(const Unit& u, int R0, unsigned (&pk)[2]) {
    if constexpr (GATHER) {
#pragma unroll
        for (int h = 0; h < 2; ++h) { unsigned w = 0;
#pragma unroll
            for (int i = 0; i < 2; ++i) { const int r = h * HALF + R0 + 64 * i; const unsigned row = (r < u.nvalid) ? (unsigned)((const GAS int*)u.rows)[r] : 0u; w |= row << (16 * i); }
            pk[h] = w; }
    } else { pk[0] = 0; pk[1] = 0; }
}

template <class Epi, class Sched, bool GATHER>
__device__ __forceinline__ void gemm_stream(LAS unsigned char* lds, const Sched& S, const Epi& E) {
    int tid = threadIdx.x; asm volatile("" : "+v"(tid));
    const int wid = __builtin_amdgcn_readfirstlane(tid >> 6), lane = tid & 63, wr = wid >> 2, wc = wid & 3, fr = lane & 15, fq = lane >> 4;
    int R0, C0; stage_rc(tid * 16, R0, C0);
    const int Rb0 = Epi::PERM ? ((R0 & ~31) + perm32(R0 & 31)) : R0;
    const unsigned ldsw = (unsigned)wid * 1024u;
    const int aoff = lds_byte(wr * 64 + fr, fq * 8), boff = lds_byte(wc * 32 + fr, fq * 8);
#define G_SA(b, h) (((b) * 2 + (h)) * HTB)
#define G_SB(b, h) ((4 + (b) * 2 + (h)) * HTB)
#define G_STAGE_A(bufoff, gbase, h) do { _Pragma("unroll") for (int _i = 0; _i < 2; ++_i) { \
        const char* _p = GATHER ? ((const char*)(gbase) + vA[(h) * 2 + _i]) : ((const char*)(gbase) + (size_t)((h) * HALF + 64 * _i) * (size_t)ldA + vA[0]); \
        __builtin_amdgcn_global_load_lds((const unsigned*)_p, (LAS unsigned*)(lds + (bufoff) + ldsw + _i * 8192), 16, 0, 0); } } while (0)
#define G_STAGE_B(bufoff, gbase, h) do { _Pragma("unroll") for (int _i = 0; _i < 2; ++_i) \
        __builtin_amdgcn_global_load_lds((const unsigned*)((const char*)(gbase) + (size_t)((h) * HALF + 64 * _i) * (size_t)ldB + vB), (LAS unsigned*)(lds + (bufoff) + ldsw + _i * 8192), 16, 0, 0); } while (0)
#define G_LDA(dst, b, h) do { _Pragma("unroll") for (int m = 0; m < 4; ++m) _Pragma("unroll") for (int k = 0; k < 2; ++k) dst[m][k] = *(const LAS bf16x8*)(lds + G_SA(b, h) + aoff + m * 2048 + k * 1024); } while (0)
#define G_LDB(dst, b, h) do { _Pragma("unroll") for (int n = 0; n < 2; ++n) _Pragma("unroll") for (int k = 0; k < 2; ++k) dst[n][k] = *(const LAS bf16x8*)(lds + G_SB(b, h) + boff + n * 2048 + k * 1024); } while (0)
#define G_MMA(ai, bj, At, Bt) do { __builtin_amdgcn_s_setprio(1); _Pragma("unroll") for (int m = 0; m < 4; ++m) _Pragma("unroll") for (int n = 0; n < 2; ++n) _Pragma("unroll") for (int k = 0; k < 2; ++k) \
        acc[ai][bj][m][n] = __builtin_amdgcn_mfma_f32_16x16x32_bf16(Bt[n][k], At[m][k], acc[ai][bj][m][n], 0, 0, 0); __builtin_amdgcn_s_setprio(0); } while (0)
#define G_WAIT_V(n) asm volatile("s_waitcnt vmcnt(" #n ")" ::: "memory")
#define G_WAIT_L(n) asm volatile("s_waitcnt lgkmcnt(" #n ")" ::: "memory")
#define G_BAR __builtin_amdgcn_s_barrier()
#define G_SCHED __builtin_amdgcn_sched_barrier(0)
#define G_SET_OFFS(u, pk) do { ldA = (u).lda2; ldB = (u).ldb2; vB = (unsigned)Rb0 * (unsigned)ldB + (unsigned)C0 * 2u; \
        if constexpr (GATHER) { vA[0] = ((pk)[0] & 0xffffu) * (unsigned)ldA + (unsigned)C0 * 2u; vA[1] = ((pk)[0] >> 16) * (unsigned)ldA + (unsigned)C0 * 2u; \
                                vA[2] = ((pk)[1] & 0xffffu) * (unsigned)ldA + (unsigned)C0 * 2u; vA[3] = ((pk)[1] >> 16) * (unsigned)ldA + (unsigned)C0 * 2u; } \
        else { vA[0] = (unsigned)R0 * (unsigned)ldA + (unsigned)C0 * 2u; } } while (0)
    Unit cur, nxt; int ui = 0;
    if (!S.next(0, cur)) return;
    unsigned vA[GATHER ? 4 : 1], vB, pk[2]; int ldA, ldB;
    unit_rows<GATHER>(cur, R0, pk);
    G_SET_OFFS(cur, pk);
    f32x4 acc[2][2][4][2];
#pragma unroll
    for (int a = 0; a < 2; ++a)
#pragma unroll
        for (int b = 0; b < 2; ++b)
#pragma unroll
            for (int m = 0; m < 4; ++m)
#pragma unroll
                for (int n = 0; n < 2; ++n) acc[a][b][m][n] = (f32x4){0.f, 0.f, 0.f, 0.f};
    bf16x8 At[4][2], B0[2][2], B1[2][2];
    const char* cA = cur.A; const char* cB = cur.B;
    const size_t kstep = (size_t)(BK * 2);
    G_STAGE_B(G_SB(0, 0), cB, 0); G_STAGE_A(G_SA(0, 0), cA, 0); G_STAGE_B(G_SB(0, 1), cB, 1); G_STAGE_A(G_SA(0, 1), cA, 1);
    if (wr == 1) G_BAR;
    G_WAIT_V(4); G_BAR;
    G_STAGE_B(G_SB(1, 0), cB + kstep, 0); G_STAGE_A(G_SA(1, 0), cA + kstep, 0); G_STAGE_B(G_SB(1, 1), cB + kstep, 1);
    G_WAIT_V(6); G_BAR;
    for (;;) {
        const bool has_next = S.next(ui + 1, nxt);
        if (!has_next) nxt = cur;
        unit_rows<GATHER>(nxt, R0, pk);
        const char* nA = nxt.A; const char* nB = nxt.B;
        const int nt = cur.nt;
        for (int t = 0; t < nt; t += 2) {
            const bool last = (t == nt - 2);
            const char* a1 = cA + (size_t)(t + 1) * kstep;
            const char* a2 = last ? nA : cA + (size_t)(t + 2) * kstep; const char* b2 = last ? nB : cB + (size_t)(t + 2) * kstep;
            const char* a3 = a2 + kstep; const char* b3 = b2 + kstep;
            G_LDB(B0, 0, 0); G_SCHED; G_LDA(At, 0, 0); G_STAGE_A(G_SA(1, 1), a1, 1);
            if (last) { G_SET_OFFS(nxt, pk); }
            G_WAIT_L(8); G_BAR; G_WAIT_L(0); G_MMA(0, 0, At, B0); G_BAR; G_SCHED;
            G_LDB(B1, 0, 1); G_STAGE_B(G_SB(0, 0), b2, 0);
            G_BAR; G_WAIT_L(0); G_MMA(0, 1, At, B1); G_BAR;
            G_LDA(At, 0, 1); G_STAGE_A(G_SA(0, 0), a2, 0);
            G_BAR; G_WAIT_L(0); G_MMA(1, 0, At, B0); G_BAR; G_SCHED;
            G_STAGE_B(G_SB(0, 1), b2, 1);
            G_WAIT_V(6); G_BAR; G_MMA(1, 1, At, B1); G_BAR;
            G_LDB(B0, 1, 0); G_SCHED; G_LDA(At, 1, 0); G_STAGE_A(G_SA(0, 1), a2, 1);
            G_WAIT_L(8); G_BAR; G_WAIT_L(0); G_MMA(0, 0, At, B0); G_BAR; G_SCHED;
            G_LDB(B1, 1, 1); G_STAGE_B(G_SB(1, 0), b3, 0);
            G_BAR; G_WAIT_L(0); G_MMA(0, 1, At, B1); G_BAR;
            G_LDA(At, 1, 1); G_STAGE_A(G_SA(1, 0), a3, 0);
            G_BAR; G_WAIT_L(0); G_MMA(1, 0, At, B0); G_BAR; G_SCHED;
            G_STAGE_B(G_SB(1, 1), b3, 1);
            G_WAIT_V(6); G_BAR; G_MMA(1, 1, At, B1); G_BAR;
        }
        E(acc, cur, wr, wc, fr, fq);
        if (!has_next) break;
#pragma unroll
        for (int a = 0; a < 2; ++a)
#pragma unroll
            for (int b = 0; b < 2; ++b)
#pragma unroll
                for (int m = 0; m < 4; ++m)
#pragma unroll
                    for (int n = 0; n < 2; ++n) acc[a][b][m][n] = (f32x4){0.f, 0.f, 0.f, 0.f};
        cur = nxt; cA = nA; cB = nB; ++ui;
    }
    G_WAIT_V(0);
    if (wr == 0) G_BAR;
    G_BAR;
#undef G_SA
#undef G_SB
#undef G_STAGE_A
#undef G_STAGE_B
#undef G_LDA
#undef G_LDB
#undef G_MMA
#undef G_WAIT_V
#undef G_WAIT_L
#undef G_BAR
#undef G_SCHED
#undef G_SET_OFFS
}

__device__ __forceinline__ unsigned cvt_pk_bf16(float lo, float hi) { unsigned r; asm volatile("v_cvt_pk_bf16_f32 %0, %1, %2" : "=v"(r) : "v"(lo), "v"(hi)); return r; }

struct DenseSched {
    const char* A; const char* B; int lda2, ldb2, nt, nM, nN, G, c;
    __device__ __forceinline__ bool next(int i, Unit& u) const {
        const int Lx = i * G + c; if (Lx >= nM * nN) return false;
        const int pm = Lx / nN, pn = Lx % nN;
        u.A = A + (size_t)pm * BM * lda2; u.B = B + (size_t)pn * BM * ldb2; u.rows = nullptr; u.nvalid = 0; u.lda2 = lda2; u.ldb2 = ldb2; u.nt = nt; u.pm = pm; u.pn = pn; u.x0 = 0; u.x1 = 0; return true;
    }
};
}
namespace fk {
constexpr int RING_OFF = 0, RING_BYTES = STAGE_BYTES;
constexpr int MISC_OFF = RING_BYTES;
constexpr int LDS_BYTES = RING_BYTES + 1024;
struct Args { const float* in[54]; float* out; unsigned char* ws; int ph_lo, ph_hi, li, comb; };

struct Frame {
    LAS unsigned char* lds; volatile LAS unsigned* MISC;
    int tid, lane, wave, G, c;
    unsigned* ctl; unsigned char* ws;
};

__device__ __forceinline__ void transpose_item(const float* W, int ldw, int k0, int n0, bf16* dst, int ldd, LAS float* scr, int lane) {
#pragma unroll 8
    for (int i = 0; i < 32; ++i) { const int kk = 2 * i + (lane >> 5); scr[kk * 33 + (lane & 31)] = W[(size_t)(k0 + kk) * ldw + n0 + (lane & 31)]; }
    LDS_WAIT(); asm volatile("" ::: "memory");
    const int c = lane & 7;
#pragma unroll
    for (int j = 0; j < 4; ++j) { const int n = (lane >> 3) + 8 * j; const LAS float* s = scr + (8 * c) * 33 + n;
        v4u o; o.x = pk2(s[0 * 33], s[1 * 33]); o.y = pk2(s[2 * 33], s[3 * 33]); o.z = pk2(s[4 * 33], s[5 * 33]); o.w = pk2(s[6 * 33], s[7 * 33]);
        *(GAS v4u*)(dst + (size_t)n * ldd + 8 * c) = o; }
    LDS_WAIT(); asm volatile("" ::: "memory");
}

__device__ __forceinline__ void moe_convert(Frame& F, const Args& a, int l) {
    PHASE_IDS();
    LAS float* scr = (LAS float*)(F.lds + RING_OFF + wave * 16384);
    bf16* Wgu = (bf16*)(wsl + WS_WMOE); bf16* Wd = Wgu + (size_t)16 * 1024 * 1024;
    const float* wg = a.in[51] + (size_t)l * 16 * D * 512; const float* wu = a.in[52] + (size_t)l * 16 * D * 512; const float* wd = a.in[53] + (size_t)l * 16 * 512 * D;
    const int gw = F.c * NWAVES + wave, NGW = F.G * NWAVES;
    for (int it = gw; it < 3 * 4096; it += NGW) {
        const int which = it >> 12, r = it & 4095, e = r >> 8, q = r & 255;
        if (which < 2) { const int kb = q >> 4, nb = q & 15, k0 = kb * 64, n0 = nb * 32;
            const float* W = (which == 0 ? wg : wu) + (size_t)e * D * 512;
            bf16* dst = Wgu + ((size_t)e * 1024 + (n0 >> 7) * 256 + which * 128 + (n0 & 127)) * 1024 + k0;
            transpose_item(W, 512, k0, n0, dst, 1024, scr, lane);
        } else { const int kb = q >> 5, nb = q & 31, k0 = kb * 64, n0 = nb * 32;
            const float* W = wd + (size_t)e * 512 * D;
            bf16* dst = Wd + ((size_t)e * 1024 + n0) * 512 + k0;
            transpose_item(W, 1024, k0, n0, dst, 512, scr, lane);
        }
    }
}

__device__ __forceinline__ void moe_route(Frame& F, const Args& a, int l) {
    PHASE_IDS();
    LAS float* wt = (LAS float*)(F.lds + RING_OFF);
    const float* wg = a.in[47] + (size_t)l * D * 4; const float* we = a.in[49] + (size_t)l * D * 16;
    for (int i = tid; i < D * 4; i += NT) { const int d = i >> 2, q = i & 3; wt[q * 1024 + d] = wg[i]; }
    for (int i = tid; i < D * 16; i += NT) { const int d = i >> 4, q = i & 15; wt[(4 + q) * 1024 + d] = we[i]; }
    __syncthreads();
    const float* gain = a.in[3] + l * D; const float* bg = a.in[48] + l * 4; const float* be = a.in[50] + l * 16;
    f32x4 g[4];
#pragma unroll
    for (int j = 0; j < 4; ++j) g[j] = *(const f32x4*)(gain + 256 * j + 4 * lane);
    const float* H = (const float*)(wsl + WS_H); bf16* XN = (bf16*)(wsl + WS_ACT + A_XN);
    int* list = (int*)(wsl + WS_ACT + A_LIST); float* listw = (float*)(wsl + WS_ACT + A_LISTW); int* listd = (int*)(wsl + WS_ACT + A_LISTD);
    unsigned* cnt = F.ctl + CW_CNT + 64 * l;
    const int gw = F.c * NWAVES + wave, NGW = F.G * NWAVES;
    for (int row = gw; row < TP; row += NGW) {
        if ((row % LP) < PRE) continue;
        const GAS f32x4* hr = (const GAS f32x4*)(H + (size_t)row * D) + lane;
        f32x4 v[4]; float ss = 0.f;
#pragma unroll
        for (int j = 0; j < 4; ++j) { v[j] = hr[64 * j]; ss += (v[j].x * v[j].x + v[j].y * v[j].y) + (v[j].z * v[j].z + v[j].w * v[j].w); }
        const float rs = rsqrtf(wave_sum(ss) * (1.f / D) + RMS_EPS);
#pragma unroll
        for (int j = 0; j < 4; ++j) v[j] = v[j] * rs * g[j];
        GAS v2u* o8 = (GAS v2u*)(XN + (size_t)row * D) + lane;
#pragma unroll
        for (int j = 0; j < 4; ++j) { v2u w; w.x = pk2(v[j].x, v[j].y); w.y = pk2(v[j].z, v[j].w); o8[64 * j] = w; }
        float acc[20];
#pragma unroll
        for (int q = 0; q < 20; ++q) { float s = 0.f;
#pragma unroll
            for (int j = 0; j < 4; ++j) { const f32x4 w = *(const LAS f32x4*)(wt + q * 1024 + 256 * j + 4 * lane); s += (v[j].x * w.x + v[j].y * w.y) + (v[j].z * w.z + v[j].w * w.w); }
            acc[q] = wave_sum(s); }
        if (lane < 2) {
            float lg[4]; int gi = 0; float mx = -3.0e38f;
#pragma unroll
            for (int q = 0; q < 4; ++q) { lg[q] = acc[q] + bg[q]; if (lg[q] > mx) { mx = lg[q]; gi = q; } }
            float den = 0.f;
#pragma unroll
            for (int q = 0; q < 4; ++q) den += __expf(lg[q] - mx);
            const float pg = 1.f / den;
            float le[4];
#pragma unroll
            for (int q = 0; q < 4; ++q) { float s = 0.f;
#pragma unroll
                for (int gq = 0; gq < 4; ++gq) s = (gq == gi) ? (acc[4 + gq * 4 + q] + be[gq * 4 + q]) : s;
                le[q] = s; }
            int i1 = 0; float v1 = le[0];
#pragma unroll
            for (int q = 1; q < 4; ++q) if (le[q] > v1) { v1 = le[q]; i1 = q; }
            int i2 = 0; float v2 = -3.0e38f;
#pragma unroll
            for (int q = 0; q < 4; ++q) if (q != i1 && le[q] > v2) { v2 = le[q]; i2 = q; }
            const float e2 = __expf(v2 - v1), s1 = 1.f / (1.f + e2), s2 = e2 / (1.f + e2);
            const int k = lane; const int e = gi * 4 + (k == 0 ? i1 : i2); const float gt = (k == 0 ? s1 : s2) * pg;
            const unsigned pos = __hip_atomic_fetch_add(cnt + e, 1u, __ATOMIC_RELAXED, __HIP_MEMORY_SCOPE_AGENT);
            list[(size_t)e * LISTCAP + pos] = row; listw[(size_t)e * LISTCAP + pos] = gt; listd[(size_t)e * LISTCAP + pos] = row * 2 + k;
        }
    }
}

struct MoeSched {
    volatile LAS unsigned* tb;
    const char* A; const char* B; const int* list; int lda2, ldb2, nt, G, c, gather;
    __device__ __forceinline__ bool next(int i, Unit& u) const {
        const int Lx = i * G + c; const int ntot = __builtin_amdgcn_readfirstlane((int)tb[16]);
        if (Lx >= ntot * 4) return false;
        const int mt = Lx >> 2, pn = Lx & 3; int e = 0;
#pragma unroll
        for (int q = 1; q < 16; ++q) e = (__builtin_amdgcn_readfirstlane((int)tb[q]) <= mt) ? q : e;
        const int ti = mt - __builtin_amdgcn_readfirstlane((int)tb[e]); const int cn = __builtin_amdgcn_readfirstlane((int)tb[17 + e]) - ti * 256;
        u.nvalid = cn < 256 ? cn : 256; u.x0 = e; u.x1 = ti; u.pm = mt; u.pn = pn; u.lda2 = lda2; u.ldb2 = ldb2; u.nt = nt;
        u.B = B + ((size_t)e * 1024 + (size_t)pn * 256) * ldb2;
        if (gather) { u.A = A; u.rows = list + (size_t)e * LISTCAP + ti * 256; }
        else { u.A = A + (size_t)mt * 256 * lda2; u.rows = nullptr; }
        return true;
    }
};
__device__ __forceinline__ void moe_tables(Frame& F, int l) {
    PHASE_IDS();
    volatile LAS unsigned* tb = F.MISC + 64;
    __syncthreads();
    if (tid == 0) { unsigned s = 0;
        for (int e = 0; e < 16; ++e) { const unsigned cn = __hip_atomic_load(F.ctl + CW_CNT + 64 * l + e, __ATOMIC_RELAXED, __HIP_MEMORY_SCOPE_AGENT); tb[e] = s; tb[17 + e] = cn; s += (cn + 255u) >> 8; }
        tb[16] = s; }
    __syncthreads();
}
struct EpiSwiglu {
    static constexpr bool PERM = true;
    bf16* hid; const float* listw;
    __device__ __forceinline__ void operator()(const f32x4 (&acc)[2][2][4][2], const Unit& u, int wr, int wc, int fr, int fq) const {
        const GAS float* lw = (const GAS float*)listw + (size_t)u.x0 * LISTCAP + u.x1 * 256;
        asm volatile("" : "+v"(fr));
        GAS unsigned char* hb = (GAS unsigned char*)hid + ((size_t)u.pm * 256 * 512 + u.pn * 128 + wc * 32) * 2;
#pragma unroll
        for (int ai = 0; ai < 2; ++ai)
#pragma unroll
            for (int m = 0; m < 4; ++m) {
                const int r = ai * HALF + wr * 64 + m * 16 + fr;
                const float cw = (r < u.nvalid) ? lw[r] : 0.f;
                float o[8];
#pragma unroll
                for (int n = 0; n < 2; ++n)
#pragma unroll
                    for (int q = 0; q < 4; ++q) { const float gv = acc[ai][0][m][n][q], uv = acc[ai][1][m][n][q]; o[n * 4 + q] = gv * sigmoid_f(gv) * uv * cw; }
                v4u w; w.x = cvt_pk_bf16(o[0], o[1]); w.y = cvt_pk_bf16(o[2], o[3]); w.z = cvt_pk_bf16(o[4], o[5]); w.w = cvt_pk_bf16(o[6], o[7]);
                *(GAS v4u*)(hb + (unsigned)(r * 1024 + fq * 16)) = w;
            }
    }
};
struct EpiScatter {
    static constexpr bool PERM = true;
    bf16* O; const int* listd;
    __device__ __forceinline__ void operator()(const f32x4 (&acc)[2][2][4][2], const Unit& u, int wr, int wc, int fr, int fq) const {
        const GAS int* ld = (const GAS int*)listd + (size_t)u.x0 * LISTCAP + u.x1 * 256;
        asm volatile("" : "+v"(fr));
        GAS unsigned char* ob = (GAS unsigned char*)O + (size_t)(u.pn * 256 + wc * 32) * 2;
#pragma unroll
        for (int ai = 0; ai < 2; ++ai)
#pragma unroll
            for (int m = 0; m < 4; ++m) {
                const int r = ai * HALF + wr * 64 + m * 16 + fr;
                if (r < u.nvalid) { const int dst = ld[r];
#pragma unroll
                    for (int bj = 0; bj < 2; ++bj) { const f32x4 v0 = acc[ai][bj][m][0], v1 = acc[ai][bj][m][1];
                        v4u w; w.x = cvt_pk_bf16(v0[0], v0[1]); w.y = cvt_pk_bf16(v0[2], v0[3]); w.z = cvt_pk_bf16(v1[0], v1[1]); w.w = cvt_pk_bf16(v1[2], v1[3]);
                        *(GAS v4u*)(ob + ((unsigned)dst * 2048u + (unsigned)(bj * 256 + fq * 16))) = w; } }
            }
    }
};

}
namespace fk {
constexpr size_t KiB = 1024;
constexpr size_t WM_AB_STRIDE = 14 * MiB;
constexpr size_t WM_WIN = 0;
constexpr size_t WM_WGLU = 3 * MiB;
constexpr size_t WM_WOUT = 3 * MiB + 512 * KiB;
constexpr size_t WM_LRUW = 5 * MiB + 512 * KiB;
constexpr size_t WM_APW = 5 * MiB + 768 * KiB;
constexpr size_t WM_BX = 6 * MiB;
constexpr size_t WM_TC = 8 * MiB;
constexpr size_t WM_RW = 28 * MiB;
constexpr size_t B_HN = 0;
constexpr size_t B_Z = B_HN + (size_t)TP * D * 2;
constexpr size_t B_YS = B_Z + (size_t)TP * 1536 * 2;
constexpr size_t B_CAT = B_YS + (size_t)TP * 512 * 2;
constexpr size_t B_SSA = B_CAT + (size_t)TP * D * 2;
constexpr size_t B_SSB = B_SSA + (size_t)TP * 8 * 4;
constexpr size_t B_END = B_SSB + (size_t)TP * 32 * 4;
static_assert(B_END <= ACT_BYTES, "AB activations fit");

__device__ __forceinline__ void s5_precompute(Frame& F, const Args& a, int j, int g) {
    PHASE_IDS();
    LAS f32x2* pw = (LAS f32x2*)(F.lds + RING_OFF);
    LAS f32x2* bbar = pw + 17 * 64;
    LAS f32x2* cc = bbar + 64 * 16;
    LAS float* Kl = (LAS float*)(cc + 16 * 64);
    unsigned char* wm = wsl + WS_WMIX + (size_t)j * WM_AB_STRIDE;
    __syncthreads();
    if (tid < 64) { const int p = tid;
        const float lr = a.in[9][(j * 32 + g) * 64 + p], li = a.in[10][(j * 32 + g) * 64 + p], dt = expf(a.in[11][j * 32 + g]);
#pragma unroll 1
        for (int lag = 0; lag <= 16; ++lag) { const float m = expf((float)lag * lr * dt); pw[lag * 64 + p] = (f32x2){m * cosf((float)lag * li * dt), m * sinf((float)lag * li * dt)}; }
        const float mag = expf(lr * dt), ar = mag * cosf(li * dt), ai = mag * sinf(li * dt), den = lr * lr + li * li;
        const float zr = ((ar - 1.f) * lr + ai * li) / den, zi = (ai * lr - (ar - 1.f) * li) / den;
        const float* bre = a.in[12] + ((size_t)(j * 32 + g) * 64 + p) * 16; const float* bim = a.in[13] + ((size_t)(j * 32 + g) * 64 + p) * 16;
#pragma unroll 1
        for (int h = 0; h < 16; ++h) { const float br = bre[h], bi = bim[h]; bbar[p * 16 + h] = (f32x2){zr * br - zi * bi, zr * bi + zi * br}; }
    }
    for (int i = tid; i < 1024; i += NT) cc[i] = (f32x2){a.in[14][(size_t)(j * 32 + g) * 1024 + i], a.in[15][(size_t)(j * 32 + g) * 1024 + i]};
    __syncthreads();
    if (tid < 64) ((f32x2*)(wm + WM_APW))[g * 64 + tid] = pw[16 * 64 + tid];
    for (int i = tid; i < 4096; i += NT) { const int lag = i >> 8, h = (i >> 4) & 15, hp = i & 15; float s = 0.f;
        for (int p = 0; p < 64; ++p) { const f32x2 w = pw[lag * 64 + p], bb = bbar[p * 16 + hp], c = cc[h * 64 + p];
            const float wr_ = w.x * bb.x - w.y * bb.y, wi_ = w.x * bb.y + w.y * bb.x; s += c.x * wr_ - c.y * wi_; }
        if (lag == 0 && h == hp) s += a.in[16][(j * 32 + g) * 16 + h];
        Kl[i] = s; }
    __syncthreads();
    bf16* TC = (bf16*)(wm + WM_TC) + (size_t)g * 256 * 384; bf16* BX = (bf16*)(wm + WM_BX) + (size_t)g * 128 * 256;
    for (int i = tid; i < 256 * 48; i += NT) { const int n = i / 48, ko = i % 48, t = n >> 4, h = n & 15; float v[8];
        if (ko < 32) { const int s = ko >> 1, hp0 = (ko & 1) * 8;
#pragma unroll
            for (int q = 0; q < 8; ++q) v[q] = (s <= t) ? Kl[((t - s) * 16 + h) * 16 + hp0 + q] : 0.f;
        } else { const int p0 = (ko - 32) * 4;
#pragma unroll
            for (int q = 0; q < 4; ++q) { const f32x2 c = cc[h * 64 + p0 + q], w = pw[(t + 1) * 64 + p0 + q]; v[2 * q] = c.x * w.x - c.y * w.y; v[2 * q + 1] = -(c.x * w.y + c.y * w.x); } }
        v4u o; o.x = pk2(v[0], v[1]); o.y = pk2(v[2], v[3]); o.z = pk2(v[4], v[5]); o.w = pk2(v[6], v[7]);
        *(GAS v4u*)(TC + (size_t)n * 384 + ko * 8) = o; }
    for (int i = tid; i < 128 * 32; i += NT) { const int n = i >> 5, ko = i & 31, p = n >> 1, im = n & 1, s = ko >> 1, hp0 = (ko & 1) * 8; float v[8];
        const f32x2 w = pw[(15 - s) * 64 + p];
#pragma unroll
        for (int q = 0; q < 8; ++q) { const f32x2 bb = bbar[p * 16 + hp0 + q]; v[q] = im ? (w.x * bb.y + w.y * bb.x) : (w.x * bb.x - w.y * bb.y); }
        v4u o; o.x = pk2(v[0], v[1]); o.y = pk2(v[2], v[3]); o.z = pk2(v[4], v[5]); o.w = pk2(v[6], v[7]);
        *(GAS v4u*)(BX + (size_t)n * 256 + ko * 8) = o; }
    __syncthreads();
}

__device__ __forceinline__ void prologue_ab(Frame& F, const Args& a) {
    PHASE_IDS();
    const int gw = F.c * NWAVES + wave, NGW = F.G * NWAVES;
    float* H = (float*)(wsl + WS_H);
    for (int row = gw; row < TP; row += NGW) { const int b = row / LP, t = row % LP - PRE;
        GAS f32x4* o = (GAS f32x4*)(H + (size_t)row * D) + lane;
        if (t < 0) {
#pragma unroll
            for (int q = 0; q < 4; ++q) o[64 * q] = (f32x4){0.f, 0.f, 0.f, 0.f};
        } else { const float* src = t < NMETA ? a.in[1] + (size_t)t * D : a.in[0] + ((size_t)b * SEQ + (t - NMETA)) * D;
#pragma unroll
            for (int q = 0; q < 4; ++q) o[64 * q] = ((const GAS f32x4*)src)[64 * q + lane]; } }
    LAS float* scr = (LAS float*)(F.lds + RING_OFF + wave * 16384);
    constexpr int I_IN = 16 * 48, I_GLU = 8 * 16, I_OUT = 16 * 32, I_LRU = 32, I_AB = I_IN + I_GLU + I_OUT + I_LRU;
    for (int it = gw; it < 2 * I_AB; it += NGW) { const int j = it / I_AB; int r = it % I_AB; unsigned char* wm = wsl + WS_WMIX + (size_t)j * WM_AB_STRIDE;
        if (r < I_IN) { const int kb = r / 48, nb = r % 48; transpose_item(a.in[5] + (size_t)j * D * 1536, 1536, kb * 64, nb * 32, (bf16*)(wm + WM_WIN) + (size_t)nb * 32 * 1024 + kb * 64, 1024, scr, lane); continue; } r -= I_IN;
        if (r < I_GLU) { const int kb = r / 16, nb = r % 16; transpose_item(a.in[17] + (size_t)j * 512 * 512, 512, kb * 64, nb * 32, (bf16*)(wm + WM_WGLU) + (size_t)nb * 32 * 512 + kb * 64, 512, scr, lane); continue; } r -= I_GLU;
        if (r < I_OUT) { const int kb = r / 32, nb = r % 32; transpose_item(a.in[6] + (size_t)j * D * D, 1024, kb * 64, nb * 32, (bf16*)(wm + WM_WOUT) + (size_t)nb * 32 * 1024 + kb * 64, 1024, scr, lane); continue; } r -= I_OUT;
        { const int hd = r >> 2, which = (r >> 1) & 1, nb = r & 1;
          transpose_item(a.in[which ? 23 : 21] + (size_t)(j * 8 + hd) * 4096, 64, 0, nb * 32, (bf16*)(wm + WM_LRUW) + ((size_t)hd * 128 + which * 64 + nb * 32) * 64, 64, scr, lane); }
    }
    __syncthreads();
    for (int u = F.c; u < 64; u += F.G) s5_precompute(F, a, u >> 5, u & 31);
}

__device__ __forceinline__ float load_row(const float* H, const bf16* O, int row, int has_o, int lane, f32x4 (&v)[4]) {
    const GAS f32x4* hr = (const GAS f32x4*)(H + (size_t)row * D) + lane; float ss = 0.f;
#pragma unroll
    for (int q = 0; q < 4; ++q) v[q] = hr[64 * q];
    if (has_o) { const GAS v2u* o0 = (const GAS v2u*)(O + (size_t)row * 2 * D) + lane; const GAS v2u* o1 = o0 + 256;
#pragma unroll
        for (int q = 0; q < 4; ++q) { const v2u x = o0[64 * q], y = o1[64 * q];
            v[q].x += bflo(x.x) + bflo(y.x); v[q].y += bfhi(x.x) + bfhi(y.x); v[q].z += bflo(x.y) + bflo(y.y); v[q].w += bfhi(x.y) + bfhi(y.y); } }
#pragma unroll
    for (int q = 0; q < 4; ++q) ss += (v[q].x * v[q].x + v[q].y * v[q].y) + (v[q].z * v[q].z + v[q].w * v[q].w);
    return rsqrtf(wave_sum(ss) * (1.f / D) + RMS_EPS);
}
__device__ __forceinline__ void pass_norm(Frame& F, const float* gain, int has_o, bf16* out) {
    PHASE_IDS();
    const int gw = F.c * NWAVES + wave, NGW = F.G * NWAVES;
    f32x4 g[4];
#pragma unroll
    for (int q = 0; q < 4; ++q) g[q] = *(const GAS f32x4*)(gain + 256 * q + 4 * lane);
    const float* H = (const float*)(wsl + WS_H); const bf16* O = (const bf16*)(wsl + WS_O);
    for (int row = gw; row < TP; row += NGW) {
        GAS v2u* o8 = (GAS v2u*)(out + (size_t)row * D) + lane;
        if ((row % LP) < PRE) {
#pragma unroll
            for (int q = 0; q < 4; ++q) o8[64 * q] = (v2u){0u, 0u};
            continue; }
        f32x4 v[4]; const float rs = load_row(H, O, row, has_o, lane, v);
#pragma unroll
        for (int q = 0; q < 4; ++q) { const f32x4 x = v[q] * rs * g[q]; v2u w; w.x = pk2(x.x, x.y); w.y = pk2(x.z, x.w); o8[64 * q] = w; }
    }
}
__device__ __forceinline__ void pass_final(Frame& F, const float* gain, float* out) {
    PHASE_IDS();
    const int gw = F.c * NWAVES + wave, NGW = F.G * NWAVES;
    f32x4 g[4];
#pragma unroll
    for (int q = 0; q < 4; ++q) g[q] = *(const GAS f32x4*)(gain + 256 * q + 4 * lane);
    const float* H = (const float*)(wsl + WS_H); const bf16* O = (const bf16*)(wsl + WS_O);
    for (int r = gw; r < NB * SEQ; r += NGW) { const int b = r / SEQ, s = r % SEQ, row = b * LP + PRE + NMETA + s;
        f32x4 v[4]; const float rs = load_row(H, O, row, 1, lane, v);
        GAS f32x4* o = (GAS f32x4*)(out + (size_t)r * D) + lane;
#pragma unroll
        for (int q = 0; q < 4; ++q) o[64 * q] = v[q] * rs * g[q];
    }
}

struct EpiBf16 {
    static constexpr bool PERM = true;
    bf16* O; int ldo;
    __device__ __forceinline__ void operator()(const f32x4 (&acc)[2][2][4][2], const Unit& u, int wr, int wc, int fr, int fq) const {
        asm volatile("" : "+v"(fr));
        GAS unsigned char* ob = (GAS unsigned char*)O + ((size_t)u.pm * 256 * ldo + u.pn * 256 + wc * 32) * 2;
#pragma unroll
        for (int ai = 0; ai < 2; ++ai)
#pragma unroll
            for (int m = 0; m < 4; ++m) { const int r = ai * HALF + wr * 64 + m * 16 + fr;
#pragma unroll
                for (int bj = 0; bj < 2; ++bj) { const f32x4 v0 = acc[ai][bj][m][0], v1 = acc[ai][bj][m][1];
                    v4u w; w.x = cvt_pk_bf16(v0[0], v0[1]); w.y = cvt_pk_bf16(v0[2], v0[3]); w.z = cvt_pk_bf16(v1[0], v1[1]); w.w = cvt_pk_bf16(v1[2], v1[3]);
                    *(GAS v4u*)(ob + ((unsigned)r * (unsigned)ldo * 2u + (unsigned)(bj * 256 + fq * 16))) = w; } }
    }
};
struct EpiGlu {
    static constexpr bool PERM = true;
    const bf16* YS; bf16* CAT; const float* bglu; float* SSA;
    __device__ __forceinline__ void operator()(const f32x4 (&acc)[2][2][4][2], const Unit& u, int wr, int wc, int fr, int fq) const {
        asm volatile("" : "+v"(fr));
        f32x4 bv[2][2];
#pragma unroll
        for (int bj = 0; bj < 2; ++bj)
#pragma unroll
            for (int n = 0; n < 2; ++n) bv[bj][n] = *(const GAS f32x4*)(bglu + u.pn * 256 + bj * HALF + wc * 32 + fq * 8 + 4 * n);
#pragma unroll
        for (int ai = 0; ai < 2; ++ai)
#pragma unroll
            for (int m = 0; m < 4; ++m) { const int r = ai * HALF + wr * 64 + m * 16 + fr; const size_t row = (size_t)u.pm * 256 + r; float ss = 0.f;
#pragma unroll
                for (int bj = 0; bj < 2; ++bj) { const int col = u.pn * 256 + bj * HALF + wc * 32 + fq * 8;
                    const v4u y = *(const GAS v4u*)(YS + row * 512 + col); const f32x4 v0 = acc[ai][bj][m][0] + bv[bj][0], v1 = acc[ai][bj][m][1] + bv[bj][1];
                    float o[8]; o[0] = bflo(y.x) * sigmoid_f(v0[0]); o[1] = bfhi(y.x) * sigmoid_f(v0[1]); o[2] = bflo(y.y) * sigmoid_f(v0[2]); o[3] = bfhi(y.y) * sigmoid_f(v0[3]);
                    o[4] = bflo(y.z) * sigmoid_f(v1[0]); o[5] = bfhi(y.z) * sigmoid_f(v1[1]); o[6] = bflo(y.w) * sigmoid_f(v1[2]); o[7] = bfhi(y.w) * sigmoid_f(v1[3]);
#pragma unroll
                    for (int q = 0; q < 8; ++q) ss += o[q] * o[q];
                    v4u w; w.x = cvt_pk_bf16(o[0], o[1]); w.y = cvt_pk_bf16(o[2], o[3]); w.z = cvt_pk_bf16(o[4], o[5]); w.w = cvt_pk_bf16(o[6], o[7]);
                    *(GAS v4u*)(CAT + row * 1024 + col) = w; }
                ss += __shfl_xor(ss, 16); ss += __shfl_xor(ss, 32);
                if (fq == 0) ((GAS float*)SSA)[row * 8 + u.pn * 4 + wc] = ss; }
    }
};
struct EpiResid {
    static constexpr bool PERM = false;
    float* H; const bf16* O; int has_o;
    __device__ __forceinline__ void operator()(const f32x4 (&acc)[2][2][4][2], const Unit& u, int wr, int wc, int fr, int fq) const {
        asm volatile("" : "+v"(fr));
#pragma unroll
        for (int ai = 0; ai < 2; ++ai)
#pragma unroll
            for (int m = 0; m < 4; ++m) { const size_t row = (size_t)u.pm * 256 + ai * HALF + wr * 64 + m * 16 + fr;
#pragma unroll
                for (int bj = 0; bj < 2; ++bj)
#pragma unroll
                    for (int n = 0; n < 2; ++n) { const int col = u.pn * 256 + bj * HALF + wc * 32 + n * 16 + fq * 4;
                        GAS f32x4* hp = (GAS f32x4*)(H + row * D + col); f32x4 v = *hp + acc[ai][bj][m][n];
                        if (has_o) { const v2u x = *(const GAS v2u*)(O + row * 2 * D + col), y = *(const GAS v2u*)(O + row * 2 * D + D + col);
                            v.x += bflo(x.x) + bflo(y.x); v.y += bfhi(x.x) + bfhi(y.x); v.z += bflo(x.y) + bflo(y.y); v.w += bfhi(x.y) + bfhi(y.y); }
                        *hp = v; } }
    }
};

constexpr int S5_UP = 264, S5_XP = 136;
__device__ __forceinline__ void s5_unit(Frame& F, int j, int b, int g) {
    PHASE_IDS();
    const int fr = lane & 15, fq = lane >> 4;
    LAS bf16* Uc = (LAS bf16*)(F.lds + RING_OFF); LAS bf16* EX = Uc + 144 * S5_UP;
    const unsigned char* wm = wsl + WS_WMIX + (size_t)j * WM_AB_STRIDE;
    const bf16* Z = (const bf16*)(wsl + WS_ACT + B_Z); bf16* YS = (bf16*)(wsl + WS_ACT + B_YS);
    const bf16* BX = (const bf16*)(wm + WM_BX) + (size_t)g * 128 * 256; const bf16* TC = (const bf16*)(wm + WM_TC) + (size_t)g * 256 * 384;
    const size_t row0 = (size_t)b * LP + PRE;
    __syncthreads();
    for (int i = tid; i < L * 2; i += NT) { const int t = i >> 1, hf = i & 1;
        const v4u x = *(const GAS v4u*)(Z + (row0 + t) * 1536 + g * 16 + hf * 8);
        *(LAS v4u*)(Uc + (t >> 4) * S5_UP + (t & 15) * 16 + hf * 8) = x; }
    __syncthreads();
    {
        f32x4 acc[9];
#pragma unroll
        for (int mt = 0; mt < 9; ++mt) acc[mt] = (f32x4){0.f, 0.f, 0.f, 0.f};
#pragma unroll 2
        for (int ks = 0; ks < 8; ++ks) { const bf16x8 bf = *(const GAS bf16x8*)(BX + (size_t)(16 * wave + fr) * 256 + 32 * ks + 8 * fq);
#pragma unroll
            for (int mt = 0; mt < 9; ++mt) { const bf16x8 af = *(const LAS bf16x8*)(Uc + (16 * mt + fr) * S5_UP + 32 * ks + 8 * fq); acc[mt] = __builtin_amdgcn_mfma_f32_16x16x32_bf16(bf, af, acc[mt], 0, 0, 0); } }
#pragma unroll
        for (int mt = 0; mt < 9; ++mt) { v2u w; w.x = pk2(acc[mt][0], acc[mt][1]); w.y = pk2(acc[mt][2], acc[mt][3]); *(LAS v2u*)(EX + (16 * mt + fr) * S5_XP + 16 * wave + 4 * fq) = w; }
    }
    __syncthreads();
    if (tid < 64) {
        const f32x2 A = ((const GAS f32x2*)(wm + WM_APW))[g * 64 + tid]; float xr = 0.f, xi = 0.f;
        LAS unsigned* ex = (LAS unsigned*)EX + tid;
#pragma unroll 4
        for (int c = 0; c < 129; ++c) { const unsigned e = ex[c * (S5_XP / 2)]; ex[c * (S5_XP / 2)] = pk2(xr, xi);
            const float er = bflo(e), ei = bfhi(e); const float nr = A.x * xr - A.y * xi + er, ni = A.x * xi + A.y * xr + ei; xr = nr; xi = ni; }
    }
    __syncthreads();
    {
        f32x4 acc[2][9];
#pragma unroll
        for (int nt = 0; nt < 2; ++nt)
#pragma unroll
            for (int mt = 0; mt < 9; ++mt) acc[nt][mt] = (f32x4){0.f, 0.f, 0.f, 0.f};
#pragma unroll 2
        for (int ks = 0; ks < 12; ++ks) {
            bf16x8 bf[2];
#pragma unroll
            for (int nt = 0; nt < 2; ++nt) bf[nt] = *(const GAS bf16x8*)(TC + (size_t)(16 * (2 * wave + nt) + fr) * 384 + 32 * ks + 8 * fq);
#pragma unroll
            for (int mt = 0; mt < 9; ++mt) { const bf16x8 af = (ks < 8) ? *(const LAS bf16x8*)(Uc + (16 * mt + fr) * S5_UP + 32 * ks + 8 * fq) : *(const LAS bf16x8*)(EX + (16 * mt + fr) * S5_XP + 32 * (ks - 8) + 8 * fq);
#pragma unroll
                for (int nt = 0; nt < 2; ++nt) acc[nt][mt] = __builtin_amdgcn_mfma_f32_16x16x32_bf16(bf[nt], af, acc[nt][mt], 0, 0, 0); } }
#pragma unroll
        for (int nt = 0; nt < 2; ++nt)
#pragma unroll
            for (int mt = 0; mt < 9; ++mt) { const int c = 16 * mt + fr, tt = 16 * c + 2 * wave + nt;
                if (tt < L) { const f32x4 y = acc[nt][mt]; v2u w; w.x = pk2(gelu_tanh_f(y[0]), gelu_tanh_f(y[1])); w.y = pk2(gelu_tanh_f(y[2]), gelu_tanh_f(y[3]));
                    *(GAS v2u*)(YS + (row0 + tt) * 512 + g * 16 + 4 * fq) = w; } }
    }
}

__device__ __forceinline__ void lru_unit(Frame& F, const Args& a, int j, int b, int hd, int q4) {
    PHASE_IDS();
    const int fr = lane & 15, fq = lane >> 4;
    constexpr int XP = 72;
    LAS bf16* XC = (LAS bf16*)(F.lds + RING_OFF);
    LAS f32x2* ABv = (LAS f32x2*)(F.lds + RING_OFF + 128 * XP * 2);
    LAS f32x2* PS = ABv + 128 * 16;
    LAS float* carry = (LAS float*)(PS + 32 * 16);
    const unsigned char* wm = wsl + WS_WMIX + (size_t)j * WM_AB_STRIDE;
    const bf16* Z = (const bf16*)(wsl + WS_ACT + B_Z); bf16* CAT = (bf16*)(wsl + WS_ACT + B_CAT); float* SSB = (float*)(wsl + WS_ACT + B_SSB);
    const size_t row0 = (size_t)b * LP + PRE;
    const int cbase = hd * 64;
    const bf16* LW = (const bf16*)(wm + WM_LRUW) + (size_t)hd * 128 * 64;
    bf16x8 wa[2], wx[2];
#pragma unroll
    for (int ks = 0; ks < 2; ++ks) { wa[ks] = *(const GAS bf16x8*)(LW + (size_t)(16 * q4 + fr) * 64 + 32 * ks + 8 * fq); wx[ks] = *(const GAS bf16x8*)(LW + (size_t)(64 + 16 * q4 + fr) * 64 + 32 * ks + 8 * fq); }
    const int oc = tid & 7; float cw[4][8], cb[8];
#pragma unroll
    for (int e = 0; e < 8; ++e) { cb[e] = a.in[20][j * 512 + cbase + 8 * oc + e];
#pragma unroll
        for (int k = 0; k < 4; ++k) cw[k][e] = a.in[19][(j * 4 + k) * 512 + cbase + 8 * oc + e]; }
    float ba[4], bx[4], sp8[4];
#pragma unroll
    for (int e = 0; e < 4; ++e) { const int c = cbase + 16 * q4 + 4 * fq + e; ba[e] = a.in[22][j * 512 + c]; bx[e] = a.in[24][j * 512 + c]; const float lam = a.in[25][j * 512 + c]; sp8[e] = 8.0f * (lam < -20.f ? -lam : log1pf(__expf(-lam))); }
    const int cc = tid & 15, sub = tid >> 4; const int cs = cbase + 16 * q4 + cc;
    __syncthreads();
    if (tid < 16) carry[tid] = 0.f;
    v4u rec[2][4];
#define LRU_LOAD_REC(t0) do { _Pragma("unroll") for (int i = 0; i < 2; ++i) { const int tl = (tid + 512 * i) >> 3; \
        _Pragma("unroll") for (int k = 0; k < 4; ++k) { const int tt = (t0) + tl - 3 + k; \
            rec[i][k] = (tt >= 0 && tt < L) ? *(const GAS v4u*)(Z + (row0 + tt) * 1536 + 1024 + cbase + 8 * oc) : (v4u){0u, 0u, 0u, 0u}; } } } while (0)
    LRU_LOAD_REC(0);
    for (int tile = 0; tile < 17; ++tile) { const int t0 = tile * 128;
        unsigned short gz[4];
#pragma unroll
        for (int s = 0; s < 4; ++s) { const int tt = t0 + 4 * sub + s; gz[s] = tt < L ? ((const GAS unsigned short*)Z)[(row0 + tt) * 1536 + 512 + cs] : (unsigned short)0; }
#pragma unroll
        for (int i = 0; i < 2; ++i) { const int tl = (tid + 512 * i) >> 3; float x[8];
#pragma unroll
            for (int e = 0; e < 8; ++e) x[e] = cb[e];
#pragma unroll
            for (int k = 0; k < 4; ++k) { const v4u r = rec[i][k];
                x[0] += cw[k][0] * bflo(r.x); x[1] += cw[k][1] * bfhi(r.x); x[2] += cw[k][2] * bflo(r.y); x[3] += cw[k][3] * bfhi(r.y);
                x[4] += cw[k][4] * bflo(r.z); x[5] += cw[k][5] * bfhi(r.z); x[6] += cw[k][6] * bflo(r.w); x[7] += cw[k][7] * bfhi(r.w); }
            v4u w; w.x = pk2(x[0], x[1]); w.y = pk2(x[2], x[3]); w.z = pk2(x[4], x[5]); w.w = pk2(x[6], x[7]);
            *(LAS v4u*)(XC + tl * XP + 8 * oc) = w; }
        if (tile < 16) LRU_LOAD_REC(t0 + 128);
        __syncthreads();
        {
            const int tl = 16 * wave + fr; f32x4 ra = (f32x4){0.f, 0.f, 0.f, 0.f}, rx = ra;
#pragma unroll
            for (int ks = 0; ks < 2; ++ks) { const bf16x8 af = *(const LAS bf16x8*)(XC + tl * XP + 32 * ks + 8 * fq);
                ra = __builtin_amdgcn_mfma_f32_16x16x32_bf16(wa[ks], af, ra, 0, 0, 0); rx = __builtin_amdgcn_mfma_f32_16x16x32_bf16(wx[ks], af, rx, 0, 0, 0); }
            const v2u xq = *(const LAS v2u*)(XC + tl * XP + 16 * q4 + 4 * fq); const float xv[4] = {bflo(xq.x), bfhi(xq.x), bflo(xq.y), bfhi(xq.y)};
            const bool valid = (t0 + tl) < L;
#pragma unroll
            for (int e = 0; e < 4; ++e) { const float r = sigmoid_f(ra[e] + ba[e]), ig = sigmoid_f(rx[e] + bx[e]); const float la = -r * sp8[e];
                const float av = __expf(la), bv = sqrtf(-expm1f(2.f * la)) * (ig * xv[e]);
                f32x2 abw; abw.x = valid ? av : 1.f; abw.y = valid ? bv : 0.f; ABv[tl * 16 + 4 * fq + e] = abw; }
        }
        __syncthreads();
        {
            float P = 1.f, hl = 0.f;
#pragma unroll
            for (int s = 0; s < 4; ++s) { const f32x2 ab = ABv[(4 * sub + s) * 16 + cc]; hl = ab.x * hl + ab.y; P *= ab.x; }
            PS[sub * 16 + cc] = (f32x2){P, hl};
        }
        __syncthreads();
        {
            float h = carry[cc];
            for (int s2 = 0; s2 < sub; ++s2) { const f32x2 ps = PS[s2 * 16 + cc]; h = ps.x * h + ps.y; }
#pragma unroll
            for (int s = 0; s < 4; ++s) { const int tt = t0 + 4 * sub + s; const f32x2 ab = ABv[(4 * sub + s) * 16 + cc]; h = ab.x * h + ab.y;
                const float o = gelu_tanh_f(bf2f(gz[s])) * h; float ss = o * o;
                ss += __shfl_xor(ss, 1); ss += __shfl_xor(ss, 2); ss += __shfl_xor(ss, 4); ss += __shfl_xor(ss, 8);
                if (tt < L) { ((GAS unsigned short*)CAT)[(row0 + tt) * 1024 + 512 + cs] = (unsigned short)f2bf(o); if (cc == 0) ((GAS float*)SSB)[(row0 + tt) * 32 + hd * 4 + q4] = ss; } }
            __syncthreads();
            if (sub == 31) carry[cc] = h;
        }
        __syncthreads();
    }
#undef LRU_LOAD_REC
}

__device__ __forceinline__ void pass_abnorm(Frame& F, const float* na, const float* nb) {
    PHASE_IDS();
    const int gw = F.c * NWAVES + wave, NGW = F.G * NWAVES;
    bf16* CAT = (bf16*)(wsl + WS_ACT + B_CAT); const float* SSA = (const float*)(wsl + WS_ACT + B_SSA); const float* SSB = (const float*)(wsl + WS_ACT + B_SSB);
    float ga[8], gb[8];
#pragma unroll
    for (int e = 0; e < 8; ++e) { ga[e] = na[8 * lane + e]; gb[e] = nb[8 * lane + e]; }
    for (int row = gw; row < TP; row += NGW) {
        GAS v4u* p = (GAS v4u*)(CAT + (size_t)row * 1024) + lane;
        if ((row % LP) < PRE) { p[0] = (v4u){0u, 0u, 0u, 0u}; p[64] = (v4u){0u, 0u, 0u, 0u}; continue; }
        float sa = 0.f, sb = 0.f;
#pragma unroll
        for (int e = 0; e < 8; ++e) sa += ((const GAS float*)SSA)[(size_t)row * 8 + e];
#pragma unroll
        for (int e = 0; e < 32; ++e) sb += ((const GAS float*)SSB)[(size_t)row * 32 + e];
        const float ra = rsqrtf(sa * (1.f / 512.f) + RMS_EPS), rb = rsqrtf(sb * (1.f / 512.f) + RMS_EPS);
        v4u x = p[0], y = p[64];
        x.x = pk2(bflo(x.x) * ra * ga[0], bfhi(x.x) * ra * ga[1]); x.y = pk2(bflo(x.y) * ra * ga[2], bfhi(x.y) * ra * ga[3]); x.z = pk2(bflo(x.z) * ra * ga[4], bfhi(x.z) * ra * ga[5]); x.w = pk2(bflo(x.w) * ra * ga[6], bfhi(x.w) * ra * ga[7]);
        y.x = pk2(bflo(y.x) * rb * gb[0], bfhi(y.x) * rb * gb[1]); y.y = pk2(bflo(y.y) * rb * gb[2], bfhi(y.y) * rb * gb[3]); y.z = pk2(bflo(y.z) * rb * gb[4], bfhi(y.z) * rb * gb[5]); y.w = pk2(bflo(y.w) * rb * gb[6], bfhi(y.w) * rb * gb[7]);
        p[0] = x; p[64] = y;
    }
}
}
namespace fk {
constexpr size_t WM_RW_STRIDE = 11 * MiB;
constexpr size_t RW_WRKV = 0;
constexpr size_t RW_WO = 6 * MiB;
constexpr size_t RW_L1 = 8 * MiB;
constexpr size_t RW_W2W = 10 * MiB;
constexpr size_t RW_W2A = 10 * MiB + 128 * KiB;
constexpr size_t RW_W2G = 10 * MiB + 256 * KiB;
constexpr size_t RW_W2V = 10 * MiB + 512 * KiB;
static_assert(WM_RW + 2 * WM_RW_STRIDE <= 50 * MiB, "mixer weights fit");
constexpr size_t RB = (size_t)TP * D * 2;
constexpr size_t R_HN = 0;
constexpr size_t R_XR = 1 * RB, R_XK = 2 * RB, R_XV = 3 * RB;
constexpr size_t R_R = 4 * RB, R_K = 5 * RB, R_V = 6 * RB;
constexpr size_t R_L1 = 7 * RB;
constexpr size_t R_END = R_L1 + (size_t)TP * 512 * 2;
static_assert(R_END <= ACT_BYTES, "RWKV activations fit");

__device__ __forceinline__ void transpose_item_s(const float* W, int ldw, int k0, int n0, bf16* dst, int ldd, LAS float* scr, int lane, const float* mu, int mode, int kcount) {
    for (int i = 0; i < kcount / 2; ++i) { const int kk = 2 * i + (lane >> 5); float s = 1.f; if (mode == 1) s = mu[k0 + kk]; else if (mode == 2) s = 1.f - mu[k0 + kk];
        scr[kk * 33 + (lane & 31)] = W[(size_t)(k0 + kk) * ldw + n0 + (lane & 31)] * s; }
    LDS_WAIT(); asm volatile("" ::: "memory");
    const int c = lane & 7;
    if (8 * c < kcount) {
#pragma unroll
        for (int jj = 0; jj < 4; ++jj) { const int n = (lane >> 3) + 8 * jj; const LAS float* s = scr + (8 * c) * 33 + n;
            v4u o; o.x = pk2(s[0 * 33], s[1 * 33]); o.y = pk2(s[2 * 33], s[3 * 33]); o.z = pk2(s[4 * 33], s[5 * 33]); o.w = pk2(s[6 * 33], s[7 * 33]);
            *(GAS v4u*)(dst + (size_t)n * ldd + 8 * c) = o; } }
    LDS_WAIT(); asm volatile("" ::: "memory");
}
__device__ __forceinline__ void prologue_rw(Frame& F, const Args& a) {
    PHASE_IDS();
    const int gw = F.c * NWAVES + wave, NGW = F.G * NWAVES;
    LAS float* scr = (LAS float*)(F.lds + RING_OFF + wave * 16384);
    constexpr int I_SQ = 512, I_L1 = 288, I_W2 = 32 + 32 + 64 + 32, I_RW = 4 * I_SQ + I_L1 + I_W2;
    for (int it = gw; it < 2 * I_RW; it += NGW) { const int j = it / I_RW; int r = it % I_RW; unsigned char* wm = wsl + WS_WMIX + WM_RW + (size_t)j * WM_RW_STRIDE;
        if (r < 4 * I_SQ) { const int m = r / I_SQ, q = r % I_SQ, kb = q >> 5, nb = q & 31;
            const float* W = a.in[m == 0 ? 27 : m == 1 ? 28 : m == 2 ? 29 : 30] + (size_t)j * D * D;
            bf16* dst = (m < 3 ? (bf16*)(wm + RW_WRKV) + (size_t)m * D * D : (bf16*)(wm + RW_WO)) + (size_t)nb * 32 * 1024 + kb * 64;
            transpose_item_s(W, 1024, kb * 64, nb * 32, dst, 1024, scr, lane, nullptr, 0, 64); continue; } r -= 4 * I_SQ;
        if (r < I_L1) { const int part = r & 1, q = r >> 1, kb = q & 15, nbx = q >> 4;
            const float* mu = a.in[26] + (size_t)j * 6 * D; const float* W; int ldw, n0, muix, drow;
            if (nbx < 2) { W = a.in[32] + (size_t)j * D * 64; ldw = 64; n0 = nbx * 32; muix = 1; drow = n0; }
            else if (nbx < 4) { W = a.in[35] + (size_t)j * D * 64; ldw = 64; n0 = (nbx - 2) * 32; muix = 4; drow = 64 + n0; }
            else if (nbx < 8) { W = a.in[40] + (size_t)j * D * 128; ldw = 128; n0 = (nbx - 4) * 32; muix = 5; drow = 128 + n0; }
            else { if (j == 0) continue; W = a.in[38] + (size_t)(j - 1) * D * 32; ldw = 32; n0 = 0; muix = 3; drow = 256; }
            bf16* dst = (bf16*)(wm + RW_L1) + (size_t)drow * 2048 + part * 1024 + kb * 64;
            transpose_item_s(W, ldw, kb * 64, n0, dst, 2048, scr, lane, mu + muix * D, part == 0 ? 1 : 2, 64); continue; } r -= I_L1;
        if (r < 32) { transpose_item_s(a.in[33] + (size_t)j * 64 * D, 1024, 0, r * 32, (bf16*)(wm + RW_W2W) + (size_t)r * 32 * 64, 64, scr, lane, nullptr, 0, 64); continue; } r -= 32;
        if (r < 32) { transpose_item_s(a.in[36] + (size_t)j * 64 * D, 1024, 0, r * 32, (bf16*)(wm + RW_W2A) + (size_t)r * 32 * 64, 64, scr, lane, nullptr, 0, 64); continue; } r -= 32;
        if (r < 64) { const int kb = r >> 5, nb = r & 31; transpose_item_s(a.in[41] + (size_t)j * 128 * D, 1024, kb * 64, nb * 32, (bf16*)(wm + RW_W2G) + (size_t)nb * 32 * 128 + kb * 64, 128, scr, lane, nullptr, 0, 64); continue; } r -= 64;
        if (j > 0) transpose_item_s(a.in[39] + (size_t)(j - 1) * 32 * D, 1024, 0, r * 32, (bf16*)(wm + RW_W2V) + (size_t)r * 32 * 32, 32, scr, lane, nullptr, 0, 32);
    }
    { GAS v4u* z = (GAS v4u*)(wsl + WS_WMIX + WM_RW + WM_RW_STRIDE + RW_L1 + (size_t)288 * 2048 * 2); const int n16 = 224 * 2048 * 2 / 16;
      for (int i = F.c * NT + tid; i < n16; i += F.G * NT) z[i] = (v4u){0u, 0u, 0u, 0u}; }
}

__device__ __forceinline__ void pass_rwin(Frame& F, const float* gain, const float* mu, int has_o) {
    PHASE_IDS();
    const int gw = F.c * NWAVES + wave, NGW = F.G * NWAVES;
    f32x4 g[4], mr[4], mk[4], mv[4];
#pragma unroll
    for (int q = 0; q < 4; ++q) { g[q] = *(const GAS f32x4*)(gain + 256 * q + 4 * lane); mr[q] = *(const GAS f32x4*)(mu + 0 * D + 256 * q + 4 * lane); mk[q] = *(const GAS f32x4*)(mu + 2 * D + 256 * q + 4 * lane); mv[q] = *(const GAS f32x4*)(mu + 3 * D + 256 * q + 4 * lane); }
    const float* H = (const float*)(wsl + WS_H); const bf16* O = (const bf16*)(wsl + WS_O);
    unsigned char* act = wsl + WS_ACT;
    for (int run = gw; run < TP / 8; run += NGW) { const int r0 = run * 8, rb = run % (LP / 8);
        f32x4 prev[4];
#pragma unroll
        for (int q = 0; q < 4; ++q) prev[q] = (f32x4){0.f, 0.f, 0.f, 0.f};
        if (rb > 2) { f32x4 v[4]; const float rs = load_row(H, O, r0 - 1, has_o, lane, v);
#pragma unroll
            for (int q = 0; q < 4; ++q) prev[q] = v[q] * rs * g[q]; }
        for (int rr = 0; rr < 8; ++rr) { const int row = r0 + rr;
            GAS v2u* o0 = (GAS v2u*)(act + R_HN + (size_t)row * D * 2) + lane; GAS v2u* o1 = (GAS v2u*)(act + R_XR + (size_t)row * D * 2) + lane;
            GAS v2u* o2 = (GAS v2u*)(act + R_XK + (size_t)row * D * 2) + lane; GAS v2u* o3 = (GAS v2u*)(act + R_XV + (size_t)row * D * 2) + lane;
            if (rb < 2) {
#pragma unroll
                for (int q = 0; q < 4; ++q) { o0[64 * q] = (v2u){0u, 0u}; o1[64 * q] = (v2u){0u, 0u}; o2[64 * q] = (v2u){0u, 0u}; o3[64 * q] = (v2u){0u, 0u}; }
                continue; }
            f32x4 v[4]; const float rs = load_row(H, O, row, has_o, lane, v);
#pragma unroll
            for (int q = 0; q < 4; ++q) { const f32x4 cur = v[q] * rs * g[q], dx = prev[q] - cur; prev[q] = cur;
                const f32x4 xr = cur + dx * mr[q], xk = cur + dx * mk[q], xv = cur + dx * mv[q];
                v2u w; w.x = pk2(cur.x, cur.y); w.y = pk2(cur.z, cur.w); o0[64 * q] = w;
                w.x = pk2(xr.x, xr.y); w.y = pk2(xr.z, xr.w); o1[64 * q] = w;
                w.x = pk2(xk.x, xk.y); w.y = pk2(xk.z, xk.w); o2[64 * q] = w;
                w.x = pk2(xv.x, xv.y); w.y = pk2(xv.z, xv.w); o3[64 * q] = w; }
        }
    }
}

struct RwSched {
    const char* act; const char* wm; int nl  , G, c;
    __device__ __forceinline__ void single(int s, Unit& u) const { const int which = s / 260, rem = s % 260, pm = rem >> 2, pn = rem & 3;
        u.A = act + (which == 0 ? R_XR : which == 1 ? R_XK : R_XV) + (size_t)pm * 256 * 2048; u.B = wm + RW_WRKV + ((size_t)which * 1024 + pn * 256) * 2048;
        u.rows = nullptr; u.nvalid = 0; u.lda2 = 2048; u.ldb2 = 2048; u.nt = 16; u.pm = pm; u.pn = pn; u.x0 = which; u.x1 = 0; }
    __device__ __forceinline__ void dbl(int d, Unit& u) const { const int pm = d / nl, pn = d % nl;
        u.A = act + R_HN + ((size_t)pm * 256 - 1) * 2048; u.B = wm + RW_L1 + (size_t)pn * 256 * 4096;
        u.rows = nullptr; u.nvalid = 0; u.lda2 = 2048; u.ldb2 = 4096; u.nt = 32; u.pm = pm; u.pn = pn; u.x0 = 3; u.x1 = 0; }
    __device__ __forceinline__ bool next(int i, Unit& u) const {
        const int nd = 65 * nl, ns = 780; int rho;
        if (c < nd) { if (i == 0) { dbl(c, u); return true; } rho = (i - 1) * G + c; }
        else { if (i < 2) { const int s = 2 * (c - nd) + i; if (s >= ns) return false; single(s, u); return true; } rho = (i - 2) * G + c; }
        const int s = 2 * (G - nd) + rho; if (s >= ns || G < nd) return false;
        single(s, u); return true;
    }
};
struct EpiRw {
    static constexpr bool PERM = true;
    bf16* Rb; bf16* Kb; bf16* Vb; bf16* L1b;
    __device__ __forceinline__ void operator()(const f32x4 (&acc)[2][2][4][2], const Unit& u, int wr, int wc, int fr, int fq) const {
        asm volatile("" : "+v"(fr));
        const int lora = (u.x0 == 3); const int ldo = lora ? 512 : 1024;
        GAS unsigned char* ob = (GAS unsigned char*)(u.x0 == 0 ? Rb : u.x0 == 1 ? Kb : u.x0 == 2 ? Vb : L1b) + ((size_t)u.pm * 256 * ldo + u.pn * 256 + wc * 32) * 2;
#pragma unroll
        for (int bj = 0; bj < 2; ++bj) { const int act = (lora && u.pn == 0) ? (bj == 0 ? (wc < 2 ? 1 : 0) : 2) : 0;
#pragma unroll
            for (int ai = 0; ai < 2; ++ai)
#pragma unroll
                for (int m = 0; m < 4; ++m) { const int r = ai * HALF + wr * 64 + m * 16 + fr; float o[8];
#pragma unroll
                    for (int n = 0; n < 2; ++n)
#pragma unroll
                        for (int q = 0; q < 4; ++q) { const float x = acc[ai][bj][m][n][q]; o[n * 4 + q] = act == 1 ? (2.f * sigmoid_f(2.f * x) - 1.f) : act == 2 ? sigmoid_f(x) : x; }
                    v4u w; w.x = cvt_pk_bf16(o[0], o[1]); w.y = cvt_pk_bf16(o[2], o[3]); w.z = cvt_pk_bf16(o[4], o[5]); w.w = cvt_pk_bf16(o[6], o[7]);
                    *(GAS v4u*)(ob + ((unsigned)r * (unsigned)ldo * 2u + (unsigned)(bj * 256 + fq * 16))) = w; } }
    }
};

__device__ __forceinline__ void rw_prep_unit(Frame& F, const Args& a, int j, int hd, int rng) {
    PHASE_IDS();
    const int fr = lane & 15, fq = lane >> 4;
    constexpr int PW = 72, PG = 136, PV = 40;
    LAS bf16* Lw = (LAS bf16*)(F.lds + RING_OFF); LAS bf16* La = Lw + 64 * PW; LAS bf16* Lg = La + 64 * PW; LAS bf16* Lv = Lg + 64 * PG;
    LAS float* cst = (LAS float*)(Lv + 64 * PV);
    const unsigned char* wm = wsl + WS_WMIX + WM_RW + (size_t)j * WM_RW_STRIDE; unsigned char* act = wsl + WS_ACT;
    __syncthreads();
    for (int i = tid; i < 64 * 8; i += NT) { const int n = i >> 3, c8 = i & 7;
        *(LAS v4u*)(Lw + n * PW + 8 * c8) = *(const GAS v4u*)((const bf16*)(wm + RW_W2W) + (size_t)(hd * 64 + n) * 64 + 8 * c8);
        *(LAS v4u*)(La + n * PW + 8 * c8) = *(const GAS v4u*)((const bf16*)(wm + RW_W2A) + (size_t)(hd * 64 + n) * 64 + 8 * c8); }
    for (int i = tid; i < 64 * 16; i += NT) { const int n = i >> 4, c8 = i & 15; *(LAS v4u*)(Lg + n * PG + 8 * c8) = *(const GAS v4u*)((const bf16*)(wm + RW_W2G) + (size_t)(hd * 64 + n) * 128 + 8 * c8); }
    if (j > 0) for (int i = tid; i < 64 * 4; i += NT) { const int n = i >> 2, c8 = i & 3; *(LAS v4u*)(Lv + n * PV + 8 * c8) = *(const GAS v4u*)((const bf16*)(wm + RW_W2V) + (size_t)(hd * 64 + n) * 32 + 8 * c8); }
    if (tid < 64) { const int c = hd * 64 + tid; cst[tid] = a.in[31][j * D + c]; cst[64 + tid] = a.in[34][j * D + c]; cst[128 + tid] = j > 0 ? a.in[37][(j - 1) * D + c] : 0.f; cst[192 + tid] = a.in[42][j * D + c]; cst[256 + tid] = a.in[43][j * D + c]; }
    __syncthreads();
    const bf16* L1 = (const bf16*)(act + R_L1); bf16* Kb = (bf16*)(act + R_K); bf16* Vb = (bf16*)(act + R_V); const bf16* VF = (const bf16*)(wsl + WS_VF);
    bf16* WLb = (bf16*)(act + R_XR); bf16* KKb = (bf16*)(act + R_XK); bf16* BBb = (bf16*)(act + R_XV); bf16* GGb = (bf16*)(act + R_HN);
    for (int tile = rng * 65 + wave; tile < rng * 65 + 65; tile += NWAVES) {
        if (tile % (LP / 16) == 0) continue;
        const size_t row = (size_t)tile * 16 + fr;
        const bf16* lr = L1 + row * 512 + 8 * fq;
        bf16x8 aw[2], aa[2], ag[4], av;
#pragma unroll
        for (int ks = 0; ks < 2; ++ks) { aw[ks] = *(const GAS bf16x8*)(lr + 32 * ks); aa[ks] = *(const GAS bf16x8*)(lr + 64 + 32 * ks); }
#pragma unroll
        for (int ks = 0; ks < 4; ++ks) ag[ks] = *(const GAS bf16x8*)(lr + 128 + 32 * ks);
        av = *(const GAS bf16x8*)(lr + 256);
        const size_t cb = row * D + hd * 64 + 4 * fq;
        float kx[4][4], aq[4][4], kq[4][4]; float ss = 0.f;
#pragma unroll
        for (int nt = 0; nt < 4; ++nt) { f32x4 ca = (f32x4){0.f, 0.f, 0.f, 0.f};
#pragma unroll
            for (int ks = 0; ks < 2; ++ks) ca = __builtin_amdgcn_mfma_f32_16x16x32_bf16(*(const LAS bf16x8*)(La + (16 * nt + fr) * PW + 32 * ks + 8 * fq), aa[ks], ca, 0, 0, 0);
            const v2u kk2 = *(const GAS v2u*)(Kb + cb + 16 * nt); const float kv[4] = {bflo(kk2.x), bfhi(kk2.x), bflo(kk2.y), bfhi(kk2.y)};
#pragma unroll
            for (int e = 0; e < 4; ++e) { const int ch = 16 * nt + 4 * fq + e; aq[nt][e] = sigmoid_f(cst[64 + ch] + ca[e]); kq[nt][e] = kv[e]; kx[nt][e] = kv[e] * cst[192 + ch]; ss += kx[nt][e] * kx[nt][e]; } }
        ss += __shfl_xor(ss, 16); ss += __shfl_xor(ss, 32);
        const float inv = 1.f / fmaxf(sqrtf(ss), 1e-12f);
#pragma unroll
        for (int nt = 0; nt < 4; ++nt) { f32x4 cw_ = (f32x4){0.f, 0.f, 0.f, 0.f}, cg = cw_, cv = cw_;
#pragma unroll
            for (int ks = 0; ks < 2; ++ks) cw_ = __builtin_amdgcn_mfma_f32_16x16x32_bf16(*(const LAS bf16x8*)(Lw + (16 * nt + fr) * PW + 32 * ks + 8 * fq), aw[ks], cw_, 0, 0, 0);
#pragma unroll
            for (int ks = 0; ks < 4; ++ks) cg = __builtin_amdgcn_mfma_f32_16x16x32_bf16(*(const LAS bf16x8*)(Lg + (16 * nt + fr) * PG + 32 * ks + 8 * fq), ag[ks], cg, 0, 0, 0);
            if (j > 0) cv = __builtin_amdgcn_mfma_f32_16x16x32_bf16(*(const LAS bf16x8*)(Lv + (16 * nt + fr) * PV + 8 * fq), av, cv, 0, 0, 0);
            float wl[4], kn[4], bb[4], k2[4];
#pragma unroll
            for (int e = 0; e < 4; ++e) { const int ch = 16 * nt + 4 * fq + e; const float x = cst[ch] + cw_[e];
                const float sp = (-x > 20.f) ? -x : log1pf(__expf(-x)); wl[e] = -__expf(-sp - 0.5f);
                kn[e] = kx[nt][e] * inv; bb[e] = kn[e] * aq[nt][e]; k2[e] = kq[nt][e] * (1.f + (aq[nt][e] - 1.f) * cst[256 + ch]); }
            v2u w; const size_t off = cb + 16 * nt;
            w.x = pk2(wl[0], wl[1]); w.y = pk2(wl[2], wl[3]); *(GAS v2u*)(WLb + off) = w;
            w.x = pk2(kn[0], kn[1]); w.y = pk2(kn[2], kn[3]); *(GAS v2u*)(KKb + off) = w;
            w.x = pk2(bb[0], bb[1]); w.y = pk2(bb[2], bb[3]); *(GAS v2u*)(BBb + off) = w;
            w.x = pk2(k2[0], k2[1]); w.y = pk2(k2[2], k2[3]); *(GAS v2u*)(Kb + off) = w;
            w.x = pk2(cg[0], cg[1]); w.y = pk2(cg[2], cg[3]); *(GAS v2u*)(GGb + off) = w;
            if (j > 0) { const v2u v2 = *(const GAS v2u*)(Vb + off), f2 = *(const GAS v2u*)(VF + off); const float vv[4] = {bflo(v2.x), bfhi(v2.x), bflo(v2.y), bfhi(v2.y)}, vf[4] = {bflo(f2.x), bfhi(f2.x), bflo(f2.y), bfhi(f2.y)}; float vo[4];
#pragma unroll
                for (int e = 0; e < 4; ++e) { const int ch = 16 * nt + 4 * fq + e; vo[e] = vv[e] + (vf[e] - vv[e]) * sigmoid_f(cst[128 + ch] + cv[e]); }
                w.x = pk2(vo[0], vo[1]); w.y = pk2(vo[2], vo[3]); *(GAS v2u*)(Vb + off) = w; }
        }
    }
}

__device__ __forceinline__ void wkv_unit(Frame& F, const Args& a, int j, int b, int hd) {
    PHASE_IDS();
    constexpr int TB = 32;
    LAS float* buf = (LAS float*)(F.lds + RING_OFF);
    LAS float* yb = buf + 2 * 6 * TB * 64;
    unsigned char* act = wsl + WS_ACT;
    const int ahi = tid >> 8;
    const bf16* src0 = (const bf16*)(act + (ahi ? R_XR : R_XK)); const bf16* src1 = (const bf16*)(act + (ahi ? R_K : R_XV));
    const bf16* src2 = ahi ? (j == 0 ? (const bf16*)(wsl + WS_VF) : (const bf16*)(act + R_V)) : (const bf16*)(act + R_R);
    bf16* GG = (bf16*)(act + R_HN);
    const size_t row0 = (size_t)b * LP + PRE; const int cbase = hd * 64;
    const int i = tid >> 3, jo = tid & 7;
    float S[8];
#pragma unroll
    for (int e = 0; e < 8; ++e) S[e] = 0.f;
    v4u st[3];
#define WKV_LOAD(t0) do { _Pragma("unroll") for (int q = 0; q < 3; ++q) { const int tk = (tid >> 3) & 31, c8 = tid & 7; const int tt = (t0) + tk; const bf16* sp_ = q == 0 ? src0 : q == 1 ? src1 : src2; \
        st[q] = tt < L ? *(const GAS v4u*)(sp_ + (row0 + tt) * D + cbase + 8 * c8) : (v4u){0u, 0u, 0u, 0u}; } } while (0)
#define WKV_STORE(bi) do { _Pragma("unroll") for (int q = 0; q < 3; ++q) { const int p = tid + NT * q, arr = p >> 8, tk = (p >> 3) & 31, c8 = p & 7; \
        float x[8] = {bflo(st[q].x), bfhi(st[q].x), bflo(st[q].y), bfhi(st[q].y), bflo(st[q].z), bfhi(st[q].z), bflo(st[q].w), bfhi(st[q].w)}; \
        if (arr == 0) { _Pragma("unroll") for (int e = 0; e < 8; ++e) x[e] = -x[e]; } \
        if (arr == 1) { _Pragma("unroll") for (int e = 0; e < 8; ++e) x[e] = __expf(x[e]); } \
        LAS f32x4* d = (LAS f32x4*)(buf + ((bi) * 6 + arr) * TB * 64 + tk * 64 + 8 * c8); d[0] = (f32x4){x[0], x[1], x[2], x[3]}; d[1] = (f32x4){x[4], x[5], x[6], x[7]}; } } while (0)
    const float* rk = a.in[44] + (size_t)(j * 16 + hd) * 64; const float* lnw = a.in[45] + j * D + cbase; const float* lnb = a.in[46] + j * D + cbase;
    __syncthreads();
    WKV_LOAD(0); WKV_STORE(0);
    __syncthreads();
    constexpr int NBLK = (L + TB - 1) / TB;
    for (int blk = 0; blk < NBLK; ++blk) { const int bi = blk & 1, t0 = blk * TB;
        if (blk + 1 < NBLK) WKV_LOAD(t0 + TB);
        const LAS float* A_ = buf + (bi * 6 + 0) * TB * 64 + 8 * jo; const LAS float* W_ = buf + (bi * 6 + 1) * TB * 64 + 8 * jo; const LAS float* B_ = buf + (bi * 6 + 2) * TB * 64 + 8 * jo;
        const LAS float* K_ = buf + (bi * 6 + 3) * TB * 64 + 8 * jo; const LAS float* R_ = buf + (bi * 6 + 4) * TB * 64 + 8 * jo; const LAS float* V_ = buf + (bi * 6 + 5) * TB * 64 + i;
#pragma unroll 2
        for (int tk = 0; tk < TB; ++tk) {
            const f32x4 a0 = *(const LAS f32x4*)(A_ + tk * 64), a1 = *(const LAS f32x4*)(A_ + tk * 64 + 4), w0 = *(const LAS f32x4*)(W_ + tk * 64), w1 = *(const LAS f32x4*)(W_ + tk * 64 + 4);
            const f32x4 b0 = *(const LAS f32x4*)(B_ + tk * 64), b1 = *(const LAS f32x4*)(B_ + tk * 64 + 4), k0 = *(const LAS f32x4*)(K_ + tk * 64), k1 = *(const LAS f32x4*)(K_ + tk * 64 + 4);
            const f32x4 r0 = *(const LAS f32x4*)(R_ + tk * 64), r1 = *(const LAS f32x4*)(R_ + tk * 64 + 4); const float vi = V_[tk * 64];
            float sa = (S[0] * a0.x + S[1] * a0.y) + (S[2] * a0.z + S[3] * a0.w) + (S[4] * a1.x + S[5] * a1.y) + (S[6] * a1.z + S[7] * a1.w);
            sa += __shfl_xor(sa, 1); sa += __shfl_xor(sa, 2); sa += __shfl_xor(sa, 4);
            S[0] = S[0] * w0.x + (sa * b0.x + vi * k0.x); S[1] = S[1] * w0.y + (sa * b0.y + vi * k0.y); S[2] = S[2] * w0.z + (sa * b0.z + vi * k0.z); S[3] = S[3] * w0.w + (sa * b0.w + vi * k0.w);
            S[4] = S[4] * w1.x + (sa * b1.x + vi * k1.x); S[5] = S[5] * w1.y + (sa * b1.y + vi * k1.y); S[6] = S[6] * w1.z + (sa * b1.z + vi * k1.z); S[7] = S[7] * w1.w + (sa * b1.w + vi * k1.w);
            float y = (S[0] * r0.x + S[1] * r0.y) + (S[2] * r0.z + S[3] * r0.w) + (S[4] * r1.x + S[5] * r1.y) + (S[6] * r1.z + S[7] * r1.w);
            y += __shfl_xor(y, 1); y += __shfl_xor(y, 2); y += __shfl_xor(y, 4);
            if (jo == 0) yb[tk * 64 + i] = y;
        }
        __syncthreads();
        {
            const int tk = tid >> 4, i4 = 4 * (tid & 15), tt = t0 + tk;
            const f32x4 y4 = *(const LAS f32x4*)(yb + tk * 64 + i4);
            const f32x4 r4 = *(const LAS f32x4*)(buf + (bi * 6 + 4) * TB * 64 + tk * 64 + i4), k4 = *(const LAS f32x4*)(buf + (bi * 6 + 3) * TB * 64 + tk * 64 + i4), v4 = *(const LAS f32x4*)(buf + (bi * 6 + 5) * TB * 64 + tk * 64 + i4);
            const f32x4 rk4 = *(const GAS f32x4*)(rk + i4);
            float s1 = (y4.x + y4.y) + (y4.z + y4.w), s3 = (r4.x * k4.x * rk4.x + r4.y * k4.y * rk4.y) + (r4.z * k4.z * rk4.z + r4.w * k4.w * rk4.w);
#pragma unroll
            for (int o = 1; o < 16; o <<= 1) { s1 += __shfl_xor(s1, o); s3 += __shfl_xor(s3, o); }
            const float mean = s1 * (1.f / 64.f); const f32x4 d4 = y4 - mean; float s2 = (d4.x * d4.x + d4.y * d4.y) + (d4.z * d4.z + d4.w * d4.w);
#pragma unroll
            for (int o = 1; o < 16; o <<= 1) s2 += __shfl_xor(s2, o);
            const float rstd = rsqrtf(s2 * (1.f / 64.f) + 64e-5f);
            if (tt < L) { GAS v2u* gp = (GAS v2u*)(GG + (row0 + tt) * D + cbase + i4); const v2u g2 = *gp; const f32x4 lw4 = *(const GAS f32x4*)(lnw + i4), lb4 = *(const GAS f32x4*)(lnb + i4);
                const float o0 = (d4.x * rstd * lw4.x + lb4.x + s3 * v4.x) * bflo(g2.x), o1 = (d4.y * rstd * lw4.y + lb4.y + s3 * v4.y) * bfhi(g2.x);
                const float o2 = (d4.z * rstd * lw4.z + lb4.z + s3 * v4.z) * bflo(g2.y), o3 = (d4.w * rstd * lw4.w + lb4.w + s3 * v4.w) * bfhi(g2.y);
                v2u w; w.x = pk2(o0, o1); w.y = pk2(o2, o3); *gp = w; }
        }
        if (blk + 1 < NBLK) WKV_STORE(bi ^ 1);
        __syncthreads();
    }
#undef WKV_LOAD
#undef WKV_STORE
}
}
namespace fk {
__global__ void __launch_bounds__(NT, 2) mega(Args args) {
    extern __shared__ __attribute__((aligned(16))) unsigned char lds_raw[];
    Frame F;
    F.lds = (LAS unsigned char*)lds_raw; F.MISC = (volatile LAS unsigned*)(F.lds + MISC_OFF);
    F.tid = threadIdx.x; F.lane = F.tid & 63; F.wave = __builtin_amdgcn_readfirstlane(F.tid >> 6);
    F.G = gridDim.x; F.c = blockIdx.x; F.ws = args.ws; F.ctl = (unsigned*)(args.ws + WS_CTL);
    for (int u = F.tid; u < 256; u += NT) F.MISC[u] = 0u;
    __syncthreads();
    XcdBarrier bar = xcd_barrier_post(F.ctl + CW_BAR + args.li * XCD_BAR_WORDS, F.MISC + 8);
    const int lo = args.ph_lo, hi = args.ph_hi;
#define IN(k) (lo <= (k) && (k) < hi)
#define SEAM(k) do { if ((k) + 1 < hi) xcd_barrier(bar); } while (0)
    if (IN(0)) { prologue_ab(F, args); prologue_rw(F, args); SEAM(0); }
    for (int l = 0; l < 4; ++l) {
        const int pb = 1 + 20 * l; const int has_o = (args.comb && l > 0) ? 1 : 0;
        unsigned char* wsl = F.ws; asm volatile("" : "+s"(wsl));
        if ((l & 1) == 0) {
            const int j = l >> 1; unsigned char* wm = wsl + WS_WMIX + (size_t)j * WM_AB_STRIDE; unsigned char* act = wsl + WS_ACT;
            if (IN(pb + 0)) { pass_norm(F, args.in[2] + l * D, has_o, (bf16*)(act + B_HN)); SEAM(pb + 0); }
            if (IN(pb + 1)) {
                DenseSched S{(const char*)(act + B_HN), (const char*)(wm + WM_WIN), 2048, 2048, 16, TP / 256, 6, F.G, F.c};
                EpiBf16 E{(bf16*)(act + B_Z), 1536};
                gemm_stream<EpiBf16, DenseSched, false>(F.lds + RING_OFF, S, E);
                SEAM(pb + 1);
            }
            if (IN(pb + 2)) {
                for (int u = F.c; u < 512; u += F.G) { if (u < 256) lru_unit(F, args, j, u >> 5, (u >> 2) & 7, u & 3); else s5_unit(F, j, (u - 256) >> 5, (u - 256) & 31); }
                SEAM(pb + 2);
            }
            if (IN(pb + 3)) {
                DenseSched S{(const char*)(act + B_YS), (const char*)(wm + WM_WGLU), 1024, 1024, 8, TP / 256, 2, F.G, F.c};
                EpiGlu E{(const bf16*)(act + B_YS), (bf16*)(act + B_CAT), args.in[18] + j * 512, (float*)(act + B_SSA)};
                gemm_stream<EpiGlu, DenseSched, false>(F.lds + RING_OFF, S, E);
                SEAM(pb + 3);
            }
            if (IN(pb + 4)) { pass_abnorm(F, args.in[7] + j * 512, args.in[8] + j * 512); SEAM(pb + 4); }
            if (IN(pb + 5)) {
                DenseSched S{(const char*)(act + B_CAT), (const char*)(wm + WM_WOUT), 2048, 2048, 16, TP / 256, 4, F.G, F.c};
                EpiResid E{(float*)(wsl + WS_H), (const bf16*)(wsl + WS_O), has_o};
                gemm_stream<EpiResid, DenseSched, false>(F.lds + RING_OFF, S, E);
                SEAM(pb + 5);
            }
        }
        if ((l & 1) == 1) {
            const int j = l >> 1; unsigned char* wm = wsl + WS_WMIX + WM_RW + (size_t)j * WM_RW_STRIDE; unsigned char* act = wsl + WS_ACT;
            if (IN(pb + 0)) { pass_rwin(F, args.in[2] + l * D, args.in[26] + (size_t)j * 6 * D, has_o); SEAM(pb + 0); }
            if (IN(pb + 1)) {
                RwSched S{(const char*)act, (const char*)wm, j == 0 ? 1 : 2, F.G, F.c};
                EpiRw E{(bf16*)(act + R_R), (bf16*)(act + R_K), j == 0 ? (bf16*)(wsl + WS_VF) : (bf16*)(act + R_V), (bf16*)(act + R_L1)};
                gemm_stream<EpiRw, RwSched, false>(F.lds + RING_OFF, S, E);
                SEAM(pb + 1);
            }
            if (IN(pb + 2)) { for (int u = F.c; u < 256; u += F.G) rw_prep_unit(F, args, j, u >> 4, u & 15); SEAM(pb + 2); }
            if (IN(pb + 3)) { for (int u = F.c; u < 128; u += F.G) wkv_unit(F, args, j, u >> 4, u & 15); SEAM(pb + 3); }
            if (IN(pb + 4)) {
                DenseSched S{(const char*)(act + R_HN), (const char*)(wm + RW_WO), 2048, 2048, 16, TP / 256, 4, F.G, F.c};
                EpiResid E{(float*)(wsl + WS_H), (const bf16*)(wsl + WS_O), has_o};
                gemm_stream<EpiResid, DenseSched, false>(F.lds + RING_OFF, S, E);
                SEAM(pb + 4);
            }
        }
        if (IN(pb + 9)) { moe_convert(F, args, l); SEAM(pb + 9); }
        if (IN(pb + 10)) { moe_route(F, args, l); SEAM(pb + 10); }
        if (IN(pb + 11)) {
            moe_tables(F, l);
            MoeSched S{F.MISC + 64, (const char*)(wsl + WS_ACT + A_XN), (const char*)(wsl + WS_WMOE), (const int*)(wsl + WS_ACT + A_LIST), 2048, 2048, 16, F.G, F.c, 1};
            EpiSwiglu E{(bf16*)(wsl + WS_ACT + A_HID), (const float*)(wsl + WS_ACT + A_LISTW)};
            gemm_stream<EpiSwiglu, MoeSched, true>(F.lds + RING_OFF, S, E);
            SEAM(pb + 11);
        }
        if (IN(pb + 12)) {
            moe_tables(F, l);
            MoeSched S{F.MISC + 64, (const char*)(wsl + WS_ACT + A_HID), (const char*)(wsl + WS_WMOE + (size_t)16 * 1024 * 1024 * 2), nullptr, 1024, 1024, 8, F.G, F.c, 0};
            EpiScatter E{(bf16*)(wsl + WS_O), (const int*)(wsl + WS_ACT + A_LISTD)};
            gemm_stream<EpiScatter, MoeSched, false>(F.lds + RING_OFF, S, E);
            SEAM(pb + 12);
        }
    }
    if (IN(90)) { pass_final(F, args.in[4], args.out); }
#undef IN
#undef SEAM
}
}
extern "C" void kernel_launch(void* const* d_in, const int* in_sizes, int n_in, void* d_out, int out_size, void* d_ws, size_t ws_size, hipStream_t stream) {
    using namespace fk;
    static int grid = 0;
    if (grid == 0) {
        int dev = 0, cus = 0;
        if (ws_size < WS_END || n_in != 54) { fprintf(stderr, "kernel_launch: bad sizes (ws %zu)\n", ws_size); grid = -1; return; }
        if (hipGetDevice(&dev) != hipSuccess || hipDeviceGetAttribute(&cus, hipDeviceAttributeMultiprocessorCount, dev) != hipSuccess) { grid = -1; return; }
        if (hipFuncSetAttribute((const void*)mega, hipFuncAttributeMaxDynamicSharedMemorySize, LDS_BYTES) != hipSuccess) { fprintf(stderr, "hipFuncSetAttribute failed\n"); grid = -1; return; }
        int per_cu = 0; (void)hipOccupancyMaxActiveBlocksPerMultiprocessor(&per_cu, (const void*)mega, NT, LDS_BYTES); (void)hipGetLastError();
        grid = cus;
    }
    if (grid < 0) return;
    unsigned char* ws = (unsigned char*)d_ws;
    (void)hipMemsetAsync(ws + WS_CTL, 0, CTL_ZERO_BYTES, stream);
    Args a{}; for (int i = 0; i < 54; ++i) a.in[i] = (const float*)d_in[i]; a.out = (float*)d_out; a.ws = ws; a.comb = 1;
    a.ph_lo = 0; a.ph_hi = 91; a.li = 0;
    hipLaunchKernelGGL(mega, dim3(grid), dim3(NT), LDS_BYTES, stream, a);
}
```

```cpp
#include <hip/hip_runtime.h>
#include <cstdio>
#include <cstdint>
#define GAS __attribute__((address_space(1)))
#define LAS __attribute__((address_space(3)))
typedef unsigned short bf16;
typedef unsigned v4u __attribute__((ext_vector_type(4)));
typedef unsigned v2u __attribute__((ext_vector_type(2)));
typedef float f32x4 __attribute__((ext_vector_type(4)));
typedef float f32x2 __attribute__((ext_vector_type(2)));
typedef short bf16x8 __attribute__((ext_vector_type(8)));
#define LDS_WAIT() asm volatile("s_waitcnt lgkmcnt(0)" ::: "memory")
#define PHASE_IDS() int tid = threadIdx.x; asm volatile("" : "+v"(tid)); const int lane = tid & 63; const int wave = __builtin_amdgcn_readfirstlane(tid >> 6); (void)lane; (void)wave; unsigned char* wsl = F.ws; asm volatile("" : "+s"(wsl))
#define VM_WAIT() asm volatile("s_waitcnt vmcnt(0)" ::: "memory")

namespace fk {
constexpr int D = 1024, NB = 8, SEQ = 2048, NMETA = 16, L = SEQ + NMETA, PRE = 16, LP = L + PRE, TP = NB * LP;
constexpr int NWAVES = 8, NT = 512;
constexpr float RMS_EPS = 1e-6f;
static_assert(TP % 256 == 0, "row padding");
constexpr int MOE_ROWS = 37120;
constexpr int LISTCAP = TP;

constexpr size_t MiB = 1u << 20;
constexpr size_t WS_CTL = 0, CTL_ZERO_BYTES = 1 * MiB;
constexpr size_t WS_WMIX = 1 * MiB;
constexpr size_t WS_WMOE = 51 * MiB;
constexpr size_t WS_H = 99 * MiB;
constexpr size_t WS_VF = 164 * MiB;
constexpr size_t WS_O = WS_VF + (size_t)TP * D * 2;
constexpr size_t WS_ACT = WS_O + (size_t)TP * 2 * D * 2;
constexpr size_t WS_END = 512 * MiB;
constexpr size_t ACT_BYTES = WS_END - WS_ACT;
constexpr size_t A_XN = 0;
constexpr size_t A_HID = A_XN + (size_t)TP * D * 2;
constexpr size_t A_LIST = A_HID + (size_t)MOE_ROWS * 512 * 2;
constexpr size_t A_LISTW = A_LIST + (size_t)16 * LISTCAP * 4;
constexpr size_t A_LISTD = A_LISTW + (size_t)16 * LISTCAP * 4;
constexpr size_t A_MOE_END = A_LISTD + (size_t)16 * LISTCAP * 4;
static_assert(A_MOE_END <= ACT_BYTES, "MoE activations fit");
constexpr int CW_BAR = 4096;
constexpr int CW_CNT = 131072;

__device__ __forceinline__ unsigned f2bf(float f) { unsigned u = __builtin_bit_cast(unsigned, f); return (u + 0x7fffu + ((u >> 16) & 1u)) >> 16; }
__device__ __forceinline__ unsigned pk2(float lo, float hi) { return f2bf(lo) | (f2bf(hi) << 16); }
__device__ __forceinline__ float bf2f(unsigned b) { return __builtin_bit_cast(float, b << 16); }
__device__ __forceinline__ float bflo(unsigned w) { return __builtin_bit_cast(float, w << 16); }
__device__ __forceinline__ float bfhi(unsigned w) { return __builtin_bit_cast(float, w & 0xffff0000u); }
template <int CTRL> __device__ __forceinline__ float dpp_mov(float x) { return __builtin_bit_cast(float, __builtin_amdgcn_update_dpp(0, __builtin_bit_cast(int, x), CTRL, 0xf, 0xf, true)); }
__device__ __forceinline__ float sum8(float x) { x += dpp_mov<0xB1>(x); x += dpp_mov<0x4E>(x); x += dpp_mov<0x141>(x); return x; }
__device__ __forceinline__ float sum16(float x) { x = sum8(x); x += dpp_mov<0x140>(x); return x; }
__device__ __forceinline__ float wave_sum(float v) {
    v = sum16(v);
    const float s0 = __builtin_bit_cast(float, __builtin_amdgcn_readlane(__builtin_bit_cast(int, v), 0)), s1 = __builtin_bit_cast(float, __builtin_amdgcn_readlane(__builtin_bit_cast(int, v), 16));
    const float s2 = __builtin_bit_cast(float, __builtin_amdgcn_readlane(__builtin_bit_cast(int, v), 32)), s3 = __builtin_bit_cast(float, __builtin_amdgcn_readlane(__builtin_bit_cast(int, v), 48));
    return (s0 + s1) + (s2 + s3);
}
__device__ __forceinline__ float sigmoid_f(float x) { return 1.f / (1.f + __expf(-x)); }
__device__ __forceinline__ float gelu_tanh_f(float x) { const float u = 0.7978845608028654f * (x + 0.044715f * x * x * x); return x * sigmoid_f(2.f * u); }

#define XB_TMO      128
#define XB_XCNT(j)  (256  + 64 * (j))
#define XB_XSUB(j)  (1280 + 64 * (j))
#define XB_XGEN(j)  (2304 + 64 * (j))
#define XB_TOP      3328
#define XB_TOPGEN   3392
#define XCD_BAR_WORDS 3456
#define XB_SPIN_CAP (1u << 18)
__device__ __forceinline__ unsigned xb_ld(unsigned* p)              { return __hip_atomic_load(p, __ATOMIC_RELAXED, __HIP_MEMORY_SCOPE_AGENT); }
__device__ __forceinline__ unsigned xb_add(unsigned* p, unsigned v) { return __hip_atomic_fetch_add(p, v, __ATOMIC_RELAXED, __HIP_MEMORY_SCOPE_AGENT); }
__device__ __forceinline__ unsigned xb_xcc_id() { return (unsigned)__builtin_amdgcn_s_getreg((3 << 11) | 20) & 0xFu; }
#define XB_SPIN(cond, bar) do { unsigned _sp = 0; while (cond) { __builtin_amdgcn_s_sleep(1); \
    if ((++_sp & 255u) == 0u) { if (xb_ld(&(bar)[XB_TMO])) break; if (_sp > XB_SPIN_CAP) { atomicAdd(&(bar)[XB_TMO], 1u); break; } } } } while (0)
struct XcdBarrier { unsigned* bar; unsigned x; volatile LAS unsigned* st; };
__device__ __forceinline__ XcdBarrier xcd_barrier_post(unsigned* bar, volatile LAS unsigned* st) {
    XcdBarrier b; b.bar = bar; b.x = xb_xcc_id(); b.st = st;
    if (threadIdx.x == 0) (void)xb_add(&bar[XB_XCNT(b.x)], 1u);
    return b;
}
__device__ __forceinline__ void xcd_barrier_complete(unsigned* bar, unsigned x, unsigned& nloc, unsigned& nx) {
    const unsigned G = gridDim.x * gridDim.y * gridDim.z;
    unsigned sum, cnt, mine, sp = 0u;
    for (;;) {
        sum = 0u; cnt = 0u; mine = 0u;
#pragma unroll
        for (unsigned j = 0; j < 16; ++j) { const unsigned c = xb_ld(&bar[XB_XCNT(j)]); sum += c; cnt += (c > 0u) ? 1u : 0u; mine = (j == x) ? c : mine; }
        if (sum == G) break;
        __builtin_amdgcn_s_sleep(1);
        if ((++sp & 255u) == 0u) { if (xb_ld(&bar[XB_TMO])) break; if (sp > XB_SPIN_CAP) { atomicAdd(&bar[XB_TMO], 1u); break; } }
    }
    nloc = mine > 0u ? mine : 1u; nx = cnt > 0u ? cnt : 1u;
}
__device__ __forceinline__ void xcd_barrier(const XcdBarrier& b) {
    asm volatile("s_waitcnt vmcnt(0)" ::: "memory");
    __syncthreads();
    if (threadIdx.x == 0) {
        unsigned* bar = b.bar;
        __builtin_amdgcn_s_waitcnt(0);
        unsigned nloc = b.st[0], nx = b.st[1];
        if (nloc == 0u) { xcd_barrier_complete(bar, b.x, nloc, nx); b.st[0] = nloc; b.st[1] = nx; }
        const unsigned old = xb_add(&bar[XB_XSUB(b.x)], 1u);
        const unsigned gen = old / nloc;
        if (old + 1u == (gen + 1u) * nloc) {
            __builtin_amdgcn_fence(__ATOMIC_RELEASE, "agent");
            asm volatile("s_waitcnt vmcnt(0)" ::: "memory");
            const unsigned og = xb_add(&bar[XB_TOP], 1u);
            const unsigned tg = og / nx;
            if (og + 1u == (tg + 1u) * nx) xb_add(&bar[XB_TOPGEN], 1u);
            else XB_SPIN(xb_ld(&bar[XB_TOPGEN]) == tg, bar);
            __builtin_amdgcn_fence(__ATOMIC_ACQUIRE, "agent");
            xb_add(&bar[XB_XGEN(b.x)], 1u);
            asm volatile("s_waitcnt vmcnt(0)" ::: "memory");
        } else {
            XB_SPIN(xb_ld(&bar[XB_XGEN(b.x)]) == gen, bar);
            __builtin_amdgcn_fence(__ATOMIC_ACQUIRE, "agent");
            asm volatile("s_waitcnt vmcnt(0)" ::: "memory");
        }
    }
    __syncthreads();
}

constexpr int BM = 256, BK = 64, HALF = 128, HTB = HALF * BK * 2, STAGE_BYTES = 8 * HTB;
__host__ __device__ __forceinline__ int lds_byte(int r, int c) { const int st = (r >> 4) * 2 + (c >> 5), rr = r & 15, cc = c & 31, ob = rr * 64 + cc * 2; return st * 1024 + (ob ^ (((ob >> 9) & 1) << 5)); }
__host__ __device__ __forceinline__ void stage_rc(int b, int& R, int& C) { const int st = b / 1024, sb = b % 1024, swz = sb ^ (((sb >> 9) & 1) << 5); R = (st >> 1) * 16 + swz / 64; C = (st & 1) * 32 + (swz % 64) / 2; }
__host__ __device__ __forceinline__ int perm32(int rho) { const int n = rho >> 4, i = rho & 15; return 8 * (i >> 2) + 4 * n + (i & 3); }

struct Unit {
    const char* A;
    const char* B;
    const int* rows;
    int nvalid;
    int lda2, ldb2;
    int nt;
    int pm, pn, x0, x1;
};
template <bool GATHER> struct AOff { unsigned v[GATHER ? 4 : 1]; };
template <bool GATHER> __device__ __forceinline__ void unit_rows(const Unit& u, int R0, unsigned (&pk)[2]) {
    if constexpr (GATHER) {
#pragma unroll
        for (int h = 0; h < 2; ++h) { unsigned w = 0;
#pragma unroll
            for (int i = 0; i < 2; ++i) { const int r = h * HALF + R0 + 64 * i; const unsigned row = (r < u.nvalid) ? (unsigned)((const GAS int*)u.rows)[r] : 0u; w |= row << (16 * i); }
            pk[h] = w; }
    } else { pk[0] = 0; pk[1] = 0; }
}

template <class Epi, class Sched, bool GATHER>
__device__ __forceinline__ void gemm_stream(LAS unsigned char* lds, const Sched& S, const Epi& E) {
    int tid = threadIdx.x; asm volatile("" : "+v"(tid));
    const int wid = __builtin_amdgcn_readfirstlane(tid >> 6), lane = tid & 63, wr = wid >> 2, wc = wid & 3, fr = lane & 15, fq = lane >> 4;
    int R0, C0; stage_rc(tid * 16, R0, C0);
    const int Rb0 = Epi::PERM ? ((R0 & ~31) + perm32(R0 & 31)) : R0;
    const unsigned ldsw = (unsigned)wid * 1024u;
    const int aoff = lds_byte(wr * 64 + fr, fq * 8), boff = lds_byte(wc * 32 + fr, fq * 8);
#define G_SA(b, h) (((b) * 2 + (h)) * HTB)
#define G_SB(b, h) ((4 + (b) * 2 + (h)) * HTB)
#define G_STAGE_A(bufoff, gbase, h) do { _Pragma("unroll") for (int _i = 0; _i < 2; ++_i) { \
        const char* _p = GATHER ? ((const char*)(gbase) + vA[(h) * 2 + _i]) : ((const char*)(gbase) + (size_t)((h) * HALF + 64 * _i) * (size_t)ldA + vA[0]); \
        __builtin_amdgcn_global_load_lds((const unsigned*)_p, (LAS unsigned*)(lds + (bufoff) + ldsw + _i * 8192), 16, 0, 0); } } while (0)
#define G_STAGE_B(bufoff, gbase, h) do { _Pragma("unroll") for (int _i = 0; _i < 2; ++_i) \
        __builtin_amdgcn_global_load_lds((const unsigned*)((const char*)(gbase) + (size_t)((h) * HALF + 64 * _i) * (size_t)ldB + vB), (LAS unsigned*)(lds + (bufoff) + ldsw + _i * 8192), 16, 0, 0); } while (0)
#define G_LDA(dst, b, h) do { _Pragma("unroll") for (int m = 0; m < 4; ++m) _Pragma("unroll") for (int k = 0; k < 2; ++k) dst[m][k] = *(const LAS bf16x8*)(lds + G_SA(b, h) + aoff + m * 2048 + k * 1024); } while (0)
#define G_LDB(dst, b, h) do { _Pragma("unroll") for (int n = 0; n < 2; ++n) _Pragma("unroll") for (int k = 0; k < 2; ++k) dst[n][k] = *(const LAS bf16x8*)(lds + G_SB(b, h) + boff + n * 2048 + k * 1024); } while (0)
#define G_MMA(ai, bj, At, Bt) do { __builtin_amdgcn_s_setprio(1); _Pragma("unroll") for (int m = 0; m < 4; ++m) _Pragma("unroll") for (int n = 0; n < 2; ++n) _Pragma("unroll") for (int k = 0; k < 2; ++k) \
        acc[ai][bj][m][n] = __builtin_amdgcn_mfma_f32_16x16x32_bf16(Bt[n][k], At[m][k], acc[ai][bj][m][n], 0, 0, 0); __builtin_amdgcn_s_setprio(0); } while (0)
#define G_WAIT_V(n) asm volatile("s_waitcnt vmcnt(" #n ")" ::: "memory")
#define G_WAIT_L(n) asm volatile("s_waitcnt lgkmcnt(" #n ")" ::: "memory")
#define G_BAR __builtin_amdgcn_s_barrier()
#define G_SCHED __builtin_amdgcn_sched_barrier(0)
#define G_SET_OFFS(u, pk) do { ldA = (u).lda2; ldB = (u).ldb2; vB = (unsigned)Rb0 * (unsigned)ldB + (unsigned)C0 * 2u; \
        if constexpr (GATHER) { vA[0] = ((pk)[0] & 0xffffu) * (unsigned)ldA + (unsigned)C0 * 2u; vA[1] = ((pk)[0] >> 16) * (unsigned)ldA + (unsigned)C0 * 2u; \
                                vA[2] = ((pk)[1] & 0xffffu) * (unsigned)ldA + (unsigned)C0 * 2u; vA[3] = ((pk)[1] >> 16) * (unsigned)ldA + (unsigned)C0 * 2u; } \
        else { vA[0] = (unsigned)R0 * (unsigned)ldA + (unsigned)C0 * 2u; } } while (0)
    Unit cur, nxt; int ui = 0;
    if (!S.next(0, cur)) return;
    unsigned vA[GATHER ? 4 : 1], vB, pk[2]; int ldA, ldB;
    unit_rows<GATHER>(cur, R0, pk);
    G_SET_OFFS(cur, pk);
    f32x4 acc[2][2][4][2];
#pragma unroll
    for (int a = 0; a < 2; ++a)
#pragma unroll
        for (int b = 0; b < 2; ++b)
#pragma unroll
            for (int m = 0; m < 4; ++m)
#pragma unroll
                for (int n = 0; n < 2; ++n) acc[a][b][m][n] = (f32x4){0.f, 0.f, 0.f, 0.f};
    bf16x8 At[4][2], B0[2][2], B1[2][2];
    const char* cA = cur.A; const char* cB = cur.B;
    const size_t kstep = (size_t)(BK * 2);
    G_STAGE_B(G_SB(0, 0), cB, 0); G_STAGE_A(G_SA(0, 0), cA, 0); G_STAGE_B(G_SB(0, 1), cB, 1); G_STAGE_A(G_SA(0, 1), cA, 1);
    if (wr == 1) G_BAR;
    G_WAIT_V(4); G_BAR;
    G_STAGE_B(G_SB(1, 0), cB + kstep, 0); G_STAGE_A(G_SA(1, 0), cA + kstep, 0); G_STAGE_B(G_SB(1, 1), cB + kstep, 1);
    G_WAIT_V(6); G_BAR;
    for (;;) {
        const bool has_next = S.next(ui + 1, nxt);
        if (!has_next) nxt = cur;
        unit_rows<GATHER>(nxt, R0, pk);
        const char* nA = nxt.A; const char* nB = nxt.B;
        const int nt = cur.nt;
        for (int t = 0; t < nt; t += 2) {
            const bool last = (t == nt - 2);
            const char* a1 = cA + (size_t)(t + 1) * kstep;
            const char* a2 = last ? nA : cA + (size_t)(t + 2) * kstep; const char* b2 = last ? nB : cB + (size_t)(t + 2) * kstep;
            const char* a3 = a2 + kstep; const char* b3 = b2 + kstep;
            G_LDB(B0, 0, 0); G_SCHED; G_LDA(At, 0, 0); G_STAGE_A(G_SA(1, 1), a1, 1);
            if (last) { G_SET_OFFS(nxt, pk); }
            G_WAIT_L(8); G_BAR; G_WAIT_L(0); G_MMA(0, 0, At, B0); G_BAR; G_SCHED;
            G_LDB(B1, 0, 1); G_STAGE_B(G_SB(0, 0), b2, 0);
            G_BAR; G_WAIT_L(0); G_MMA(0, 1, At, B1); G_BAR;
            G_LDA(At, 0, 1); G_STAGE_A(G_SA(0, 0), a2, 0);
            G_BAR; G_WAIT_L(0); G_MMA(1, 0, At, B0); G_BAR; G_SCHED;
            G_STAGE_B(G_SB(0, 1), b2, 1);
            G_WAIT_V(6); G_BAR; G_MMA(1, 1, At, B1); G_BAR;
            G_LDB(B0, 1, 0); G_SCHED; G_LDA(At, 1, 0); G_STAGE_A(G_SA(0, 1), a2, 1);
            G_WAIT_L(8); G_BAR; G_WAIT_L(0); G_MMA(0, 0, At, B0); G_BAR; G_SCHED;
            G_LDB(B1, 1, 1); G_STAGE_B(G_SB(1, 0), b3, 0);
            G_BAR; G_WAIT_L(0); G_MMA(0, 1, At, B1); G_BAR;
            G_LDA(At, 1, 1); G_STAGE_A(G_SA(1, 0), a3, 0);
            G_BAR; G_WAIT_L(0); G_MMA(1, 0, At, B0); G_BAR; G_SCHED;
            G_STAGE_B(G_SB(1, 1), b3, 1);
            G_WAIT_V(6); G_BAR; G_MMA(1, 1, At, B1); G_BAR;
        }
        E(acc, cur, wr, wc, fr, fq);
        if (!has_next) break;
#pragma unroll
        for (int a = 0; a < 2; ++a)
#pragma unroll
            for (int b = 0; b < 2; ++b)
#pragma unroll
                for (int m = 0; m < 4; ++m)
#pragma unroll
                    for (int n = 0; n < 2; ++n) acc[a][b][m][n] = (f32x4){0.f, 0.f, 0.f, 0.f};
        cur = nxt; cA = nA; cB = nB; ++ui;
    }
    G_WAIT_V(0);
    if (wr == 0) G_BAR;
    G_BAR;
#undef G_SA
#undef G_SB
#undef G_STAGE_A
#undef G_STAGE_B
#undef G_LDA
#undef G_LDB
#undef G_MMA
#undef G_WAIT_V
#undef G_WAIT_L
#undef G_BAR
#undef G_SCHED
#undef G_SET_OFFS
}

__device__ __forceinline__ unsigned cvt_pk_bf16(float lo, float hi) { unsigned r; asm volatile("v_cvt_pk_bf16_f32 %0, %1, %2" : "=v"(r) : "v"(lo), "v"(hi)); return r; }

struct DenseSched {
    const char* A; const char* B; int lda2, ldb2, nt, nM, nN, G, c;
    __device__ __forceinline__ bool next(int i, Unit& u) const {
        const int Lx = i * G + c; if (Lx >= nM * nN) return false;
        const int pm = Lx / nN, pn = Lx % nN;
        u.A = A + (size_t)pm * BM * lda2; u.B = B + (size_t)pn * BM * ldb2; u.rows = nullptr; u.nvalid = 0; u.lda2 = lda2; u.ldb2 = ldb2; u.nt = nt; u.pm = pm; u.pn = pn; u.x0 = 0; u.x1 = 0; return true;
    }
};
}
namespace fk {
constexpr int RING_OFF = 0, RING_BYTES = STAGE_BYTES;
constexpr int MISC_OFF = RING_BYTES;
constexpr int LDS_BYTES = RING_BYTES + 1024;
struct Args { const float* in[54]; float* out; unsigned char* ws; int ph_lo, ph_hi, li, comb, rep_group, rep_n; };

struct Frame {
    LAS unsigned char* lds; volatile LAS unsigned* MISC;
    int tid, lane, wave, G, c;
    unsigned* ctl; unsigned char* ws;
};

__device__ __forceinline__ void transpose_item(const float* W, int ldw, int k0, int n0, bf16* dst, int ldd, LAS float* scr, int lane) {
#pragma unroll 8
    for (int i = 0; i < 32; ++i) { const int kk = 2 * i + (lane >> 5); scr[kk * 33 + (lane & 31)] = W[(size_t)(k0 + kk) * ldw + n0 + (lane & 31)]; }
    LDS_WAIT(); asm volatile("" ::: "memory");
    const int c = lane & 7;
#pragma unroll
    for (int j = 0; j < 4; ++j) { const int n = (lane >> 3) + 8 * j; const LAS float* s = scr + (8 * c) * 33 + n;
        v4u o; o.x = pk2(s[0 * 33], s[1 * 33]); o.y = pk2(s[2 * 33], s[3 * 33]); o.z = pk2(s[4 * 33], s[5 * 33]); o.w = pk2(s[6 * 33], s[7 * 33]);
        *(GAS v4u*)(dst + (size_t)n * ldd + 8 * c) = o; }
    LDS_WAIT(); asm volatile("" ::: "memory");
}

__device__ __forceinline__ void moe_convert(Frame& F, const Args& a, int l) {
    PHASE_IDS();
    LAS float* scr = (LAS float*)(F.lds + RING_OFF + wave * 16384);
    bf16* Wgu = (bf16*)(wsl + WS_WMOE); bf16* Wd = Wgu + (size_t)16 * 1024 * 1024;
    const float* wg = a.in[51] + (size_t)l * 16 * D * 512; const float* wu = a.in[52] + (size_t)l * 16 * D * 512; const float* wd = a.in[53] + (size_t)l * 16 * 512 * D;
    const int gw = F.c * NWAVES + wave, NGW = F.G * NWAVES;
    for (int it = gw; it < 3 * 4096; it += NGW) {
        const int which = it >> 12, r = it & 4095, e = r >> 8, q = r & 255;
        if (which < 2) { const int kb = q >> 4, nb = q & 15, k0 = kb * 64, n0 = nb * 32;
            const float* W = (which == 0 ? wg : wu) + (size_t)e * D * 512;
            bf16* dst = Wgu + ((size_t)e * 1024 + (n0 >> 7) * 256 + which * 128 + (n0 & 127)) * 1024 + k0;
            transpose_item(W, 512, k0, n0, dst, 1024, scr, lane);
        } else { const int kb = q >> 5, nb = q & 31, k0 = kb * 64, n0 = nb * 32;
            const float* W = wd + (size_t)e * 512 * D;
            bf16* dst = Wd + ((size_t)e * 1024 + n0) * 512 + k0;
            transpose_item(W, 1024, k0, n0, dst, 512, scr, lane);
        }
    }
}

__device__ __forceinline__ void moe_route(Frame& F, const Args& a, int l, int dry) {
    PHASE_IDS();
    LAS float* wt = (LAS float*)(F.lds + RING_OFF);
    const float* wg = a.in[47] + (size_t)l * D * 4; const float* we = a.in[49] + (size_t)l * D * 16;
    for (int i = tid; i < D * 4; i += NT) { const int d = i >> 2, q = i & 3; wt[q * 1024 + d] = wg[i]; }
    for (int i = tid; i < D * 16; i += NT) { const int d = i >> 4, q = i & 15; wt[(4 + q) * 1024 + d] = we[i]; }
    if (tid < 16) ((LAS unsigned*)(wt + 20 * 1024))[tid] = 0u;
    __syncthreads();
    const float* gain = a.in[3] + l * D; const float* bg = a.in[48] + l * 4; const float* be = a.in[50] + l * 16;
    f32x4 g[4];
#pragma unroll
    for (int j = 0; j < 4; ++j) g[j] = *(const f32x4*)(gain + 256 * j + 4 * lane);
    const float* H = (const float*)(wsl + WS_H); bf16* XN = (bf16*)(wsl + WS_ACT + A_XN);
    int* list = (int*)(wsl + WS_ACT + A_LIST); float* listw = (float*)(wsl + WS_ACT + A_LISTW); int* listd = (int*)(wsl + WS_ACT + A_LISTD);
    unsigned* cnt = F.ctl + CW_CNT + 1024 * l;
    LAS unsigned* lcnt = (LAS unsigned*)(wt + 20 * 1024); LAS unsigned* lbase = lcnt + 16; LAS unsigned* ent = lbase + 16;
    const int gw = F.c * NWAVES + wave, NGW = F.G * NWAVES;
    f32x4 v[4], vn[4];
    const int rchunk = (TP + F.G - 1) / F.G, rlim = (F.c + 1) * rchunk < TP ? (F.c + 1) * rchunk : TP, rfirst = F.c * rchunk + wave;
    { const int r0_ = rfirst; if (r0_ < rlim && (r0_ % LP) >= PRE) { const GAS f32x4* hr = (const GAS f32x4*)(H + (size_t)r0_ * D) + lane;
#pragma unroll
        for (int j = 0; j < 4; ++j) v[j] = hr[64 * j]; } }
    for (int row = rfirst; row < rlim; row += NWAVES) {
        { const int nrow = row + NWAVES; if (nrow < rlim && (nrow % LP) >= PRE) { const GAS f32x4* hr = (const GAS f32x4*)(H + (size_t)nrow * D) + lane;
#pragma unroll
            for (int j = 0; j < 4; ++j) vn[j] = hr[64 * j]; } }
        if ((row % LP) < PRE) {
#pragma unroll
            for (int j = 0; j < 4; ++j) v[j] = vn[j];
            continue; }
        float ss = 0.f;
#pragma unroll
        for (int j = 0; j < 4; ++j) ss += (v[j].x * v[j].x + v[j].y * v[j].y) + (v[j].z * v[j].z + v[j].w * v[j].w);
        const float rs = rsqrtf(wave_sum(ss) * (1.f / D) + RMS_EPS);
#pragma unroll
        for (int j = 0; j < 4; ++j) v[j] = v[j] * rs * g[j];
        GAS v2u* o8 = (GAS v2u*)(XN + (size_t)row * D) + lane;
#pragma unroll
        for (int j = 0; j < 4; ++j) { v2u w; w.x = pk2(v[j].x, v[j].y); w.y = pk2(v[j].z, v[j].w); o8[64 * j] = w; }
        float acc[20];
#pragma unroll
        for (int q = 0; q < 20; ++q) { float s = 0.f;
#pragma unroll
            for (int j = 0; j < 4; ++j) { const f32x4 w = *(const LAS f32x4*)(wt + q * 1024 + 256 * j + 4 * lane); s += (v[j].x * w.x + v[j].y * w.y) + (v[j].z * w.z + v[j].w * w.w); }
            acc[q] = wave_sum(s); }
        if (lane < 2 && !dry) {
            float lg[4]; int gi = 0; float mx = -3.0e38f;
#pragma unroll
            for (int q = 0; q < 4; ++q) { lg[q] = acc[q] + bg[q]; if (lg[q] > mx) { mx = lg[q]; gi = q; } }
            float den = 0.f;
#pragma unroll
            for (int q = 0; q < 4; ++q) den += __expf(lg[q] - mx);
            const float pg = 1.f / den;
            float le[4];
#pragma unroll
            for (int q = 0; q < 4; ++q) { float s = 0.f;
#pragma unroll
                for (int gq = 0; gq < 4; ++gq) s = (gq == gi) ? (acc[4 + gq * 4 + q] + be[gq * 4 + q]) : s;
                le[q] = s; }
            int i1 = 0; float v1 = le[0];
#pragma unroll
            for (int q = 1; q < 4; ++q) if (le[q] > v1) { v1 = le[q]; i1 = q; }
            int i2 = 0; float v2 = -3.0e38f;
#pragma unroll
            for (int q = 0; q < 4; ++q) if (q != i1 && le[q] > v2) { v2 = le[q]; i2 = q; }
            const float e2 = __expf(v2 - v1), s1 = 1.f / (1.f + e2), s2 = e2 / (1.f + e2);
            const int k = lane; const int e = gi * 4 + (k == 0 ? i1 : i2); const float gt = (k == 0 ? s1 : s2) * pg;
            const unsigned lp = __hip_atomic_fetch_add(lcnt + e, 1u, __ATOMIC_RELAXED, __HIP_MEMORY_SCOPE_WORKGROUP);
            const int ei = ((row - F.c * rchunk) * 2 + k) * 4; ent[ei] = (unsigned)row; ent[ei + 1] = (unsigned)e; ent[ei + 2] = __builtin_bit_cast(unsigned, gt); ent[ei + 3] = lp;
        }
#pragma unroll
        for (int j = 0; j < 4; ++j) v[j] = vn[j];
    }
    __syncthreads();
    if (tid < 16 && !dry) { const unsigned n = lcnt[tid]; lbase[tid] = n ? __hip_atomic_fetch_add(cnt + 64 * tid, n, __ATOMIC_RELAXED, __HIP_MEMORY_SCOPE_AGENT) : 0u; }
    __syncthreads();
    if (!dry) for (int i = tid; i < 2 * rchunk; i += NT) { const int row = F.c * rchunk + (i >> 1);
        if (row < rlim && (row % LP) >= PRE) { const unsigned e = ent[4 * i + 1]; const unsigned pos = lbase[e] + ent[4 * i + 3];
            list[(size_t)e * LISTCAP + pos] = (int)ent[4 * i]; listw[(size_t)e * LISTCAP + pos] = __builtin_bit_cast(float, ent[4 * i + 2]); listd[(size_t)e * LISTCAP + pos] = (int)ent[4 * i] * 2 + (i & 1); } }
    __syncthreads();
}

struct MoeSched {
    volatile LAS unsigned* tb;
    const char* A; const char* B; const int* list; int lda2, ldb2, nt, G, c, gather;
    __device__ __forceinline__ bool next(int i, Unit& u) const {
        const int Lx = i * G + c; const int ntot = __builtin_amdgcn_readfirstlane((int)tb[16]);
        if (Lx >= ntot * 4) return false;
        const int mt = Lx >> 2, pn = Lx & 3; int e = 0;
#pragma unroll
        for (int q = 1; q < 16; ++q) e = (__builtin_amdgcn_readfirstlane((int)tb[q]) <= mt) ? q : e;
        const int ti = mt - __builtin_amdgcn_readfirstlane((int)tb[e]); const int cn = __builtin_amdgcn_readfirstlane((int)tb[17 + e]) - ti * 256;
        u.nvalid = cn < 256 ? cn : 256; u.x0 = e; u.x1 = ti; u.pm = mt; u.pn = pn; u.lda2 = lda2; u.ldb2 = ldb2; u.nt = nt;
        u.B = B + ((size_t)e * 1024 + (size_t)pn * 256) * ldb2;
        if (gather) { u.A = A; u.rows = list + (size_t)e * LISTCAP + ti * 256; }
        else { u.A = A + (size_t)mt * 256 * lda2; u.rows = nullptr; }
        return true;
    }
};
__device__ __forceinline__ void moe_tables(Frame& F, int l) {
    PHASE_IDS();
    volatile LAS unsigned* tb = F.MISC + 64;
    __syncthreads();
    if (tid < 64) {
        const unsigned cn = lane < 16 ? __hip_atomic_load(F.ctl + CW_CNT + 1024 * l + 64 * lane, __ATOMIC_RELAXED, __HIP_MEMORY_SCOPE_AGENT) : 0u;
        unsigned s = 0;
#pragma unroll
        for (int e = 0; e < 16; ++e) { const unsigned ce = (unsigned)__builtin_amdgcn_readlane((int)cn, e); if (lane == 0) { tb[e] = s; tb[17 + e] = ce; } s += (ce + 255u) >> 8; }
        if (lane == 0) tb[16] = s;
    }
    __syncthreads();
}
struct EpiSwiglu {
    static constexpr bool PERM = true;
    bf16* hid; const float* listw;
    __device__ __forceinline__ void operator()(const f32x4 (&acc)[2][2][4][2], const Unit& u, int wr, int wc, int fr, int fq) const {
        const GAS float* lw = (const GAS float*)listw + (size_t)u.x0 * LISTCAP + u.x1 * 256;
        asm volatile("" : "+v"(fr));
        GAS unsigned char* hb = (GAS unsigned char*)hid + ((size_t)u.pm * 256 * 512 + u.pn * 128 + wc * 32) * 2;
#pragma unroll
        for (int ai = 0; ai < 2; ++ai)
#pragma unroll
            for (int m = 0; m < 4; ++m) {
                const int r = ai * HALF + wr * 64 + m * 16 + fr;
                const float cw = (r < u.nvalid) ? lw[r] : 0.f;
                float o[8];
#pragma unroll
                for (int n = 0; n < 2; ++n)
#pragma unroll
                    for (int q = 0; q < 4; ++q) { const float gv = acc[ai][0][m][n][q], uv = acc[ai][1][m][n][q]; o[n * 4 + q] = gv * sigmoid_f(gv) * uv * cw; }
                v4u w; w.x = cvt_pk_bf16(o[0], o[1]); w.y = cvt_pk_bf16(o[2], o[3]); w.z = cvt_pk_bf16(o[4], o[5]); w.w = cvt_pk_bf16(o[6], o[7]);
                *(GAS v4u*)(hb + (unsigned)(r * 1024 + fq * 16)) = w;
            }
    }
};
struct EpiScatter {
    static constexpr bool PERM = true;
    bf16* O; const int* listd;
    __device__ __forceinline__ void operator()(const f32x4 (&acc)[2][2][4][2], const Unit& u, int wr, int wc, int fr, int fq) const {
        const GAS int* ld = (const GAS int*)listd + (size_t)u.x0 * LISTCAP + u.x1 * 256;
        asm volatile("" : "+v"(fr));
        GAS unsigned char* ob = (GAS unsigned char*)O + (size_t)(u.pn * 256 + wc * 32) * 2;
#pragma unroll
        for (int ai = 0; ai < 2; ++ai)
#pragma unroll
            for (int m = 0; m < 4; ++m) {
                const int r = ai * HALF + wr * 64 + m * 16 + fr;
                if (r < u.nvalid) { const int dst = ld[r];
#pragma unroll
                    for (int bj = 0; bj < 2; ++bj) { const f32x4 v0 = acc[ai][bj][m][0], v1 = acc[ai][bj][m][1];
                        v4u w; w.x = cvt_pk_bf16(v0[0], v0[1]); w.y = cvt_pk_bf16(v0[2], v0[3]); w.z = cvt_pk_bf16(v1[0], v1[1]); w.w = cvt_pk_bf16(v1[2], v1[3]);
                        *(GAS v4u*)(ob + ((unsigned)dst * 2048u + (unsigned)(bj * 256 + fq * 16))) = w; } }
            }
    }
};

}
namespace fk {
constexpr size_t KiB = 1024;
constexpr size_t WM_AB_STRIDE = 14 * MiB;
constexpr size_t WM_WIN = 0;
constexpr size_t WM_WGLU = 3 * MiB;
constexpr size_t WM_WOUT = 3 * MiB + 512 * KiB;
constexpr size_t WM_LRUW = 5 * MiB + 512 * KiB;
constexpr size_t WM_APW = 5 * MiB + 768 * KiB;
constexpr size_t WM_BX = 6 * MiB;
constexpr size_t WM_TC = 8 * MiB;
constexpr size_t WM_RW = 28 * MiB;
constexpr size_t B_HN = 0;
constexpr size_t B_Z = B_HN + (size_t)TP * D * 2;
constexpr size_t B_YS = B_Z + (size_t)TP * 1536 * 2;
constexpr size_t B_CAT = B_YS + (size_t)TP * 512 * 2;
constexpr size_t B_SSA = B_CAT + (size_t)TP * D * 2;
constexpr size_t B_SSB = B_SSA + (size_t)TP * 8 * 4;
constexpr size_t B_END = B_SSB + (size_t)TP * 32 * 4;
static_assert(B_END <= ACT_BYTES, "AB activations fit");

__device__ __forceinline__ void s5_precompute(Frame& F, const Args& a, int j, int g) {
    PHASE_IDS();
    LAS f32x2* pw = (LAS f32x2*)(F.lds + RING_OFF);
    LAS f32x2* bbar = pw + 17 * 64;
    LAS f32x2* cc = bbar + 64 * 16;
    LAS float* Kl = (LAS float*)(cc + 16 * 64);
    unsigned char* wm = wsl + WS_WMIX + (size_t)j * WM_AB_STRIDE;
    __syncthreads();
    if (tid < 64) { const int p = tid;
        const float lr = a.in[9][(j * 32 + g) * 64 + p], li = a.in[10][(j * 32 + g) * 64 + p], dt = expf(a.in[11][j * 32 + g]);
#pragma unroll 1
        for (int lag = 0; lag <= 16; ++lag) { const float m = expf((float)lag * lr * dt); pw[lag * 64 + p] = (f32x2){m * cosf((float)lag * li * dt), m * sinf((float)lag * li * dt)}; }
        const float mag = expf(lr * dt), ar = mag * cosf(li * dt), ai = mag * sinf(li * dt), den = lr * lr + li * li;
        const float zr = ((ar - 1.f) * lr + ai * li) / den, zi = (ai * lr - (ar - 1.f) * li) / den;
        const float* bre = a.in[12] + ((size_t)(j * 32 + g) * 64 + p) * 16; const float* bim = a.in[13] + ((size_t)(j * 32 + g) * 64 + p) * 16;
#pragma unroll 1
        for (int h = 0; h < 16; ++h) { const float br = bre[h], bi = bim[h]; bbar[p * 16 + h] = (f32x2){zr * br - zi * bi, zr * bi + zi * br}; }
    }
    for (int i = tid; i < 1024; i += NT) cc[i] = (f32x2){a.in[14][(size_t)(j * 32 + g) * 1024 + i], a.in[15][(size_t)(j * 32 + g) * 1024 + i]};
    __syncthreads();
    if (tid < 64) ((f32x2*)(wm + WM_APW))[g * 64 + tid] = pw[16 * 64 + tid];
    for (int i = tid; i < 4096; i += NT) { const int lag = i >> 8, h = (i >> 4) & 15, hp = i & 15; float s = 0.f;
        for (int p = 0; p < 64; ++p) { const f32x2 w = pw[lag * 64 + p], bb = bbar[p * 16 + hp], c = cc[h * 64 + p];
            const float wr_ = w.x * bb.x - w.y * bb.y, wi_ = w.x * bb.y + w.y * bb.x; s += c.x * wr_ - c.y * wi_; }
        if (lag == 0 && h == hp) s += a.in[16][(j * 32 + g) * 16 + h];
        Kl[i] = s; }
    __syncthreads();
    bf16* TC = (bf16*)(wm + WM_TC) + (size_t)g * 256 * 384; bf16* BX = (bf16*)(wm + WM_BX) + (size_t)g * 128 * 256;
    for (int i = tid; i < 256 * 48; i += NT) { const int n = i / 48, ko = i % 48, t = n >> 4, h = n & 15; float v[8];
        if (ko < 32) { const int s = ko >> 1, hp0 = (ko & 1) * 8;
#pragma unroll
            for (int q = 0; q < 8; ++q) v[q] = (s <= t) ? Kl[((t - s) * 16 + h) * 16 + hp0 + q] : 0.f;
        } else { const int p0 = (ko - 32) * 4;
#pragma unroll
            for (int q = 0; q < 4; ++q) { const f32x2 c = cc[h * 64 + p0 + q], w = pw[(t + 1) * 64 + p0 + q]; v[2 * q] = c.x * w.x - c.y * w.y; v[2 * q + 1] = -(c.x * w.y + c.y * w.x); } }
        v4u o; o.x = pk2(v[0], v[1]); o.y = pk2(v[2], v[3]); o.z = pk2(v[4], v[5]); o.w = pk2(v[6], v[7]);
        *(GAS v4u*)(TC + (size_t)n * 384 + ko * 8) = o; }
    for (int i = tid; i < 128 * 32; i += NT) { const int n = i >> 5, ko = i & 31, p = n >> 1, im = n & 1, s = ko >> 1, hp0 = (ko & 1) * 8; float v[8];
        const f32x2 w = pw[(15 - s) * 64 + p];
#pragma unroll
        for (int q = 0; q < 8; ++q) { const f32x2 bb = bbar[p * 16 + hp0 + q]; v[q] = im ? (w.x * bb.y + w.y * bb.x) : (w.x * bb.x - w.y * bb.y); }
        v4u o; o.x = pk2(v[0], v[1]); o.y = pk2(v[2], v[3]); o.z = pk2(v[4], v[5]); o.w = pk2(v[6], v[7]);
        *(GAS v4u*)(BX + (size_t)n * 256 + ko * 8) = o; }
    __syncthreads();
}

__device__ __forceinline__ void prologue_ab(Frame& F, const Args& a) {
    PHASE_IDS();
    const int gw = F.c * NWAVES + wave, NGW = F.G * NWAVES;
    float* H = (float*)(wsl + WS_H);
    for (int row = gw; row < TP; row += NGW) { const int b = row / LP, t = row % LP - PRE;
        GAS f32x4* o = (GAS f32x4*)(H + (size_t)row * D) + lane;
        if (t < 0) {
#pragma unroll
            for (int q = 0; q < 4; ++q) o[64 * q] = (f32x4){0.f, 0.f, 0.f, 0.f};
        } else { const float* src = t < NMETA ? a.in[1] + (size_t)t * D : a.in[0] + ((size_t)b * SEQ + (t - NMETA)) * D;
#pragma unroll
            for (int q = 0; q < 4; ++q) o[64 * q] = ((const GAS f32x4*)src)[64 * q + lane]; } }
    LAS float* scr = (LAS float*)(F.lds + RING_OFF + wave * 16384);
    constexpr int I_IN = 16 * 48, I_GLU = 8 * 16, I_OUT = 16 * 32, I_LRU = 32, I_AB = I_IN + I_GLU + I_OUT + I_LRU;
    for (int it = gw; it < 2 * I_AB; it += NGW) { const int j = it / I_AB; int r = it % I_AB; unsigned char* wm = wsl + WS_WMIX + (size_t)j * WM_AB_STRIDE;
        if (r < I_IN) { const int kb = r / 48, nb = r % 48; transpose_item(a.in[5] + (size_t)j * D * 1536, 1536, kb * 64, nb * 32, (bf16*)(wm + WM_WIN) + (size_t)nb * 32 * 1024 + kb * 64, 1024, scr, lane); continue; } r -= I_IN;
        if (r < I_GLU) { const int kb = r / 16, nb = r % 16; transpose_item(a.in[17] + (size_t)j * 512 * 512, 512, kb * 64, nb * 32, (bf16*)(wm + WM_WGLU) + (size_t)nb * 32 * 512 + kb * 64, 512, scr, lane); continue; } r -= I_GLU;
        if (r < I_OUT) { const int kb = r / 32, nb = r % 32; transpose_item(a.in[6] + (size_t)j * D * D, 1024, kb * 64, nb * 32, (bf16*)(wm + WM_WOUT) + (size_t)nb * 32 * 1024 + kb * 64, 1024, scr, lane); continue; } r -= I_OUT;
        { const int hd = r >> 2, which = (r >> 1) & 1, nb = r & 1;
          transpose_item(a.in[which ? 23 : 21] + (size_t)(j * 8 + hd) * 4096, 64, 0, nb * 32, (bf16*)(wm + WM_LRUW) + ((size_t)hd * 128 + which * 64 + nb * 32) * 64, 64, scr, lane); }
    }
    __syncthreads();
    for (int u = F.c; u < 64; u += F.G) s5_precompute(F, a, u >> 5, u & 31);
}

struct RowBuf { f32x4 v[4]; v2u a[4], b[4]; };
__device__ __forceinline__ void row_issue(RowBuf& R, const float* H, const bf16* O, int row, int has_o, int lane) {
    const GAS f32x4* hr = (const GAS f32x4*)(H + (size_t)row * D) + lane;
#pragma unroll
    for (int q = 0; q < 4; ++q) R.v[q] = hr[64 * q];
    if (has_o) { const GAS v2u* o0 = (const GAS v2u*)(O + (size_t)row * 2 * D) + lane; const GAS v2u* o1 = o0 + 256;
#pragma unroll
        for (int q = 0; q < 4; ++q) { R.a[q] = o0[64 * q]; R.b[q] = o1[64 * q]; } }
}
__device__ __forceinline__ float row_finish(RowBuf& R, int has_o) {
    float ss = 0.f;
    if (has_o) {
#pragma unroll
        for (int q = 0; q < 4; ++q) { const v2u x = R.a[q], y = R.b[q];
            R.v[q].x += bflo(x.x) + bflo(y.x); R.v[q].y += bfhi(x.x) + bfhi(y.x); R.v[q].z += bflo(x.y) + bflo(y.y); R.v[q].w += bfhi(x.y) + bfhi(y.y); } }
#pragma unroll
    for (int q = 0; q < 4; ++q) ss += (R.v[q].x * R.v[q].x + R.v[q].y * R.v[q].y) + (R.v[q].z * R.v[q].z + R.v[q].w * R.v[q].w);
    return rsqrtf(wave_sum(ss) * (1.f / D) + RMS_EPS);
}
__device__ __forceinline__ void pass_norm(Frame& F, const float* gain, int has_o, bf16* out) {
    PHASE_IDS();
    const int gw = F.c * NWAVES + wave, NGW = F.G * NWAVES;
    f32x4 g[4];
#pragma unroll
    for (int q = 0; q < 4; ++q) g[q] = *(const GAS f32x4*)(gain + 256 * q + 4 * lane);
    const float* H = (const float*)(wsl + WS_H); const bf16* O = (const bf16*)(wsl + WS_O);
    RowBuf cur, nxt;
    const int rchunk = (TP + F.G - 1) / F.G, rlim = (F.c + 1) * rchunk < TP ? (F.c + 1) * rchunk : TP, rfirst = F.c * rchunk + wave;
    if (rfirst < rlim && (rfirst % LP) >= PRE) row_issue(cur, H, O, rfirst, has_o, lane);
    for (int row = rfirst; row < rlim; row += NWAVES) {
        const int nrow = row + NWAVES; if (nrow < rlim && (nrow % LP) >= PRE) row_issue(nxt, H, O, nrow, has_o, lane);
        GAS v2u* o8 = (GAS v2u*)(out + (size_t)row * D) + lane;
        if ((row % LP) < PRE) {
#pragma unroll
            for (int q = 0; q < 4; ++q) o8[64 * q] = (v2u){0u, 0u};
        } else { const float rs = row_finish(cur, has_o);
#pragma unroll
            for (int q = 0; q < 4; ++q) { const f32x4 x = cur.v[q] * rs * g[q]; v2u w; w.x = pk2(x.x, x.y); w.y = pk2(x.z, x.w); o8[64 * q] = w; } }
        cur = nxt;
    }
}
__device__ __forceinline__ void pass_final(Frame& F, const float* gain, float* out) {
    PHASE_IDS();
    const int gw = F.c * NWAVES + wave, NGW = F.G * NWAVES;
    f32x4 g[4];
#pragma unroll
    for (int q = 0; q < 4; ++q) g[q] = *(const GAS f32x4*)(gain + 256 * q + 4 * lane);
    const float* H = (const float*)(wsl + WS_H); const bf16* O = (const bf16*)(wsl + WS_O);
    RowBuf cur, nxt;
    const int rchunk = (NB * SEQ + F.G - 1) / F.G, rlim = (F.c + 1) * rchunk < NB * SEQ ? (F.c + 1) * rchunk : NB * SEQ, rfirst = F.c * rchunk + wave;
    if (rfirst < rlim) row_issue(cur, H, O, (rfirst / SEQ) * LP + PRE + NMETA + rfirst % SEQ, 1, lane);
    for (int r = rfirst; r < rlim; r += NWAVES) {
        const int nr = r + NWAVES; if (nr < rlim) row_issue(nxt, H, O, (nr / SEQ) * LP + PRE + NMETA + nr % SEQ, 1, lane);
        const float rs = row_finish(cur, 1);
        GAS f32x4* o = (GAS f32x4*)(out + (size_t)r * D) + lane;
#pragma unroll
        for (int q = 0; q < 4; ++q) o[64 * q] = cur.v[q] * rs * g[q];
        cur = nxt;
    }
}

struct EpiBf16 {
    static constexpr bool PERM = true;
    bf16* O; int ldo;
    __device__ __forceinline__ void operator()(const f32x4 (&acc)[2][2][4][2], const Unit& u, int wr, int wc, int fr, int fq) const {
        asm volatile("" : "+v"(fr));
        GAS unsigned char* ob = (GAS unsigned char*)O + ((size_t)u.pm * 256 * ldo + u.pn * 256 + wc * 32) * 2;
#pragma unroll
        for (int ai = 0; ai < 2; ++ai)
#pragma unroll
            for (int m = 0; m < 4; ++m) { const int r = ai * HALF + wr * 64 + m * 16 + fr;
#pragma unroll
                for (int bj = 0; bj < 2; ++bj) { const f32x4 v0 = acc[ai][bj][m][0], v1 = acc[ai][bj][m][1];
                    v4u w; w.x = cvt_pk_bf16(v0[0], v0[1]); w.y = cvt_pk_bf16(v0[2], v0[3]); w.z = cvt_pk_bf16(v1[0], v1[1]); w.w = cvt_pk_bf16(v1[2], v1[3]);
                    *(GAS v4u*)(ob + ((unsigned)r * (unsigned)ldo * 2u + (unsigned)(bj * 256 + fq * 16))) = w; } }
    }
};
struct EpiGlu {
    static constexpr bool PERM = true;
    const bf16* YS; bf16* CAT; const float* bglu; float* SSA;
    __device__ __forceinline__ void operator()(const f32x4 (&acc)[2][2][4][2], const Unit& u, int wr, int wc, int fr, int fq) const {
        asm volatile("" : "+v"(fr));
        f32x4 bv[2][2];
#pragma unroll
        for (int bj = 0; bj < 2; ++bj)
#pragma unroll
            for (int n = 0; n < 2; ++n) bv[bj][n] = *(const GAS f32x4*)(bglu + u.pn * 256 + bj * HALF + wc * 32 + fq * 8 + 4 * n);
#pragma unroll
        for (int ai = 0; ai < 2; ++ai)
#pragma unroll
            for (int m = 0; m < 4; ++m) { const int r = ai * HALF + wr * 64 + m * 16 + fr; const size_t row = (size_t)u.pm * 256 + r; float ss = 0.f;
#pragma unroll
                for (int bj = 0; bj < 2; ++bj) { const int col = u.pn * 256 + bj * HALF + wc * 32 + fq * 8;
                    const v4u y = *(const GAS v4u*)(YS + row * 512 + col); const f32x4 v0 = acc[ai][bj][m][0] + bv[bj][0], v1 = acc[ai][bj][m][1] + bv[bj][1];
                    float o[8]; o[0] = bflo(y.x) * sigmoid_f(v0[0]); o[1] = bfhi(y.x) * sigmoid_f(v0[1]); o[2] = bflo(y.y) * sigmoid_f(v0[2]); o[3] = bfhi(y.y) * sigmoid_f(v0[3]);
                    o[4] = bflo(y.z) * sigmoid_f(v1[0]); o[5] = bfhi(y.z) * sigmoid_f(v1[1]); o[6] = bflo(y.w) * sigmoid_f(v1[2]); o[7] = bfhi(y.w) * sigmoid_f(v1[3]);
#pragma unroll
                    for (int q = 0; q < 8; ++q) ss += o[q] * o[q];
                    v4u w; w.x = cvt_pk_bf16(o[0], o[1]); w.y = cvt_pk_bf16(o[2], o[3]); w.z = cvt_pk_bf16(o[4], o[5]); w.w = cvt_pk_bf16(o[6], o[7]);
                    *(GAS v4u*)(CAT + row * 1024 + col) = w; }
                ss += __shfl_xor(ss, 16); ss += __shfl_xor(ss, 32);
                if (fq == 0) ((GAS float*)SSA)[row * 8 + u.pn * 4 + wc] = ss; }
    }
};
struct EpiResid {
    static constexpr bool PERM = false;
    float* H; const bf16* O; int has_o; int dry;
    __device__ __forceinline__ void operator()(const f32x4 (&acc)[2][2][4][2], const Unit& u, int wr, int wc, int fr, int fq) const {
        asm volatile("" : "+v"(fr));
#pragma unroll
        for (int ai = 0; ai < 2; ++ai)
#pragma unroll
            for (int m = 0; m < 4; ++m) { const size_t row = (size_t)u.pm * 256 + ai * HALF + wr * 64 + m * 16 + fr;
#pragma unroll
                for (int bj = 0; bj < 2; ++bj)
#pragma unroll
                    for (int n = 0; n < 2; ++n) { const int col = u.pn * 256 + bj * HALF + wc * 32 + n * 16 + fq * 4;
                        GAS f32x4* hp = (GAS f32x4*)(H + row * D + col); f32x4 v = *hp + acc[ai][bj][m][n];
                        if (has_o) { const v2u x = *(const GAS v2u*)(O + row * 2 * D + col), y = *(const GAS v2u*)(O + row * 2 * D + D + col);
                            v.x += bflo(x.x) + bflo(y.x); v.y += bfhi(x.x) + bfhi(y.x); v.z += bflo(x.y) + bflo(y.y); v.w += bfhi(x.y) + bfhi(y.y); }
                        if (!dry) *hp = v; } }
    }
};

constexpr int S5_UP = 264, S5_XP = 136;
__device__ __forceinline__ void s5_unit(Frame& F, int j, int b, int g) {
    PHASE_IDS();
    const int fr = lane & 15, fq = lane >> 4;
    LAS bf16* Uc = (LAS bf16*)(F.lds + RING_OFF); LAS bf16* EX = Uc + 144 * S5_UP;
    const unsigned char* wm = wsl + WS_WMIX + (size_t)j * WM_AB_STRIDE;
    const bf16* Z = (const bf16*)(wsl + WS_ACT + B_Z); bf16* YS = (bf16*)(wsl + WS_ACT + B_YS);
    const bf16* BX = (const bf16*)(wm + WM_BX) + (size_t)g * 128 * 256; const bf16* TC = (const bf16*)(wm + WM_TC) + (size_t)g * 256 * 384;
    const size_t row0 = (size_t)b * LP + PRE;
    __syncthreads();
    for (int i = tid; i < L * 2; i += NT) { const int t = i >> 1, hf = i & 1;
        const v4u x = *(const GAS v4u*)(Z + (row0 + t) * 1536 + g * 16 + hf * 8);
        *(LAS v4u*)(Uc + (t >> 4) * S5_UP + (t & 15) * 16 + hf * 8) = x; }
    __syncthreads();
    {
        f32x4 acc[9];
#pragma unroll
        for (int mt = 0; mt < 9; ++mt) acc[mt] = (f32x4){0.f, 0.f, 0.f, 0.f};
#pragma unroll 2
        for (int ks = 0; ks < 8; ++ks) { const bf16x8 bf = *(const GAS bf16x8*)(BX + (size_t)(16 * wave + fr) * 256 + 32 * ks + 8 * fq);
#pragma unroll
            for (int mt = 0; mt < 9; ++mt) { const bf16x8 af = *(const LAS bf16x8*)(Uc + (16 * mt + fr) * S5_UP + 32 * ks + 8 * fq); acc[mt] = __builtin_amdgcn_mfma_f32_16x16x32_bf16(bf, af, acc[mt], 0, 0, 0); } }
#pragma unroll
        for (int mt = 0; mt < 9; ++mt) { v2u w; w.x = pk2(acc[mt][0], acc[mt][1]); w.y = pk2(acc[mt][2], acc[mt][3]); *(LAS v2u*)(EX + (16 * mt + fr) * S5_XP + 16 * wave + 4 * fq) = w; }
    }
    __syncthreads();
    if (tid < 64) {
        const f32x2 A = ((const GAS f32x2*)(wm + WM_APW))[g * 64 + tid]; float xr = 0.f, xi = 0.f;
        LAS unsigned* ex = (LAS unsigned*)EX + tid;
#pragma unroll 4
        for (int c = 0; c < 129; ++c) { const unsigned e = ex[c * (S5_XP / 2)]; ex[c * (S5_XP / 2)] = pk2(xr, xi);
            const float er = bflo(e), ei = bfhi(e); const float nr = A.x * xr - A.y * xi + er, ni = A.x * xi + A.y * xr + ei; xr = nr; xi = ni; }
    }
    __syncthreads();
    {
        f32x4 acc[2][9];
#pragma unroll
        for (int nt = 0; nt < 2; ++nt)
#pragma unroll
            for (int mt = 0; mt < 9; ++mt) acc[nt][mt] = (f32x4){0.f, 0.f, 0.f, 0.f};
#pragma unroll 2
        for (int ks = 0; ks < 12; ++ks) {
            bf16x8 bf[2];
#pragma unroll
            for (int nt = 0; nt < 2; ++nt) bf[nt] = *(const GAS bf16x8*)(TC + (size_t)(16 * (2 * wave + nt) + fr) * 384 + 32 * ks + 8 * fq);
#pragma unroll
            for (int mt = 0; mt < 9; ++mt) { const bf16x8 af = (ks < 8) ? *(const LAS bf16x8*)(Uc + (16 * mt + fr) * S5_UP + 32 * ks + 8 * fq) : *(const LAS bf16x8*)(EX + (16 * mt + fr) * S5_XP + 32 * (ks - 8) + 8 * fq);
#pragma unroll
                for (int nt = 0; nt < 2; ++nt) acc[nt][mt] = __builtin_amdgcn_mfma_f32_16x16x32_bf16(bf[nt], af, acc[nt][mt], 0, 0, 0); } }
#pragma unroll
        for (int nt = 0; nt < 2; ++nt)
#pragma unroll
            for (int mt = 0; mt < 9; ++mt) { const int c = 16 * mt + fr, tt = 16 * c + 2 * wave + nt;
                if (tt < L) { const f32x4 y = acc[nt][mt]; v2u w; w.x = pk2(gelu_tanh_f(y[0]), gelu_tanh_f(y[1])); w.y = pk2(gelu_tanh_f(y[2]), gelu_tanh_f(y[3]));
                    *(GAS v2u*)(YS + (row0 + tt) * 512 + g * 16 + 4 * fq) = w; } }
    }
}

__device__ __forceinline__ void lru_unit(Frame& F, const Args& a, int j, int b, int hd, int q4) {
    PHASE_IDS();
    const int fr = lane & 15, fq = lane >> 4;
    constexpr int XP = 72;
    LAS bf16* XC = (LAS bf16*)(F.lds + RING_OFF);
    LAS f32x2* ABv = (LAS f32x2*)(F.lds + RING_OFF + 128 * XP * 2);
    LAS f32x2* PS = ABv + 128 * 16;
    LAS float* carry = (LAS float*)(PS + 32 * 16);
    const unsigned char* wm = wsl + WS_WMIX + (size_t)j * WM_AB_STRIDE;
    const bf16* Z = (const bf16*)(wsl + WS_ACT + B_Z); bf16* CAT = (bf16*)(wsl + WS_ACT + B_CAT); float* SSB = (float*)(wsl + WS_ACT + B_SSB);
    const size_t row0 = (size_t)b * LP + PRE;
    const int cbase = hd * 64;
    const bf16* LW = (const bf16*)(wm + WM_LRUW) + (size_t)hd * 128 * 64;
    bf16x8 wa[2], wx[2];
#pragma unroll
    for (int ks = 0; ks < 2; ++ks) { wa[ks] = *(const GAS bf16x8*)(LW + (size_t)(16 * q4 + fr) * 64 + 32 * ks + 8 * fq); wx[ks] = *(const GAS bf16x8*)(LW + (size_t)(64 + 16 * q4 + fr) * 64 + 32 * ks + 8 * fq); }
    const int oc = tid & 7; float cw[4][8], cb[8];
#pragma unroll
    for (int e = 0; e < 8; ++e) { cb[e] = a.in[20][j * 512 + cbase + 8 * oc + e];
#pragma unroll
        for (int k = 0; k < 4; ++k) cw[k][e] = a.in[19][(j * 4 + k) * 512 + cbase + 8 * oc + e]; }
    float ba[4], bx[4], sp8[4];
#pragma unroll
    for (int e = 0; e < 4; ++e) { const int c = cbase + 16 * q4 + 4 * fq + e; ba[e] = a.in[22][j * 512 + c]; bx[e] = a.in[24][j * 512 + c]; const float lam = a.in[25][j * 512 + c]; sp8[e] = 8.0f * (lam < -20.f ? -lam : log1pf(__expf(-lam))); }
    const int cc = tid & 15, sub = tid >> 4; const int cs = cbase + 16 * q4 + cc;
    __syncthreads();
    if (tid < 16) carry[tid] = 0.f;
    v4u rec[2][4];
#define LRU_LOAD_REC(t0) do { _Pragma("unroll") for (int i = 0; i < 2; ++i) { const int tl = (tid + 512 * i) >> 3; \
        _Pragma("unroll") for (int k = 0; k < 4; ++k) { const int tt = (t0) + tl - 3 + k; \
            rec[i][k] = (tt >= 0 && tt < L) ? *(const GAS v4u*)(Z + (row0 + tt) * 1536 + 1024 + cbase + 8 * oc) : (v4u){0u, 0u, 0u, 0u}; } } } while (0)
    LRU_LOAD_REC(0);
    for (int tile = 0; tile < 17; ++tile) { const int t0 = tile * 128;
        unsigned short gz[4];
#pragma unroll
        for (int s = 0; s < 4; ++s) { const int tt = t0 + 4 * sub + s; gz[s] = tt < L ? ((const GAS unsigned short*)Z)[(row0 + tt) * 1536 + 512 + cs] : (unsigned short)0; }
#pragma unroll
        for (int i = 0; i < 2; ++i) { const int tl = (tid + 512 * i) >> 3; float x[8];
#pragma unroll
            for (int e = 0; e < 8; ++e) x[e] = cb[e];
#pragma unroll
            for (int k = 0; k < 4; ++k) { const v4u r = rec[i][k];
                x[0] += cw[k][0] * bflo(r.x); x[1] += cw[k][1] * bfhi(r.x); x[2] += cw[k][2] * bflo(r.y); x[3] += cw[k][3] * bfhi(r.y);
                x[4] += cw[k][4] * bflo(r.z); x[5] += cw[k][5] * bfhi(r.z); x[6] += cw[k][6] * bflo(r.w); x[7] += cw[k][7] * bfhi(r.w); }
            v4u w; w.x = pk2(x[0], x[1]); w.y = pk2(x[2], x[3]); w.z = pk2(x[4], x[5]); w.w = pk2(x[6], x[7]);
            *(LAS v4u*)(XC + tl * XP + 8 * oc) = w; }
        if (tile < 16) LRU_LOAD_REC(t0 + 128);
        __syncthreads();
        {
            const int tl = 16 * wave + fr; f32x4 ra = (f32x4){0.f, 0.f, 0.f, 0.f}, rx = ra;
#pragma unroll
            for (int ks = 0; ks < 2; ++ks) { const bf16x8 af = *(const LAS bf16x8*)(XC + tl * XP + 32 * ks + 8 * fq);
                ra = __builtin_amdgcn_mfma_f32_16x16x32_bf16(wa[ks], af, ra, 0, 0, 0); rx = __builtin_amdgcn_mfma_f32_16x16x32_bf16(wx[ks], af, rx, 0, 0, 0); }
            const v2u xq = *(const LAS v2u*)(XC + tl * XP + 16 * q4 + 4 * fq); const float xv[4] = {bflo(xq.x), bfhi(xq.x), bflo(xq.y), bfhi(xq.y)};
            const bool valid = (t0 + tl) < L;
#pragma unroll
            for (int e = 0; e < 4; ++e) { const float r = sigmoid_f(ra[e] + ba[e]), ig = sigmoid_f(rx[e] + bx[e]); const float la = -r * sp8[e];
                const float av = __expf(la), bv = sqrtf(-expm1f(2.f * la)) * (ig * xv[e]);
                f32x2 abw; abw.x = valid ? av : 1.f; abw.y = valid ? bv : 0.f; ABv[tl * 16 + 4 * fq + e] = abw; }
        }
        __syncthreads();
        {
            float P = 1.f, hl = 0.f;
#pragma unroll
            for (int s = 0; s < 4; ++s) { const f32x2 ab = ABv[(4 * sub + s) * 16 + cc]; hl = ab.x * hl + ab.y; P *= ab.x; }
            PS[sub * 16 + cc] = (f32x2){P, hl};
        }
        __syncthreads();
        {
            float h = carry[cc];
            for (int s2 = 0; s2 < sub; ++s2) { const f32x2 ps = PS[s2 * 16 + cc]; h = ps.x * h + ps.y; }
#pragma unroll
            for (int s = 0; s < 4; ++s) { const int tt = t0 + 4 * sub + s; const f32x2 ab = ABv[(4 * sub + s) * 16 + cc]; h = ab.x * h + ab.y;
                const float o = gelu_tanh_f(bf2f(gz[s])) * h; float ss = o * o;
                ss = sum16(ss);
                if (tt < L) { ((GAS unsigned short*)CAT)[(row0 + tt) * 1024 + 512 + cs] = (unsigned short)f2bf(o); if (cc == 0) ((GAS float*)SSB)[(row0 + tt) * 32 + hd * 4 + q4] = ss; } }
            __syncthreads();
            if (sub == 31) carry[cc] = h;
        }
        __syncthreads();
    }
#undef LRU_LOAD_REC
}

__device__ __forceinline__ void pass_abnorm(Frame& F, const float* na, const float* nb, int dry) {
    PHASE_IDS();
    const int gw = F.c * NWAVES + wave, NGW = F.G * NWAVES;
    bf16* CAT = (bf16*)(wsl + WS_ACT + B_CAT); const float* SSA = (const float*)(wsl + WS_ACT + B_SSA); const float* SSB = (const float*)(wsl + WS_ACT + B_SSB);
    float ga[8], gb[8];
#pragma unroll
    for (int e = 0; e < 8; ++e) { ga[e] = na[8 * lane + e]; gb[e] = nb[8 * lane + e]; }
    const int rchunk = (TP + F.G - 1) / F.G, rlim = (F.c + 1) * rchunk < TP ? (F.c + 1) * rchunk : TP;
    for (int row = F.c * rchunk + wave; row < rlim; row += NWAVES) {
        GAS v4u* p = (GAS v4u*)(CAT + (size_t)row * 1024) + lane;
        if ((row % LP) < PRE) { p[0] = (v4u){0u, 0u, 0u, 0u}; p[64] = (v4u){0u, 0u, 0u, 0u}; continue; }
        float sa = 0.f, sb = 0.f;
#pragma unroll
        for (int e = 0; e < 8; ++e) sa += ((const GAS float*)SSA)[(size_t)row * 8 + e];
#pragma unroll
        for (int e = 0; e < 32; ++e) sb += ((const GAS float*)SSB)[(size_t)row * 32 + e];
        const float ra = rsqrtf(sa * (1.f / 512.f) + RMS_EPS), rb = rsqrtf(sb * (1.f / 512.f) + RMS_EPS);
        v4u x = p[0], y = p[64];
        x.x = pk2(bflo(x.x) * ra * ga[0], bfhi(x.x) * ra * ga[1]); x.y = pk2(bflo(x.y) * ra * ga[2], bfhi(x.y) * ra * ga[3]); x.z = pk2(bflo(x.z) * ra * ga[4], bfhi(x.z) * ra * ga[5]); x.w = pk2(bflo(x.w) * ra * ga[6], bfhi(x.w) * ra * ga[7]);
        y.x = pk2(bflo(y.x) * rb * gb[0], bfhi(y.x) * rb * gb[1]); y.y = pk2(bflo(y.y) * rb * gb[2], bfhi(y.y) * rb * gb[3]); y.z = pk2(bflo(y.z) * rb * gb[4], bfhi(y.z) * rb * gb[5]); y.w = pk2(bflo(y.w) * rb * gb[6], bfhi(y.w) * rb * gb[7]);
        if (!dry) { p[0] = x; p[64] = y; }
    }
}
}
namespace fk {
constexpr size_t WM_RW_STRIDE = 11 * MiB;
constexpr size_t RW_WRKV = 0;
constexpr size_t RW_WO = 6 * MiB;
constexpr size_t RW_L1 = 8 * MiB;
constexpr size_t RW_W2W = 10 * MiB;
constexpr size_t RW_W2A = 10 * MiB + 128 * KiB;
constexpr size_t RW_W2G = 10 * MiB + 256 * KiB;
constexpr size_t RW_W2V = 10 * MiB + 512 * KiB;
static_assert(WM_RW + 2 * WM_RW_STRIDE <= 50 * MiB, "mixer weights fit");
constexpr size_t RB = (size_t)TP * D * 2;
constexpr size_t R_HN = 0;
constexpr size_t R_XR = 1 * RB, R_XK = 2 * RB, R_XV = 3 * RB;
constexpr size_t R_R = 4 * RB, R_K = 5 * RB, R_V = 6 * RB;
constexpr size_t R_L1 = 7 * RB;
constexpr size_t R_END = R_L1 + (size_t)TP * 512 * 2;
static_assert(R_END <= ACT_BYTES, "RWKV activations fit");

__device__ __forceinline__ void transpose_item_s(const float* W, int ldw, int k0, int n0, bf16* dst, int ldd, LAS float* scr, int lane, const float* mu, int mode, int kcount) {
    for (int i = 0; i < kcount / 2; ++i) { const int kk = 2 * i + (lane >> 5); float s = 1.f; if (mode == 1) s = mu[k0 + kk]; else if (mode == 2) s = 1.f - mu[k0 + kk];
        scr[kk * 33 + (lane & 31)] = W[(size_t)(k0 + kk) * ldw + n0 + (lane & 31)] * s; }
    LDS_WAIT(); asm volatile("" ::: "memory");
    const int c = lane & 7;
    if (8 * c < kcount) {
#pragma unroll
        for (int jj = 0; jj < 4; ++jj) { const int n = (lane >> 3) + 8 * jj; const LAS float* s = scr + (8 * c) * 33 + n;
            v4u o; o.x = pk2(s[0 * 33], s[1 * 33]); o.y = pk2(s[2 * 33], s[3 * 33]); o.z = pk2(s[4 * 33], s[5 * 33]); o.w = pk2(s[6 * 33], s[7 * 33]);
            *(GAS v4u*)(dst + (size_t)n * ldd + 8 * c) = o; } }
    LDS_WAIT(); asm volatile("" ::: "memory");
}
__device__ __forceinline__ void prologue_rw(Frame& F, const Args& a) {
    PHASE_IDS();
    const int gw = F.c * NWAVES + wave, NGW = F.G * NWAVES;
    LAS float* scr = (LAS float*)(F.lds + RING_OFF + wave * 16384);
    constexpr int I_SQ = 512, I_L1 = 288, I_W2 = 32 + 32 + 64 + 32, I_RW = 4 * I_SQ + I_L1 + I_W2;
    for (int it = gw; it < 2 * I_RW; it += NGW) { const int j = it / I_RW; int r = it % I_RW; unsigned char* wm = wsl + WS_WMIX + WM_RW + (size_t)j * WM_RW_STRIDE;
        if (r < 4 * I_SQ) { const int m = r / I_SQ, q = r % I_SQ, kb = q >> 5, nb = q & 31;
            const float* W = a.in[m == 0 ? 27 : m == 1 ? 28 : m == 2 ? 29 : 30] + (size_t)j * D * D;
            bf16* dst = (m < 3 ? (bf16*)(wm + RW_WRKV) + (size_t)m * D * D : (bf16*)(wm + RW_WO)) + (size_t)nb * 32 * 1024 + kb * 64;
            transpose_item_s(W, 1024, kb * 64, nb * 32, dst, 1024, scr, lane, nullptr, 0, 64); continue; } r -= 4 * I_SQ;
        if (r < I_L1) { const int part = r & 1, q = r >> 1, kb = q & 15, nbx = q >> 4;
            const float* mu = a.in[26] + (size_t)j * 6 * D; const float* W; int ldw, n0, muix, drow;
            if (nbx < 2) { W = a.in[32] + (size_t)j * D * 64; ldw = 64; n0 = nbx * 32; muix = 1; drow = n0; }
            else if (nbx < 4) { W = a.in[35] + (size_t)j * D * 64; ldw = 64; n0 = (nbx - 2) * 32; muix = 4; drow = 64 + n0; }
            else if (nbx < 8) { W = a.in[40] + (size_t)j * D * 128; ldw = 128; n0 = (nbx - 4) * 32; muix = 5; drow = 128 + n0; }
            else { if (j == 0) continue; W = a.in[38] + (size_t)(j - 1) * D * 32; ldw = 32; n0 = 0; muix = 3; drow = 256; }
            bf16* dst = (bf16*)(wm + RW_L1) + (size_t)drow * 2048 + part * 1024 + kb * 64;
            transpose_item_s(W, ldw, kb * 64, n0, dst, 2048, scr, lane, mu + muix * D, part == 0 ? 1 : 2, 64); continue; } r -= I_L1;
        if (r < 32) { transpose_item_s(a.in[33] + (size_t)j * 64 * D, 1024, 0, r * 32, (bf16*)(wm + RW_W2W) + (size_t)r * 32 * 64, 64, scr, lane, nullptr, 0, 64); continue; } r -= 32;
        if (r < 32) { transpose_item_s(a.in[36] + (size_t)j * 64 * D, 1024, 0, r * 32, (bf16*)(wm + RW_W2A) + (size_t)r * 32 * 64, 64, scr, lane, nullptr, 0, 64); continue; } r -= 32;
        if (r < 64) { const int kb = r >> 5, nb = r & 31; transpose_item_s(a.in[41] + (size_t)j * 128 * D, 1024, kb * 64, nb * 32, (bf16*)(wm + RW_W2G) + (size_t)nb * 32 * 128 + kb * 64, 128, scr, lane, nullptr, 0, 64); continue; } r -= 64;
        if (j > 0) transpose_item_s(a.in[39] + (size_t)(j - 1) * 32 * D, 1024, 0, r * 32, (bf16*)(wm + RW_W2V) + (size_t)r * 32 * 32, 32, scr, lane, nullptr, 0, 32);
    }
    { GAS v4u* z = (GAS v4u*)(wsl + WS_WMIX + WM_RW + WM_RW_STRIDE + RW_L1 + (size_t)288 * 2048 * 2); const int n16 = 224 * 2048 * 2 / 16;
      for (int i = F.c * NT + tid; i < n16; i += F.G * NT) z[i] = (v4u){0u, 0u, 0u, 0u}; }
}

__device__ __forceinline__ void pass_rwin(Frame& F, const float* gain, const float* mu, int has_o) {
    PHASE_IDS();
    const int gw = F.c * NWAVES + wave, NGW = F.G * NWAVES;
    f32x4 g[4], mr[4], mk[4], mv[4];
#pragma unroll
    for (int q = 0; q < 4; ++q) { g[q] = *(const GAS f32x4*)(gain + 256 * q + 4 * lane); mr[q] = *(const GAS f32x4*)(mu + 0 * D + 256 * q + 4 * lane); mk[q] = *(const GAS f32x4*)(mu + 2 * D + 256 * q + 4 * lane); mv[q] = *(const GAS f32x4*)(mu + 3 * D + 256 * q + 4 * lane); }
    const float* H = (const float*)(wsl + WS_H); const bf16* O = (const bf16*)(wsl + WS_O);
    unsigned char* act = wsl + WS_ACT;
    const int uchunk = (TP / 8 + F.G - 1) / F.G, ulim = (F.c + 1) * uchunk < TP / 8 ? (F.c + 1) * uchunk : TP / 8;
    for (int run = F.c * uchunk + wave; run < ulim; run += NWAVES) { const int r0 = run * 8, rb = run % (LP / 8);
        f32x4 prev[4];
#pragma unroll
        for (int q = 0; q < 4; ++q) prev[q] = (f32x4){0.f, 0.f, 0.f, 0.f};
        if (rb < 2) {
            for (int rr = 0; rr < 8; ++rr) { const int row = r0 + rr;
                GAS v2u* o0 = (GAS v2u*)(act + R_HN + (size_t)row * D * 2) + lane; GAS v2u* o1 = (GAS v2u*)(act + R_XR + (size_t)row * D * 2) + lane;
                GAS v2u* o2 = (GAS v2u*)(act + R_XK + (size_t)row * D * 2) + lane; GAS v2u* o3 = (GAS v2u*)(act + R_XV + (size_t)row * D * 2) + lane;
#pragma unroll
                for (int q = 0; q < 4; ++q) { o0[64 * q] = (v2u){0u, 0u}; o1[64 * q] = (v2u){0u, 0u}; o2[64 * q] = (v2u){0u, 0u}; o3[64 * q] = (v2u){0u, 0u}; } }
            continue; }
        RowBuf cur, nxt;
        const int first = (rb > 2) ? -1 : 0;
        row_issue(cur, H, O, r0 + first, has_o, lane);
        for (int rr = first; rr < 8; ++rr) { const int row = r0 + rr;
            if (rr < 7) row_issue(nxt, H, O, row + 1, has_o, lane);
            const float rs = row_finish(cur, has_o);
            if (rr < 0) {
#pragma unroll
                for (int q = 0; q < 4; ++q) prev[q] = cur.v[q] * rs * g[q];
            } else {
                GAS v2u* o0 = (GAS v2u*)(act + R_HN + (size_t)row * D * 2) + lane; GAS v2u* o1 = (GAS v2u*)(act + R_XR + (size_t)row * D * 2) + lane;
                GAS v2u* o2 = (GAS v2u*)(act + R_XK + (size_t)row * D * 2) + lane; GAS v2u* o3 = (GAS v2u*)(act + R_XV + (size_t)row * D * 2) + lane;
#pragma unroll
                for (int q = 0; q < 4; ++q) { const f32x4 cu = cur.v[q] * rs * g[q], dx = prev[q] - cu; prev[q] = cu;
                    const f32x4 xr = cu + dx * mr[q], xk = cu + dx * mk[q], xv = cu + dx * mv[q];
                    v2u w; w.x = pk2(cu.x, cu.y); w.y = pk2(cu.z, cu.w); o0[64 * q] = w;
                    w.x = pk2(xr.x, xr.y); w.y = pk2(xr.z, xr.w); o1[64 * q] = w;
                    w.x = pk2(xk.x, xk.y); w.y = pk2(xk.z, xk.w); o2[64 * q] = w;
                    w.x = pk2(xv.x, xv.y); w.y = pk2(xv.z, xv.w); o3[64 * q] = w; } }
            cur = nxt;
        }
    }
}

struct RwSched {
    const char* act; const char* wm; int nl  , G, c;
    __device__ __forceinline__ void single(int s, Unit& u) const { const int which = s / 260, rem = s % 260, pm = rem >> 2, pn = rem & 3;
        u.A = act + (which == 0 ? R_XR : which == 1 ? R_XK : R_XV) + (size_t)pm * 256 * 2048; u.B = wm + RW_WRKV + ((size_t)which * 1024 + pn * 256) * 2048;
        u.rows = nullptr; u.nvalid = 0; u.lda2 = 2048; u.ldb2 = 2048; u.nt = 16; u.pm = pm; u.pn = pn; u.x0 = which; u.x1 = 0; }
    __device__ __forceinline__ void dbl(int d, Unit& u) const { const int pm = d / nl, pn = d % nl;
        u.A = act + R_HN + ((size_t)pm * 256 - 1) * 2048; u.B = wm + RW_L1 + (size_t)pn * 256 * 4096;
        u.rows = nullptr; u.nvalid = 0; u.lda2 = 2048; u.ldb2 = 4096; u.nt = 32; u.pm = pm; u.pn = pn; u.x0 = 3; u.x1 = 0; }
    __device__ __forceinline__ bool next(int i, Unit& u) const {
        const int nd = 65 * nl, ns = 780; int rho;
        if (c < nd) { if (i == 0) { dbl(c, u); return true; } rho = (i - 1) * G + c; }
        else { if (i < 2) { const int s = 2 * (c - nd) + i; if (s >= ns) return false; single(s, u); return true; } rho = (i - 2) * G + c; }
        const int s = 2 * (G - nd) + rho; if (s >= ns || G < nd) return false;
        single(s, u); return true;
    }
};
struct EpiRw {
    static constexpr bool PERM = true;
    bf16* Rb; bf16* Kb; bf16* Vb; bf16* L1b;
    __device__ __forceinline__ void operator()(const f32x4 (&acc)[2][2][4][2], const Unit& u, int wr, int wc, int fr, int fq) const {
        asm volatile("" : "+v"(fr));
        const int lora = (u.x0 == 3); const int ldo = lora ? 512 : 1024;
        GAS unsigned char* ob = (GAS unsigned char*)(u.x0 == 0 ? Rb : u.x0 == 1 ? Kb : u.x0 == 2 ? Vb : L1b) + ((size_t)u.pm * 256 * ldo + u.pn * 256 + wc * 32) * 2;
#pragma unroll
        for (int bj = 0; bj < 2; ++bj) { const int act = (lora && u.pn == 0) ? (bj == 0 ? (wc < 2 ? 1 : 0) : 2) : 0;
#pragma unroll
            for (int ai = 0; ai < 2; ++ai)
#pragma unroll
                for (int m = 0; m < 4; ++m) { const int r = ai * HALF + wr * 64 + m * 16 + fr; float o[8];
#pragma unroll
                    for (int n = 0; n < 2; ++n)
#pragma unroll
                        for (int q = 0; q < 4; ++q) { const float x = acc[ai][bj][m][n][q]; o[n * 4 + q] = act == 1 ? (2.f * sigmoid_f(2.f * x) - 1.f) : act == 2 ? sigmoid_f(x) : x; }
                    v4u w; w.x = cvt_pk_bf16(o[0], o[1]); w.y = cvt_pk_bf16(o[2], o[3]); w.z = cvt_pk_bf16(o[4], o[5]); w.w = cvt_pk_bf16(o[6], o[7]);
                    *(GAS v4u*)(ob + ((unsigned)r * (unsigned)ldo * 2u + (unsigned)(bj * 256 + fq * 16))) = w; } }
    }
};

__device__ __forceinline__ void rw_prep_unit(Frame& F, const Args& a, int j, int hd, int rng, int dry) {
    PHASE_IDS();
    const int fr = lane & 15, fq = lane >> 4;
    constexpr int PW = 72, PG = 136, PV = 40;
    LAS bf16* Lw = (LAS bf16*)(F.lds + RING_OFF); LAS bf16* La = Lw + 64 * PW; LAS bf16* Lg = La + 64 * PW; LAS bf16* Lv = Lg + 64 * PG;
    LAS float* cst = (LAS float*)(Lv + 64 * PV);
    const unsigned char* wm = wsl + WS_WMIX + WM_RW + (size_t)j * WM_RW_STRIDE; unsigned char* act = wsl + WS_ACT;
    __syncthreads();
    for (int i = tid; i < 64 * 8; i += NT) { const int n = i >> 3, c8 = i & 7;
        *(LAS v4u*)(Lw + n * PW + 8 * c8) = *(const GAS v4u*)((const bf16*)(wm + RW_W2W) + (size_t)(hd * 64 + n) * 64 + 8 * c8);
        *(LAS v4u*)(La + n * PW + 8 * c8) = *(const GAS v4u*)((const bf16*)(wm + RW_W2A) + (size_t)(hd * 64 + n) * 64 + 8 * c8); }
    for (int i = tid; i < 64 * 16; i += NT) { const int n = i >> 4, c8 = i & 15; *(LAS v4u*)(Lg + n * PG + 8 * c8) = *(const GAS v4u*)((const bf16*)(wm + RW_W2G) + (size_t)(hd * 64 + n) * 128 + 8 * c8); }
    if (j > 0) for (int i = tid; i < 64 * 4; i += NT) { const int n = i >> 2, c8 = i & 3; *(LAS v4u*)(Lv + n * PV + 8 * c8) = *(const GAS v4u*)((const bf16*)(wm + RW_W2V) + (size_t)(hd * 64 + n) * 32 + 8 * c8); }
    if (tid < 64) { const int c = hd * 64 + tid; cst[tid] = a.in[31][j * D + c]; cst[64 + tid] = a.in[34][j * D + c]; cst[128 + tid] = j > 0 ? a.in[37][(j - 1) * D + c] : 0.f; cst[192 + tid] = a.in[42][j * D + c]; cst[256 + tid] = a.in[43][j * D + c]; }
    __syncthreads();
    const bf16* L1 = (const bf16*)(act + R_L1); bf16* Kb = (bf16*)(act + R_K); bf16* Vb = (bf16*)(act + R_V); const bf16* VF = (const bf16*)(wsl + WS_VF);
    bf16* WLb = (bf16*)(act + R_XR); bf16* KKb = (bf16*)(act + R_XK); bf16* BBb = (bf16*)(act + R_XV); bf16* GGb = (bf16*)(act + R_HN);
    for (int tile = rng * 65 + wave; tile < rng * 65 + 65; tile += NWAVES) {
        if (tile % (LP / 16) == 0) continue;
        const size_t row = (size_t)tile * 16 + fr;
        const bf16* lr = L1 + row * 512 + 8 * fq;
        bf16x8 aw[2], aa[2], ag[4], av;
#pragma unroll
        for (int ks = 0; ks < 2; ++ks) { aw[ks] = *(const GAS bf16x8*)(lr + 32 * ks); aa[ks] = *(const GAS bf16x8*)(lr + 64 + 32 * ks); }
#pragma unroll
        for (int ks = 0; ks < 4; ++ks) ag[ks] = *(const GAS bf16x8*)(lr + 128 + 32 * ks);
        av = *(const GAS bf16x8*)(lr + 256);
        const size_t cb = row * D + hd * 64 + 4 * fq;
        float kx[4][4], aq[4][4], kq[4][4]; float ss = 0.f;
#pragma unroll
        for (int nt = 0; nt < 4; ++nt) { f32x4 ca = (f32x4){0.f, 0.f, 0.f, 0.f};
#pragma unroll
            for (int ks = 0; ks < 2; ++ks) ca = __builtin_amdgcn_mfma_f32_16x16x32_bf16(*(const LAS bf16x8*)(La + (16 * nt + fr) * PW + 32 * ks + 8 * fq), aa[ks], ca, 0, 0, 0);
            const v2u kk2 = *(const GAS v2u*)(Kb + cb + 16 * nt); const float kv[4] = {bflo(kk2.x), bfhi(kk2.x), bflo(kk2.y), bfhi(kk2.y)};
#pragma unroll
            for (int e = 0; e < 4; ++e) { const int ch = 16 * nt + 4 * fq + e; aq[nt][e] = sigmoid_f(cst[64 + ch] + ca[e]); kq[nt][e] = kv[e]; kx[nt][e] = kv[e] * cst[192 + ch]; ss += kx[nt][e] * kx[nt][e]; } }
        ss += __shfl_xor(ss, 16); ss += __shfl_xor(ss, 32);
        const float inv = 1.f / fmaxf(sqrtf(ss), 1e-12f);
#pragma unroll
        for (int nt = 0; nt < 4; ++nt) { f32x4 cw_ = (f32x4){0.f, 0.f, 0.f, 0.f}, cg = cw_, cv = cw_;
#pragma unroll
            for (int ks = 0; ks < 2; ++ks) cw_ = __builtin_amdgcn_mfma_f32_16x16x32_bf16(*(const LAS bf16x8*)(Lw + (16 * nt + fr) * PW + 32 * ks + 8 * fq), aw[ks], cw_, 0, 0, 0);
#pragma unroll
            for (int ks = 0; ks < 4; ++ks) cg = __builtin_amdgcn_mfma_f32_16x16x32_bf16(*(const LAS bf16x8*)(Lg + (16 * nt + fr) * PG + 32 * ks + 8 * fq), ag[ks], cg, 0, 0, 0);
            if (j > 0) cv = __builtin_amdgcn_mfma_f32_16x16x32_bf16(*(const LAS bf16x8*)(Lv + (16 * nt + fr) * PV + 8 * fq), av, cv, 0, 0, 0);
            float wl[4], kn[4], bb[4], k2[4];
#pragma unroll
            for (int e = 0; e < 4; ++e) { const int ch = 16 * nt + 4 * fq + e; const float x = cst[ch] + cw_[e];
                const float sp = (-x > 20.f) ? -x : log1pf(__expf(-x)); wl[e] = -__expf(-sp - 0.5f);
                kn[e] = kx[nt][e] * inv; bb[e] = kn[e] * aq[nt][e]; k2[e] = kq[nt][e] * (1.f + (aq[nt][e] - 1.f) * cst[256 + ch]); }
            if (dry) continue;
            v2u w; const size_t off = cb + 16 * nt;
            w.x = pk2(wl[0], wl[1]); w.y = pk2(wl[2], wl[3]); *(GAS v2u*)(WLb + off) = w;
            w.x = pk2(kn[0], kn[1]); w.y = pk2(kn[2], kn[3]); *(GAS v2u*)(KKb + off) = w;
            w.x = pk2(bb[0], bb[1]); w.y = pk2(bb[2], bb[3]); *(GAS v2u*)(BBb + off) = w;
            w.x = pk2(k2[0], k2[1]); w.y = pk2(k2[2], k2[3]); *(GAS v2u*)(Kb + off) = w;
            w.x = pk2(cg[0], cg[1]); w.y = pk2(cg[2], cg[3]); *(GAS v2u*)(GGb + off) = w;
            if (j > 0) { const v2u v2 = *(const GAS v2u*)(Vb + off), f2 = *(const GAS v2u*)(VF + off); const float vv[4] = {bflo(v2.x), bfhi(v2.x), bflo(v2.y), bfhi(v2.y)}, vf[4] = {bflo(f2.x), bfhi(f2.x), bflo(f2.y), bfhi(f2.y)}; float vo[4];
#pragma unroll
                for (int e = 0; e < 4; ++e) { const int ch = 16 * nt + 4 * fq + e; vo[e] = vv[e] + (vf[e] - vv[e]) * sigmoid_f(cst[128 + ch] + cv[e]); }
                w.x = pk2(vo[0], vo[1]); w.y = pk2(vo[2], vo[3]); *(GAS v2u*)(Vb + off) = w; }
        }
    }
}

__device__ __forceinline__ void wkv_unit(Frame& F, const Args& a, int j, int b, int hd, int dry) {
    PHASE_IDS();
    constexpr int TB = 32;
    LAS float* buf = (LAS float*)(F.lds + RING_OFF);
    LAS float* yb = buf + 2 * 6 * TB * 64;
    unsigned char* act = wsl + WS_ACT;
    const int ahi = tid >> 8;
    const bf16* src0 = (const bf16*)(act + (ahi ? R_XR : R_XK)); const bf16* src1 = (const bf16*)(act + (ahi ? R_K : R_XV));
    const bf16* src2 = ahi ? (j == 0 ? (const bf16*)(wsl + WS_VF) : (const bf16*)(act + R_V)) : (const bf16*)(act + R_R);
    bf16* GG = (bf16*)(act + R_HN);
    const size_t row0 = (size_t)b * LP + PRE; const int cbase = hd * 64;
    const int i = tid >> 3, jo = tid & 7;
    float S[8];
#pragma unroll
    for (int e = 0; e < 8; ++e) S[e] = 0.f;
    v4u st[3];
#define WKV_LOAD(t0) do { _Pragma("unroll") for (int q = 0; q < 3; ++q) { const int tk = (tid >> 3) & 31, c8 = tid & 7; const int tt = (t0) + tk; const bf16* sp_ = q == 0 ? src0 : q == 1 ? src1 : src2; \
        st[q] = tt < L ? *(const GAS v4u*)(sp_ + (row0 + tt) * D + cbase + 8 * c8) : (v4u){0u, 0u, 0u, 0u}; } } while (0)
#define WKV_STORE(bi) do { _Pragma("unroll") for (int q = 0; q < 3; ++q) { const int p = tid + NT * q, arr = p >> 8, tk = (p >> 3) & 31, c8 = p & 7; \
        float x[8] = {bflo(st[q].x), bfhi(st[q].x), bflo(st[q].y), bfhi(st[q].y), bflo(st[q].z), bfhi(st[q].z), bflo(st[q].w), bfhi(st[q].w)}; \
        if (arr == 0) { _Pragma("unroll") for (int e = 0; e < 8; ++e) x[e] = -x[e]; } \
        if (arr == 1) { _Pragma("unroll") for (int e = 0; e < 8; ++e) x[e] = __expf(x[e]); } \
        LAS f32x4* d = (LAS f32x4*)(buf + ((bi) * 6 + arr) * TB * 64 + tk * 64 + 8 * c8); d[0] = (f32x4){x[0], x[1], x[2], x[3]}; d[1] = (f32x4){x[4], x[5], x[6], x[7]}; } } while (0)
    const float* rk = a.in[44] + (size_t)(j * 16 + hd) * 64; const float* lnw = a.in[45] + j * D + cbase; const float* lnb = a.in[46] + j * D + cbase;
    __syncthreads();
    WKV_LOAD(0); WKV_STORE(0);
    __syncthreads();
    constexpr int NBLK = (L + TB - 1) / TB;
    for (int blk = 0; blk < NBLK; ++blk) { const int bi = blk & 1, t0 = blk * TB;
        if (blk + 1 < NBLK) WKV_LOAD(t0 + TB);
        const LAS float* A_ = buf + (bi * 6 + 0) * TB * 64 + 8 * jo; const LAS float* W_ = buf + (bi * 6 + 1) * TB * 64 + 8 * jo; const LAS float* B_ = buf + (bi * 6 + 2) * TB * 64 + 8 * jo;
        const LAS float* K_ = buf + (bi * 6 + 3) * TB * 64 + 8 * jo; const LAS float* R_ = buf + (bi * 6 + 4) * TB * 64 + 8 * jo; const LAS float* V_ = buf + (bi * 6 + 5) * TB * 64 + i;
#pragma unroll 2
        for (int tk = 0; tk < TB; ++tk) {
            const f32x4 a0 = *(const LAS f32x4*)(A_ + tk * 64), a1 = *(const LAS f32x4*)(A_ + tk * 64 + 4), w0 = *(const LAS f32x4*)(W_ + tk * 64), w1 = *(const LAS f32x4*)(W_ + tk * 64 + 4);
            const f32x4 b0 = *(const LAS f32x4*)(B_ + tk * 64), b1 = *(const LAS f32x4*)(B_ + tk * 64 + 4), k0 = *(const LAS f32x4*)(K_ + tk * 64), k1 = *(const LAS f32x4*)(K_ + tk * 64 + 4);
            const f32x4 r0 = *(const LAS f32x4*)(R_ + tk * 64), r1 = *(const LAS f32x4*)(R_ + tk * 64 + 4); const float vi = V_[tk * 64];
            float sa = (S[0] * a0.x + S[1] * a0.y) + (S[2] * a0.z + S[3] * a0.w) + (S[4] * a1.x + S[5] * a1.y) + (S[6] * a1.z + S[7] * a1.w);
            sa = sum8(sa);
            S[0] = S[0] * w0.x + (sa * b0.x + vi * k0.x); S[1] = S[1] * w0.y + (sa * b0.y + vi * k0.y); S[2] = S[2] * w0.z + (sa * b0.z + vi * k0.z); S[3] = S[3] * w0.w + (sa * b0.w + vi * k0.w);
            S[4] = S[4] * w1.x + (sa * b1.x + vi * k1.x); S[5] = S[5] * w1.y + (sa * b1.y + vi * k1.y); S[6] = S[6] * w1.z + (sa * b1.z + vi * k1.z); S[7] = S[7] * w1.w + (sa * b1.w + vi * k1.w);
            float y = (S[0] * r0.x + S[1] * r0.y) + (S[2] * r0.z + S[3] * r0.w) + (S[4] * r1.x + S[5] * r1.y) + (S[6] * r1.z + S[7] * r1.w);
            y = sum8(y);
            if (jo == 0) yb[tk * 64 + i] = y;
        }
        __syncthreads();
        {
            const int tk = tid >> 4, i4 = 4 * (tid & 15), tt = t0 + tk;
            const f32x4 y4 = *(const LAS f32x4*)(yb + tk * 64 + i4);
            const f32x4 r4 = *(const LAS f32x4*)(buf + (bi * 6 + 4) * TB * 64 + tk * 64 + i4), k4 = *(const LAS f32x4*)(buf + (bi * 6 + 3) * TB * 64 + tk * 64 + i4), v4 = *(const LAS f32x4*)(buf + (bi * 6 + 5) * TB * 64 + tk * 64 + i4);
            const f32x4 rk4 = *(const GAS f32x4*)(rk + i4);
            float s1 = (y4.x + y4.y) + (y4.z + y4.w), s3 = (r4.x * k4.x * rk4.x + r4.y * k4.y * rk4.y) + (r4.z * k4.z * rk4.z + r4.w * k4.w * rk4.w);
            s1 = sum16(s1); s3 = sum16(s3);
            const float mean = s1 * (1.f / 64.f); const f32x4 d4 = y4 - mean; float s2 = (d4.x * d4.x + d4.y * d4.y) + (d4.z * d4.z + d4.w * d4.w);
            s2 = sum16(s2);
            const float rstd = rsqrtf(s2 * (1.f / 64.f) + 64e-5f);
            if (tt < L && !dry) { GAS v2u* gp = (GAS v2u*)(GG + (row0 + tt) * D + cbase + i4); const v2u g2 = *gp; const f32x4 lw4 = *(const GAS f32x4*)(lnw + i4), lb4 = *(const GAS f32x4*)(lnb + i4);
                const float o0 = (d4.x * rstd * lw4.x + lb4.x + s3 * v4.x) * bflo(g2.x), o1 = (d4.y * rstd * lw4.y + lb4.y + s3 * v4.y) * bfhi(g2.x);
                const float o2 = (d4.z * rstd * lw4.z + lb4.z + s3 * v4.z) * bflo(g2.y), o3 = (d4.w * rstd * lw4.w + lb4.w + s3 * v4.w) * bfhi(g2.y);
                v2u w; w.x = pk2(o0, o1); w.y = pk2(o2, o3); *gp = w; }
        }
        if (blk + 1 < NBLK) WKV_STORE(bi ^ 1);
        __syncthreads();
    }
#undef WKV_LOAD
#undef WKV_STORE
}
}
namespace fk {
__global__ void __launch_bounds__(NT, 2) mega(Args args) {
    extern __shared__ __attribute__((aligned(16))) unsigned char lds_raw[];
    Frame F;
    F.lds = (LAS unsigned char*)lds_raw; F.MISC = (volatile LAS unsigned*)(F.lds + MISC_OFF);
    F.tid = threadIdx.x; F.lane = F.tid & 63; F.wave = __builtin_amdgcn_readfirstlane(F.tid >> 6);
    F.G = gridDim.x; F.c = blockIdx.x; F.ws = args.ws; F.ctl = (unsigned*)(args.ws + WS_CTL);
    for (int u = F.tid; u < 256; u += NT) F.MISC[u] = 0u;
    __syncthreads();
    XcdBarrier bar = xcd_barrier_post(F.ctl + CW_BAR + args.li * XCD_BAR_WORDS, F.MISC + 8);
    const int lo = args.ph_lo, hi = args.ph_hi;
#define IN(k) (lo <= (k) && (k) < hi)
#if defined(PROBE) && PROBE
#define REP(grp) for (int rep_ = 0, nrep_ = (args.rep_group == (grp)) ? args.rep_n : 1; rep_ < nrep_; ++rep_)
#define DRY (rep_ + 1 < nrep_ ? 1 : 0)
#else
#define REP(grp)
#define DRY 0
#endif
#if defined(STAMP) && STAMP
    unsigned long long tacc = 0ull, tlast = __builtin_amdgcn_s_memrealtime();
#define TICK(cls) do { const unsigned long long tn_ = __builtin_amdgcn_s_memrealtime(); if ((STAMP_SEL >> (cls)) & 1) tacc += tn_ - tlast; tlast = tn_; } while (0)
#define SEAM(k) do { TICK(ptype_); if ((k) + 1 < hi) { xcd_barrier(bar); } TICK(20); } while (0)
#define PT(ty) const int ptype_ = (ty)
#else
#define TICK(cls)
#define PT(ty)
#define SEAM(k) do { if ((k) + 1 < hi) { REP(8) xcd_barrier(bar); } } while (0)
#endif
    if (IN(0)) { PT(0); REP(5) { prologue_ab(F, args); prologue_rw(F, args); } SEAM(0); }
    for (int l = 0; l < 4; ++l) {
        const int pb = 1 + 20 * l; const int has_o = (args.comb && l > 0) ? 1 : 0;
        unsigned char* wsl = F.ws; asm volatile("" : "+s"(wsl));
        if ((l & 1) == 0) {
            const int j = l >> 1; unsigned char* wm = wsl + WS_WMIX + (size_t)j * WM_AB_STRIDE; unsigned char* act = wsl + WS_ACT;
            if (IN(pb + 0)) { PT(1); REP(3) pass_norm(F, args.in[2] + l * D, has_o, (bf16*)(act + B_HN)); SEAM(pb + 0); }
            if (IN(pb + 1)) { PT(2);
                DenseSched S{(const char*)(act + B_HN), (const char*)(wm + WM_WIN), 2048, 2048, 16, TP / 256, 6, F.G, F.c};
                EpiBf16 E{(bf16*)(act + B_Z), 1536};
                REP(1) gemm_stream<EpiBf16, DenseSched, false>(F.lds + RING_OFF, S, E);
                SEAM(pb + 1);
            }
            if (IN(pb + 2)) { PT(3);
                REP(4) for (int u = F.c; u < 512; u += F.G) { if (u < 256) lru_unit(F, args, j, u >> 5, (u >> 2) & 7, u & 3); else s5_unit(F, j, (u - 256) >> 5, (u - 256) & 31); }
                SEAM(pb + 2);
            }
            if (IN(pb + 3)) { PT(4);
                DenseSched S{(const char*)(act + B_YS), (const char*)(wm + WM_WGLU), 1024, 1024, 8, TP / 256, 2, F.G, F.c};
                EpiGlu E{(const bf16*)(act + B_YS), (bf16*)(act + B_CAT), args.in[18] + j * 512, (float*)(act + B_SSA)};
                REP(1) gemm_stream<EpiGlu, DenseSched, false>(F.lds + RING_OFF, S, E);
                SEAM(pb + 3);
            }
            if (IN(pb + 4)) { PT(5); REP(3) pass_abnorm(F, args.in[7] + j * 512, args.in[8] + j * 512, DRY); SEAM(pb + 4); }
            if (IN(pb + 5)) { PT(6);
                DenseSched S{(const char*)(act + B_CAT), (const char*)(wm + WM_WOUT), 2048, 2048, 16, TP / 256, 4, F.G, F.c};
                EpiResid E{(float*)(wsl + WS_H), (const bf16*)(wsl + WS_O), has_o, 0};
                REP(1) { E.dry = DRY; gemm_stream<EpiResid, DenseSched, false>(F.lds + RING_OFF, S, E); }
                SEAM(pb + 5);
            }
        }
        if ((l & 1) == 1) {
            const int j = l >> 1; unsigned char* wm = wsl + WS_WMIX + WM_RW + (size_t)j * WM_RW_STRIDE; unsigned char* act = wsl + WS_ACT;
            if (IN(pb + 0)) { PT(7); REP(3) pass_rwin(F, args.in[2] + l * D, args.in[26] + (size_t)j * 6 * D, has_o); SEAM(pb + 0); }
            if (IN(pb + 1)) { PT(8);
                RwSched S{(const char*)act, (const char*)wm, j == 0 ? 1 : 2, F.G, F.c};
                EpiRw E{(bf16*)(act + R_R), (bf16*)(act + R_K), j == 0 ? (bf16*)(wsl + WS_VF) : (bf16*)(act + R_V), (bf16*)(act + R_L1)};
                REP(1) gemm_stream<EpiRw, RwSched, false>(F.lds + RING_OFF, S, E);
                SEAM(pb + 1);
            }
            if (IN(pb + 2)) { PT(9); REP(6) for (int u = F.c; u < 256; u += F.G) rw_prep_unit(F, args, j, u >> 4, u & 15, DRY); SEAM(pb + 2); }
            if (IN(pb + 3)) { PT(10); REP(2) for (int u = F.c; u < 128; u += F.G) wkv_unit(F, args, j, u >> 4, u & 15, DRY); SEAM(pb + 3); }
            if (IN(pb + 4)) { PT(11);
                DenseSched S{(const char*)(act + R_HN), (const char*)(wm + RW_WO), 2048, 2048, 16, TP / 256, 4, F.G, F.c};
                EpiResid E{(float*)(wsl + WS_H), (const bf16*)(wsl + WS_O), has_o, 0};
                REP(1) { E.dry = DRY; gemm_stream<EpiResid, DenseSched, false>(F.lds + RING_OFF, S, E); }
                SEAM(pb + 4);
            }
        }
        if (IN(pb + 9)) { PT(12); REP(5) moe_convert(F, args, l); SEAM(pb + 9); }
        if (IN(pb + 10)) { PT(13); REP(3) moe_route(F, args, l, DRY); SEAM(pb + 10); }
        if (IN(pb + 11)) { PT(14);
            REP(7) moe_tables(F, l);
            MoeSched S{F.MISC + 64, (const char*)(wsl + WS_ACT + A_XN), (const char*)(wsl + WS_WMOE), (const int*)(wsl + WS_ACT + A_LIST), 2048, 2048, 16, F.G, F.c, 1};
            EpiSwiglu E{(bf16*)(wsl + WS_ACT + A_HID), (const float*)(wsl + WS_ACT + A_LISTW)};
            REP(1) gemm_stream<EpiSwiglu, MoeSched, true>(F.lds + RING_OFF, S, E);
            SEAM(pb + 11);
        }
        if (IN(pb + 12)) { PT(15);
            REP(7) moe_tables(F, l);
            MoeSched S{F.MISC + 64, (const char*)(wsl + WS_ACT + A_HID), (const char*)(wsl + WS_WMOE + (size_t)16 * 1024 * 1024 * 2), nullptr, 1024, 1024, 8, F.G, F.c, 0};
            EpiScatter E{(bf16*)(wsl + WS_O), (const int*)(wsl + WS_ACT + A_LISTD)};
            REP(1) gemm_stream<EpiScatter, MoeSched, false>(F.lds + RING_OFF, S, E);
            SEAM(pb + 12);
        }
    }
    if (IN(90)) { REP(3) pass_final(F, args.in[4], args.out); TICK(16); }
#if defined(STAMP) && STAMP
    if (blockIdx.x == 0 && threadIdx.x == 0) { const unsigned long long t0_ = __builtin_amdgcn_s_memrealtime(); while (__builtin_amdgcn_s_memrealtime() - t0_ < tacc * (unsigned long long)(STAMP_AMP)) __builtin_amdgcn_s_sleep(8); }
#endif
#undef IN
#undef SEAM
}
}
extern "C" void kernel_launch(void* const* d_in, const int* in_sizes, int n_in, void* d_out, int out_size, void* d_ws, size_t ws_size, hipStream_t stream) {
    using namespace fk;
    static int grid = 0;
    if (grid == 0) {
        int dev = 0, cus = 0;
        if (ws_size < WS_END || n_in != 54) { fprintf(stderr, "kernel_launch: bad sizes (ws %zu)\n", ws_size); grid = -1; return; }
        if (hipGetDevice(&dev) != hipSuccess || hipDeviceGetAttribute(&cus, hipDeviceAttributeMultiprocessorCount, dev) != hipSuccess) { grid = -1; return; }
        if (hipFuncSetAttribute((const void*)mega, hipFuncAttributeMaxDynamicSharedMemorySize, LDS_BYTES) != hipSuccess) { fprintf(stderr, "hipFuncSetAttribute failed\n"); grid = -1; return; }
        int per_cu = 0; (void)hipOccupancyMaxActiveBlocksPerMultiprocessor(&per_cu, (const void*)mega, NT, LDS_BYTES); (void)hipGetLastError();
        grid = cus;
    }
    if (grid < 0) return;
    unsigned char* ws = (unsigned char*)d_ws;
    (void)hipMemsetAsync(ws + WS_CTL, 0, CTL_ZERO_BYTES, stream);
    Args a{}; for (int i = 0; i < 54; ++i) a.in[i] = (const float*)d_in[i]; a.out = (float*)d_out; a.ws = ws; a.comb = 1;
    a.ph_lo = 0; a.ph_hi = 91; a.li = 0;
#if defined(PROBE) && PROBE
    a.rep_group = PROBE_GROUP; a.rep_n = PROBE_N;
#endif
    hipLaunchKernelGGL(mega, dim3(grid), dim3(NT), LDS_BYTES, stream, a);
}
```

```cpp
#include <hip/hip_runtime.h>
#include <cstdio>
#include <cstdint>
#define GAS __attribute__((address_space(1)))
#define LAS __attribute__((address_space(3)))
typedef unsigned short bf16;
typedef unsigned v4u __attribute__((ext_vector_type(4)));
typedef unsigned v2u __attribute__((ext_vector_type(2)));
typedef float f32x4 __attribute__((ext_vector_type(4)));
typedef float f32x2 __attribute__((ext_vector_type(2)));
typedef short bf16x8 __attribute__((ext_vector_type(8)));
#define LDS_WAIT() asm volatile("s_waitcnt lgkmcnt(0)" ::: "memory")
#define PHASE_IDS() int tid = threadIdx.x; asm volatile("" : "+v"(tid)); const int lane = tid & 63; const int wave = __builtin_amdgcn_readfirstlane(tid >> 6); (void)lane; (void)wave; unsigned char* wsl = F.ws; asm volatile("" : "+s"(wsl))
#define VM_WAIT() asm volatile("s_waitcnt vmcnt(0)" ::: "memory")
#define LDS_BARRIER() do { asm volatile("s_waitcnt lgkmcnt(0)" ::: "memory"); __builtin_amdgcn_s_barrier(); asm volatile("" ::: "memory"); } while (0)

namespace fk {
constexpr int D = 1024, NB = 8, SEQ = 2048, NMETA = 16, L = SEQ + NMETA, PRE = 16, LP = L + PRE, TP = NB * LP;
constexpr int NWAVES = 8, NT = 512;
constexpr float RMS_EPS = 1e-6f;
static_assert(TP % 256 == 0, "row padding");
constexpr int MOE_ROWS = 37120;
constexpr int LISTCAP = TP;

constexpr size_t MiB = 1u << 20;
constexpr size_t WS_CTL = 0, CTL_ZERO_BYTES = 1 * MiB;
constexpr size_t WS_WMIX = 1 * MiB;
constexpr size_t WS_WMOE = 51 * MiB;
constexpr size_t WS_H = 99 * MiB;
constexpr size_t WS_VF = 164 * MiB;
constexpr size_t WS_O = WS_VF + (size_t)TP * D * 2;
constexpr size_t WS_ACT = WS_O + (size_t)TP * 2 * D * 2;
constexpr size_t WS_END = 512 * MiB;
constexpr size_t ACT_BYTES = WS_END - WS_ACT;
constexpr size_t A_XN = 0;
constexpr size_t A_HID = A_XN + (size_t)TP * D * 2;
constexpr size_t A_LIST = A_HID + (size_t)MOE_ROWS * 512 * 2;
constexpr size_t A_LISTW = A_LIST + (size_t)16 * LISTCAP * 4;
constexpr size_t A_LISTD = A_LISTW + (size_t)16 * LISTCAP * 4;
constexpr size_t A_MOE_END = A_LISTD + (size_t)16 * LISTCAP * 4;
static_assert(A_MOE_END <= ACT_BYTES, "MoE activations fit");
constexpr int CW_BAR = 4096;
constexpr int CW_Q = 65536;
constexpr int CW_DONE = 98304;
constexpr int CW_CNT = 131072;

__device__ __forceinline__ unsigned f2bf(float f) { unsigned u = __builtin_bit_cast(unsigned, f); return (u + 0x7fffu + ((u >> 16) & 1u)) >> 16; }
__device__ __forceinline__ unsigned pk2(float lo, float hi) { return f2bf(lo) | (f2bf(hi) << 16); }
__device__ __forceinline__ float bf2f(unsigned b) { return __builtin_bit_cast(float, b << 16); }
__device__ __forceinline__ float bflo(unsigned w) { return __builtin_bit_cast(float, w << 16); }
__device__ __forceinline__ float bfhi(unsigned w) { return __builtin_bit_cast(float, w & 0xffff0000u); }
template <int CTRL> __device__ __forceinline__ float dpp_mov(float x) { return __builtin_bit_cast(float, __builtin_amdgcn_update_dpp(0, __builtin_bit_cast(int, x), CTRL, 0xf, 0xf, true)); }
__device__ __forceinline__ float sum8(float x) { x += dpp_mov<0xB1>(x); x += dpp_mov<0x4E>(x); x += dpp_mov<0x141>(x); return x; }
__device__ __forceinline__ float sum16(float x) { x = sum8(x); x += dpp_mov<0x140>(x); return x; }
__device__ __forceinline__ float wave_sum(float v) {
    v = sum16(v);
    const float s0 = __builtin_bit_cast(float, __builtin_amdgcn_readlane(__builtin_bit_cast(int, v), 0)), s1 = __builtin_bit_cast(float, __builtin_amdgcn_readlane(__builtin_bit_cast(int, v), 16));
    const float s2 = __builtin_bit_cast(float, __builtin_amdgcn_readlane(__builtin_bit_cast(int, v), 32)), s3 = __builtin_bit_cast(float, __builtin_amdgcn_readlane(__builtin_bit_cast(int, v), 48));
    return (s0 + s1) + (s2 + s3);
}
__device__ __forceinline__ float sigmoid_f(float x) { return 1.f / (1.f + __expf(-x)); }
__device__ __forceinline__ float gelu_tanh_f(float x) { const float u = 0.7978845608028654f * (x + 0.044715f * x * x * x); return x * sigmoid_f(2.f * u); }

#define XB_TMO      128
#define XB_XCNT(j)  (256  + 64 * (j))
#define XB_XSUB(j)  (1280 + 64 * (j))
#define XB_XGEN(j)  (2304 + 64 * (j))
#define XB_TOP      3328
#define XB_TOPGEN   3392
#define XCD_BAR_WORDS 3456
#define XB_SPIN_CAP (1u << 18)
__device__ __forceinline__ unsigned xb_ld(unsigned* p)              { return __hip_atomic_load(p, __ATOMIC_RELAXED, __HIP_MEMORY_SCOPE_AGENT); }
__device__ __forceinline__ unsigned xb_add(unsigned* p, unsigned v) { return __hip_atomic_fetch_add(p, v, __ATOMIC_RELAXED, __HIP_MEMORY_SCOPE_AGENT); }
__device__ __forceinline__ unsigned xb_xcc_id() { return (unsigned)__builtin_amdgcn_s_getreg((3 << 11) | 20) & 0xFu; }
#define XB_SPIN(cond, bar) do { unsigned _sp = 0; while (cond) { __builtin_amdgcn_s_sleep(1); \
    if ((++_sp & 255u) == 0u) { if (xb_ld(&(bar)[XB_TMO])) break; if (_sp > XB_SPIN_CAP) { atomicAdd(&(bar)[XB_TMO], 1u); break; } } } } while (0)
struct XcdBarrier { unsigned* bar; unsigned x; volatile LAS unsigned* st; };
__device__ __forceinline__ XcdBarrier xcd_barrier_post(unsigned* bar, volatile LAS unsigned* st) {
    XcdBarrier b; b.bar = bar; b.x = xb_xcc_id(); b.st = st;
    if (threadIdx.x == 0) (void)xb_add(&bar[XB_XCNT(b.x)], 1u);
    return b;
}
__device__ __forceinline__ void xcd_barrier_complete(unsigned* bar, unsigned x, unsigned& nloc, unsigned& nx) {
    const unsigned G = gridDim.x * gridDim.y * gridDim.z;
    unsigned sum, cnt, mine, sp = 0u;
    for (;;) {
        sum = 0u; cnt = 0u; mine = 0u;
#pragma unroll
        for (unsigned j = 0; j < 16; ++j) { const unsigned c = xb_ld(&bar[XB_XCNT(j)]); sum += c; cnt += (c > 0u) ? 1u : 0u; mine = (j == x) ? c : mine; }
        if (sum == G) break;
        __builtin_amdgcn_s_sleep(1);
        if ((++sp & 255u) == 0u) { if (xb_ld(&bar[XB_TMO])) break; if (sp > XB_SPIN_CAP) { atomicAdd(&bar[XB_TMO], 1u); break; } }
    }
    nloc = mine > 0u ? mine : 1u; nx = cnt > 0u ? cnt : 1u;
}
__device__ __forceinline__ void xcd_barrier(const XcdBarrier& b) {
    asm volatile("s_waitcnt vmcnt(0)" ::: "memory");
    __syncthreads();
    if (threadIdx.x == 0) {
        unsigned* bar = b.bar;
        __builtin_amdgcn_s_waitcnt(0);
        unsigned nloc = b.st[0], nx = b.st[1];
        if (nloc == 0u) { xcd_barrier_complete(bar, b.x, nloc, nx); b.st[0] = nloc; b.st[1] = nx; }
        const unsigned old = xb_add(&bar[XB_XSUB(b.x)], 1u);
        const unsigned gen = old / nloc;
        if (old + 1u == (gen + 1u) * nloc) {
            __builtin_amdgcn_fence(__ATOMIC_RELEASE, "agent");
            asm volatile("s_waitcnt vmcnt(0)" ::: "memory");
            const unsigned og = xb_add(&bar[XB_TOP], 1u);
            const unsigned tg = og / nx;
            if (og + 1u == (tg + 1u) * nx) xb_add(&bar[XB_TOPGEN], 1u);
            else XB_SPIN(xb_ld(&bar[XB_TOPGEN]) == tg, bar);
            __builtin_amdgcn_fence(__ATOMIC_ACQUIRE, "agent");
            xb_add(&bar[XB_XGEN(b.x)], 1u);
            asm volatile("s_waitcnt vmcnt(0)" ::: "memory");
        } else {
            XB_SPIN(xb_ld(&bar[XB_XGEN(b.x)]) == gen, bar);
            __builtin_amdgcn_fence(__ATOMIC_ACQUIRE, "agent");
            asm volatile("s_waitcnt vmcnt(0)" ::: "memory");
        }
    }
    __syncthreads();
}

constexpr int BM = 256, BK = 64, HALF = 128, HTB = HALF * BK * 2, STAGE_BYTES = 8 * HTB;
__host__ __device__ __forceinline__ int lds_byte(int r, int c) { const int st = (r >> 4) * 2 + (c >> 5), rr = r & 15, cc = c & 31, ob = rr * 64 + cc * 2; return st * 1024 + (ob ^ (((ob >> 9) & 1) << 5)); }
__host__ __device__ __forceinline__ void stage_rc(int b, int& R, int& C) { const int st = b / 1024, sb = b % 1024, swz = sb ^ (((sb >> 9) & 1) << 5); R = (st >> 1) * 16 + swz / 64; C = (st & 1) * 32 + (swz % 64) / 2; }
__host__ __device__ __forceinline__ int perm32(int rho) { const int n = rho >> 4, i = rho & 15; return 8 * (i >> 2) + 4 * n + (i & 3); }

struct Unit {
    const char* A;
    const char* B;
    const int* rows;
    int nvalid;
    int lda2, ldb2;
    int nt;
    int pm, pn, x0, x1;
};
template <bool GATHER> struct AOff { unsigned v[GATHER ? 4 : 1]; };
template <bool GATHER> __device__ __forceinline__ void unit_rows(const Unit& u, int R0, unsigned (&pk)[2]) {
    if constexpr (GATHER) {
#pragma unroll
        for (int h = 0; h < 2; ++h) { unsigned w = 0;
#pragma unroll
            for (int i = 0; i < 2; ++i) { const int r = h * HALF + R0 + 64 * i; const unsigned row = (r < u.nvalid) ? (unsigned)((const GAS int*)u.rows)[r] : 0u; w |= row << (16 * i); }
            pk[h] = w; }
    } else { pk[0] = 0; pk[1] = 0; }
}

template <class Epi, class Sched, bool GATHER>
__device__ __forceinline__ void gemm_stream(LAS unsigned char* lds, const Sched& S, const Epi& E) {
    int tid = threadIdx.x; asm volatile("" : "+v"(tid));
    const int wid = __builtin_amdgcn_readfirstlane(tid >> 6), lane = tid & 63, wr = wid >> 2, wc = wid & 3, fr = lane & 15, fq = lane >> 4;
    int R0, C0; stage_rc(tid * 16, R0, C0);
    const int Rb0 = Epi::PERM ? ((R0 & ~31) + perm32(R0 & 31)) : R0;
    const unsigned ldsw = (unsigned)wid * 1024u;
    const int aoff = lds_byte(wr * 64 + fr, fq * 8), boff = lds_byte(wc * 32 + fr, fq * 8);
#define G_SA(b, h) (((b) * 2 + (h)) * HTB)
#define G_SB(b, h) ((4 + (b) * 2 + (h)) * HTB)
#define G_STAGE_A(bufoff, gbase, h) do { _Pragma("unroll") for (int _i = 0; _i < 2; ++_i) { \
        const char* _p = GATHER ? ((const char*)(gbase) + vA[(h) * 2 + _i]) : ((const char*)(gbase) + (size_t)((h) * HALF + 64 * _i) * (size_t)ldA + vA[0]); \
        __builtin_amdgcn_global_load_lds((const unsigned*)_p, (LAS unsigned*)(lds + (bufoff) + ldsw + _i * 8192), 16, 0, 0); } } while (0)
#define G_STAGE_B(bufoff, gbase, h) do { _Pragma("unroll") for (int _i = 0; _i < 2; ++_i) \
        __builtin_amdgcn_global_load_lds((const unsigned*)((const char*)(gbase) + (size_t)((h) * HALF + 64 * _i) * (size_t)ldB + vB), (LAS unsigned*)(lds + (bufoff) + ldsw + _i * 8192), 16, 0, 0); } while (0)
#define G_LDA(dst, b, h) do { _Pragma("unroll") for (int m = 0; m < 4; ++m) _Pragma("unroll") for (int k = 0; k < 2; ++k) dst[m][k] = *(const LAS bf16x8*)(lds + G_SA(b, h) + aoff + m * 2048 + k * 1024); } while (0)
#define G_LDB(dst, b, h) do { _Pragma("unroll") for (int n = 0; n < 2; ++n) _Pragma("unroll") for (int k = 0; k < 2; ++k) dst[n][k] = *(const LAS bf16x8*)(lds + G_SB(b, h) + boff + n * 2048 + k * 1024); } while (0)
#define G_MMA(ai, bj, At, Bt) do { __builtin_amdgcn_s_setprio(1); _Pragma("unroll") for (int m = 0; m < 4; ++m) _Pragma("unroll") for (int n = 0; n < 2; ++n) _Pragma("unroll") for (int k = 0; k < 2; ++k) \
        acc[ai][bj][m][n] = __builtin_amdgcn_mfma_f32_16x16x32_bf16(Bt[n][k], At[m][k], acc[ai][bj][m][n], 0, 0, 0); __builtin_amdgcn_s_setprio(0); } while (0)
#define G_WAIT_V(n) asm volatile("s_waitcnt vmcnt(" #n ")" ::: "memory")
#define G_WAIT_L(n) asm volatile("s_waitcnt lgkmcnt(" #n ")" ::: "memory")
#define G_BAR __builtin_amdgcn_s_barrier()
#define G_SCHED __builtin_amdgcn_sched_barrier(0)
#define G_SET_OFFS(u, pk) do { ldA = (u).lda2; ldB = (u).ldb2; vB = (unsigned)Rb0 * (unsigned)ldB + (unsigned)C0 * 2u; \
        if constexpr (GATHER) { vA[0] = ((pk)[0] & 0xffffu) * (unsigned)ldA + (unsigned)C0 * 2u; vA[1] = ((pk)[0] >> 16) * (unsigned)ldA + (unsigned)C0 * 2u; \
                                vA[2] = ((pk)[1] & 0xffffu) * (unsigned)ldA + (unsigned)C0 * 2u; vA[3] = ((pk)[1] >> 16) * (unsigned)ldA + (unsigned)C0 * 2u; } \
        else { vA[0] = (unsigned)R0 * (unsigned)ldA + (unsigned)C0 * 2u; } } while (0)
    Unit cur, nxt; int ui = 0;
    if (!S.next(0, cur)) return;
    unsigned vA[GATHER ? 4 : 1], vB, pk[2]; int ldA, ldB;
    unit_rows<GATHER>(cur, R0, pk);
    G_SET_OFFS(cur, pk);
    f32x4 acc[2][2][4][2];
#pragma unroll
    for (int a = 0; a < 2; ++a)
#pragma unroll
        for (int b = 0; b < 2; ++b)
#pragma unroll
            for (int m = 0; m < 4; ++m)
#pragma unroll
                for (int n = 0; n < 2; ++n) acc[a][b][m][n] = (f32x4){0.f, 0.f, 0.f, 0.f};
    bf16x8 At[4][2], B0[2][2], B1[2][2];
    const char* cA = cur.A; const char* cB = cur.B;
    const size_t kstep = (size_t)(BK * 2);
    G_STAGE_B(G_SB(0, 0), cB, 0); G_STAGE_A(G_SA(0, 0), cA, 0); G_STAGE_B(G_SB(0, 1), cB, 1); G_STAGE_A(G_SA(0, 1), cA, 1);
    if (wr == 1) G_BAR;
    G_WAIT_V(4); G_BAR;
    G_STAGE_B(G_SB(1, 0), cB + kstep, 0); G_STAGE_A(G_SA(1, 0), cA + kstep, 0); G_STAGE_B(G_SB(1, 1), cB + kstep, 1);
    G_WAIT_V(6); G_BAR;
    for (;;) {
        const bool has_next = S.next(ui + 1, nxt);
        if (!has_next) nxt = cur;
        unit_rows<GATHER>(nxt, R0, pk);
        const char* nA = nxt.A; const char* nB = nxt.B;
        const int nt = cur.nt;
        for (int t = 0; t < nt; t += 2) {
            const bool last = (t == nt - 2);
            const char* a1 = cA + (size_t)(t + 1) * kstep;
            const char* a2 = last ? nA : cA + (size_t)(t + 2) * kstep; const char* b2 = last ? nB : cB + (size_t)(t + 2) * kstep;
            const char* a3 = a2 + kstep; const char* b3 = b2 + kstep;
            G_LDB(B0, 0, 0); G_SCHED; G_LDA(At, 0, 0); G_STAGE_A(G_SA(1, 1), a1, 1);
            if (last) { G_SET_OFFS(nxt, pk); }
            G_WAIT_L(8); G_BAR; G_WAIT_L(0); G_MMA(0, 0, At, B0); G_BAR; G_SCHED;
            G_LDB(B1, 0, 1); G_STAGE_B(G_SB(0, 0), b2, 0);
            G_BAR; G_WAIT_L(0); G_MMA(0, 1, At, B1); G_BAR;
            G_LDA(At, 0, 1); G_STAGE_A(G_SA(0, 0), a2, 0);
            G_BAR; G_WAIT_L(0); G_MMA(1, 0, At, B0); G_BAR; G_SCHED;
            G_STAGE_B(G_SB(0, 1), b2, 1);
            G_WAIT_V(6); G_BAR; G_MMA(1, 1, At, B1); G_BAR;
            G_LDB(B0, 1, 0); G_SCHED; G_LDA(At, 1, 0); G_STAGE_A(G_SA(0, 1), a2, 1);
            G_WAIT_L(8); G_BAR; G_WAIT_L(0); G_MMA(0, 0, At, B0); G_BAR; G_SCHED;
            G_LDB(B1, 1, 1); G_STAGE_B(G_SB(1, 0), b3, 0);
            G_BAR; G_WAIT_L(0); G_MMA(0, 1, At, B1); G_BAR;
            G_LDA(At, 1, 1); G_STAGE_A(G_SA(1, 0), a3, 0);
            G_BAR; G_WAIT_L(0); G_MMA(1, 0, At, B0); G_BAR; G_SCHED;
            G_STAGE_B(G_SB(1, 1), b3, 1);
            G_WAIT_V(6); G_BAR; G_MMA(1, 1, At, B1); G_BAR;
        }
        E(acc, cur, wr, wc, fr, fq);
        if (!has_next) break;
#pragma unroll
        for (int a = 0; a < 2; ++a)
#pragma unroll
            for (int b = 0; b < 2; ++b)
#pragma unroll
                for (int m = 0; m < 4; ++m)
#pragma unroll
                    for (int n = 0; n < 2; ++n) acc[a][b][m][n] = (f32x4){0.f, 0.f, 0.f, 0.f};
        cur = nxt; cA = nA; cB = nB; ++ui;
    }
    G_WAIT_V(0);
    if (wr == 0) G_BAR;
    G_BAR;
#undef G_SA
#undef G_SB
#undef G_STAGE_A
#undef G_STAGE_B
#undef G_LDA
#undef G_LDB
#undef G_MMA
#undef G_WAIT_V
#undef G_WAIT_L
#undef G_BAR
#undef G_SCHED
#undef G_SET_OFFS
}

__device__ __forceinline__ unsigned cvt_pk_bf16(float lo, float hi) { unsigned r; asm volatile("v_cvt_pk_bf16_f32 %0, %1, %2" : "=v"(r) : "v"(lo), "v"(hi)); return r; }

struct DenseSched {
    const char* A; const char* B; int lda2, ldb2, nt, nM, nN, G, c;
    __device__ __forceinline__ bool next(int i, Unit& u) const {
        const int Lx = i * G + c; if (Lx >= nM * nN) return false;
        const int pm = Lx / nN, pn = Lx % nN;
        u.A = A + (size_t)pm * BM * lda2; u.B = B + (size_t)pn * BM * ldb2; u.rows = nullptr; u.nvalid = 0; u.lda2 = lda2; u.ldb2 = ldb2; u.nt = nt; u.pm = pm; u.pn = pn; u.x0 = 0; u.x1 = 0; return true;
    }
};
}
namespace fk {
constexpr int RING_OFF = 0, RING_BYTES = STAGE_BYTES;
constexpr int MISC_OFF = RING_BYTES;
constexpr int LDS_BYTES = RING_BYTES + 1024;
struct Args { const float* in[54]; float* out; unsigned char* ws; int ph_lo, ph_hi, li, comb, rep_group, rep_n; };

struct Frame {
    LAS unsigned char* lds; volatile LAS unsigned* MISC;
    int tid, lane, wave, G, c, vc;
    unsigned* ctl; unsigned char* ws;
};

__device__ __forceinline__ void transpose_item(const float* W, int ldw, int k0, int n0, bf16* dst, int ldd, LAS float* scr, int lane) {
#pragma unroll
    for (int i = 0; i < 32; ++i) { const int kk = 2 * i + (lane >> 5); scr[kk * 33 + (lane & 31)] = W[(size_t)(k0 + kk) * ldw + n0 + (lane & 31)]; }
    LDS_WAIT(); asm volatile("" ::: "memory");
    const int c = lane & 7;
#pragma unroll
    for (int j = 0; j < 4; ++j) { const int n = (lane >> 3) + 8 * j; const LAS float* s = scr + (8 * c) * 33 + n;
        v4u o; o.x = pk2(s[0 * 33], s[1 * 33]); o.y = pk2(s[2 * 33], s[3 * 33]); o.z = pk2(s[4 * 33], s[5 * 33]); o.w = pk2(s[6 * 33], s[7 * 33]);
        *(GAS v4u*)(dst + (size_t)n * ldd + 8 * c) = o; }
    LDS_WAIT(); asm volatile("" ::: "memory");
}

constexpr int MOE_CONV_ITEMS = 3 * 4096;
__device__ __forceinline__ void moe_conv_item(const Args& a, unsigned char* wsl, int l, int it, LAS float* scr, int lane) {
    bf16* Wgu = (bf16*)(wsl + WS_WMOE); bf16* Wd = Wgu + (size_t)16 * 1024 * 1024;
    const int which = it >> 12, r = it & 4095, e = r >> 8, q = r & 255;
    if (which < 2) { const int kb = q >> 4, nb = q & 15, k0 = kb * 64, n0 = nb * 32;
        const float* W = a.in[which == 0 ? 51 : 52] + ((size_t)l * 16 + e) * D * 512;
        bf16* dst = Wgu + ((size_t)e * 1024 + (n0 >> 7) * 256 + which * 128 + (n0 & 127)) * 1024 + k0;
        transpose_item(W, 512, k0, n0, dst, 1024, scr, lane);
    } else { const int kb = q >> 5, nb = q & 31, k0 = kb * 64, n0 = nb * 32;
        const float* W = a.in[53] + ((size_t)l * 16 + e) * 512 * D;
        bf16* dst = Wd + ((size_t)e * 1024 + n0) * 512 + k0;
        transpose_item(W, 1024, k0, n0, dst, 512, scr, lane);
    }
}
__device__ __forceinline__ void moe_conv_drain(Frame& F, const Args& a, int l, unsigned* done) {
    PHASE_IDS();
    LAS float* scr = (LAS float*)(F.lds + RING_OFF + wave * 16384);
    unsigned* q = F.ctl + CW_Q + 512 * l + 64 * wave;
    for (;;) {
        unsigned it = 0u, fin = 0u;
        if (lane == 0) { if (done) fin = (__hip_atomic_load(done, __ATOMIC_RELAXED, __HIP_MEMORY_SCOPE_AGENT) >= (unsigned)F.G) ? 1u : 0u; if (!fin) it = __hip_atomic_fetch_add(q, 1u, __ATOMIC_RELAXED, __HIP_MEMORY_SCOPE_AGENT); }
        fin = (unsigned)__builtin_amdgcn_readfirstlane((int)fin); it = (unsigned)__builtin_amdgcn_readfirstlane((int)it);
        if (fin || it >= (unsigned)(MOE_CONV_ITEMS / 8)) break;
        moe_conv_item(a, wsl, l, (int)it * 8 + wave, scr, lane);
    }
}
__device__ __forceinline__ void phase_done(Frame& F, unsigned* done) {
    __syncthreads();
    if (threadIdx.x == 0) __hip_atomic_fetch_add(done, 1u, __ATOMIC_RELAXED, __HIP_MEMORY_SCOPE_AGENT);
}

__device__ __forceinline__ void moe_route(Frame& F, const Args& a, int l, int dry) {
    PHASE_IDS();
    LAS float* wt = (LAS float*)(F.lds + RING_OFF);
    const float* wg = a.in[47] + (size_t)l * D * 4; const float* we = a.in[49] + (size_t)l * D * 16;
    for (int i = tid; i < D * 4; i += NT) { const int d = i >> 2, q = i & 3; wt[q * 1024 + d] = wg[i]; }
    for (int i = tid; i < D * 16; i += NT) { const int d = i >> 4, q = i & 15; wt[(4 + q) * 1024 + d] = we[i]; }
    if (tid < 16) ((LAS unsigned*)(wt + 20 * 1024))[tid] = 0u;
    __syncthreads();
    const float* gain = a.in[3] + l * D; const float* bg = a.in[48] + l * 4; const float* be = a.in[50] + l * 16;
    f32x4 g[4];
#pragma unroll
    for (int j = 0; j < 4; ++j) g[j] = *(const f32x4*)(gain + 256 * j + 4 * lane);
    const float* H = (const float*)(wsl + WS_H); bf16* XN = (bf16*)(wsl + WS_ACT + A_XN);
    int* list = (int*)(wsl + WS_ACT + A_LIST); float* listw = (float*)(wsl + WS_ACT + A_LISTW); int* listd = (int*)(wsl + WS_ACT + A_LISTD);
    unsigned* cnt = F.ctl + CW_CNT + 1024 * l;
    LAS unsigned* lcnt = (LAS unsigned*)(wt + 20 * 1024); LAS unsigned* lbase = lcnt + 16; LAS unsigned* ent = lbase + 16;
    const int gw = F.c * NWAVES + wave, NGW = F.G * NWAVES;
    f32x4 v[4], vn[4];
    const int rchunk = (TP + F.G - 1) / F.G, rlim = (F.c + 1) * rchunk < TP ? (F.c + 1) * rchunk : TP, rfirst = F.c * rchunk + wave;
    { const int r0_ = rfirst; if (r0_ < rlim && (r0_ % LP) >= PRE) { const GAS f32x4* hr = (const GAS f32x4*)(H + (size_t)r0_ * D) + lane;
#pragma unroll
        for (int j = 0; j < 4; ++j) v[j] = hr[64 * j]; } }
    for (int row = rfirst; row < rlim; row += NWAVES) {
        { const int nrow = row + NWAVES; if (nrow < rlim && (nrow % LP) >= PRE) { const GAS f32x4* hr = (const GAS f32x4*)(H + (size_t)nrow * D) + lane;
#pragma unroll
            for (int j = 0; j < 4; ++j) vn[j] = hr[64 * j]; } }
        if ((row % LP) < PRE) {
#pragma unroll
            for (int j = 0; j < 4; ++j) v[j] = vn[j];
            continue; }
        float ss = 0.f;
#pragma unroll
        for (int j = 0; j < 4; ++j) ss += (v[j].x * v[j].x + v[j].y * v[j].y) + (v[j].z * v[j].z + v[j].w * v[j].w);
        const float rs = rsqrtf(wave_sum(ss) * (1.f / D) + RMS_EPS);
#pragma unroll
        for (int j = 0; j < 4; ++j) v[j] = v[j] * rs * g[j];
        GAS v2u* o8 = (GAS v2u*)(XN + (size_t)row * D) + lane;
#pragma unroll
        for (int j = 0; j < 4; ++j) { v2u w; w.x = pk2(v[j].x, v[j].y); w.y = pk2(v[j].z, v[j].w); o8[64 * j] = w; }
        float acc[20];
#pragma unroll
        for (int q = 0; q < 20; ++q) { float s = 0.f;
#pragma unroll
            for (int j = 0; j < 4; ++j) { const f32x4 w = *(const LAS f32x4*)(wt + q * 1024 + 256 * j + 4 * lane); s += (v[j].x * w.x + v[j].y * w.y) + (v[j].z * w.z + v[j].w * w.w); }
            acc[q] = wave_sum(s); }
        if (lane < 2 && !dry) {
            float lg[4]; int gi = 0; float mx = -3.0e38f;
#pragma unroll
            for (int q = 0; q < 4; ++q) { lg[q] = acc[q] + bg[q]; if (lg[q] > mx) { mx = lg[q]; gi = q; } }
            float den = 0.f;
#pragma unroll
            for (int q = 0; q < 4; ++q) den += __expf(lg[q] - mx);
            const float pg = 1.f / den;
            float le[4];
#pragma unroll
            for (int q = 0; q < 4; ++q) { float s = 0.f;
#pragma unroll
                for (int gq = 0; gq < 4; ++gq) s = (gq == gi) ? (acc[4 + gq * 4 + q] + be[gq * 4 + q]) : s;
                le[q] = s; }
            int i1 = 0; float v1 = le[0];
#pragma unroll
            for (int q = 1; q < 4; ++q) if (le[q] > v1) { v1 = le[q]; i1 = q; }
            int i2 = 0; float v2 = -3.0e38f;
#pragma unroll
            for (int q = 0; q < 4; ++q) if (q != i1 && le[q] > v2) { v2 = le[q]; i2 = q; }
            const float e2 = __expf(v2 - v1), s1 = 1.f / (1.f + e2), s2 = e2 / (1.f + e2);
            const int k = lane; const int e = gi * 4 + (k == 0 ? i1 : i2); const float gt = (k == 0 ? s1 : s2) * pg;
            const unsigned lp = __hip_atomic_fetch_add(lcnt + e, 1u, __ATOMIC_RELAXED, __HIP_MEMORY_SCOPE_WORKGROUP);
            const int ei = ((row - F.c * rchunk) * 2 + k) * 4; ent[ei] = (unsigned)row; ent[ei + 1] = (unsigned)e; ent[ei + 2] = __builtin_bit_cast(unsigned, gt); ent[ei + 3] = lp;
        }
#pragma unroll
        for (int j = 0; j < 4; ++j) v[j] = vn[j];
    }
    __syncthreads();
    if (tid < 16 && !dry) { const unsigned n = lcnt[tid]; lbase[tid] = n ? __hip_atomic_fetch_add(cnt + 64 * tid, n, __ATOMIC_RELAXED, __HIP_MEMORY_SCOPE_AGENT) : 0u; }
    __syncthreads();
    if (!dry) for (int i = tid; i < 2 * rchunk; i += NT) { const int row = F.c * rchunk + (i >> 1);
        if (row < rlim && (row % LP) >= PRE) { const unsigned e = ent[4 * i + 1]; const unsigned pos = lbase[e] + ent[4 * i + 3];
            list[(size_t)e * LISTCAP + pos] = (int)ent[4 * i]; listw[(size_t)e * LISTCAP + pos] = __builtin_bit_cast(float, ent[4 * i + 2]); listd[(size_t)e * LISTCAP + pos] = (int)ent[4 * i] * 2 + (i & 1); } }
    __syncthreads();
}

struct MoeSched {
    volatile LAS unsigned* tb;
    const char* A; const char* B; const int* list; int lda2, ldb2, nt, G, c, gather;
    __device__ __forceinline__ bool next(int i, Unit& u) const {
        const int Lx = i * G + c; const int ntot = __builtin_amdgcn_readfirstlane((int)tb[16]);
        if (Lx >= ntot * 4) return false;
        const int mt = Lx >> 2, pn = Lx & 3; int e = 0;
#pragma unroll
        for (int q = 1; q < 16; ++q) e = (__builtin_amdgcn_readfirstlane((int)tb[q]) <= mt) ? q : e;
        const int ti = mt - __builtin_amdgcn_readfirstlane((int)tb[e]); const int cn = __builtin_amdgcn_readfirstlane((int)tb[17 + e]) - ti * 256;
        u.nvalid = cn < 256 ? cn : 256; u.x0 = e; u.x1 = ti; u.pm = mt; u.pn = pn; u.lda2 = lda2; u.ldb2 = ldb2; u.nt = nt;
        u.B = B + ((size_t)e * 1024 + (size_t)pn * 256) * ldb2;
        if (gather) { u.A = A; u.rows = list + (size_t)e * LISTCAP + ti * 256; }
        else { u.A = A + (size_t)mt * 256 * lda2; u.rows = nullptr; }
        return true;
    }
};
__device__ __forceinline__ void moe_tables(Frame& F, int l) {
    PHASE_IDS();
    volatile LAS unsigned* tb = F.MISC + 64;
    __syncthreads();
    if (tid < 64) {
        const unsigned cn = lane < 16 ? __hip_atomic_load(F.ctl + CW_CNT + 1024 * l + 64 * lane, __ATOMIC_RELAXED, __HIP_MEMORY_SCOPE_AGENT) : 0u;
        unsigned s = 0;
#pragma unroll
        for (int e = 0; e < 16; ++e) { const unsigned ce = (unsigned)__builtin_amdgcn_readlane((int)cn, e); if (lane == 0) { tb[e] = s; tb[17 + e] = ce; } s += (ce + 255u) >> 8; }
        if (lane == 0) tb[16] = s;
    }
    __syncthreads();
}
struct EpiSwiglu {
    static constexpr bool PERM = true;
    bf16* hid; const float* listw;
    __device__ __forceinline__ void operator()(const f32x4 (&acc)[2][2][4][2], const Unit& u, int wr, int wc, int fr, int fq) const {
        const GAS float* lw = (const GAS float*)listw + (size_t)u.x0 * LISTCAP + u.x1 * 256;
        asm volatile("" : "+v"(fr));
        GAS unsigned char* hb = (GAS unsigned char*)hid + ((size_t)u.pm * 256 * 512 + u.pn * 128 + wc * 32) * 2;
#pragma unroll
        for (int ai = 0; ai < 2; ++ai)
#pragma unroll
            for (int m = 0; m < 4; ++m) {
                const int r = ai * HALF + wr * 64 + m * 16 + fr;
                const float cw = (r < u.nvalid) ? lw[r] : 0.f;
                float o[8];
#pragma unroll
                for (int n = 0; n < 2; ++n)
#pragma unroll
                    for (int q = 0; q < 4; ++q) { const float gv = acc[ai][0][m][n][q], uv = acc[ai][1][m][n][q]; o[n * 4 + q] = gv * sigmoid_f(gv) * uv * cw; }
                v4u w; w.x = cvt_pk_bf16(o[0], o[1]); w.y = cvt_pk_bf16(o[2], o[3]); w.z = cvt_pk_bf16(o[4], o[5]); w.w = cvt_pk_bf16(o[6], o[7]);
                *(GAS v4u*)(hb + (unsigned)(r * 1024 + fq * 16)) = w;
            }
    }
};
struct EpiScatter {
    static constexpr bool PERM = true;
    bf16* O; const int* listd;
    __device__ __forceinline__ void operator()(const f32x4 (&acc)[2][2][4][2], const Unit& u, int wr, int wc, int fr, int fq) const {
        const GAS int* ld = (const GAS int*)listd + (size_t)u.x0 * LISTCAP + u.x1 * 256;
        asm volatile("" : "+v"(fr));
        GAS unsigned char* ob = (GAS unsigned char*)O + (size_t)(u.pn * 256 + wc * 32) * 2;
#pragma unroll
        for (int ai = 0; ai < 2; ++ai)
#pragma unroll
            for (int m = 0; m < 4; ++m) {
                const int r = ai * HALF + wr * 64 + m * 16 + fr;
                if (r < u.nvalid) { const int dst = ld[r];
#pragma unroll
                    for (int bj = 0; bj < 2; ++bj) { const f32x4 v0 = acc[ai][bj][m][0], v1 = acc[ai][bj][m][1];
                        v4u w; w.x = cvt_pk_bf16(v0[0], v0[1]); w.y = cvt_pk_bf16(v0[2], v0[3]); w.z = cvt_pk_bf16(v1[0], v1[1]); w.w = cvt_pk_bf16(v1[2], v1[3]);
                        *(GAS v4u*)(ob + ((unsigned)dst * 2048u + (unsigned)(bj * 256 + fq * 16))) = w; } }
            }
    }
};

}
namespace fk {
constexpr size_t KiB = 1024;
constexpr size_t WM_AB_STRIDE = 14 * MiB;
constexpr size_t WM_WIN = 0;
constexpr size_t WM_WGLU = 3 * MiB;
constexpr size_t WM_WOUT = 3 * MiB + 512 * KiB;
constexpr size_t WM_LRUW = 5 * MiB + 512 * KiB;
constexpr size_t WM_APW = 5 * MiB + 768 * KiB;
constexpr size_t WM_BX = 6 * MiB;
constexpr size_t WM_TC = 8 * MiB;
constexpr size_t WM_RW = 28 * MiB;
constexpr size_t B_HN = 0;
constexpr size_t B_Z = B_HN + (size_t)TP * D * 2;
constexpr size_t B_YS = B_Z + (size_t)TP * 1536 * 2;
constexpr size_t B_CAT = B_YS + (size_t)TP * 512 * 2;
constexpr size_t B_SSA = B_CAT + (size_t)TP * D * 2;
constexpr size_t B_SSB = B_SSA + (size_t)TP * 8 * 4;
constexpr size_t B_END = B_SSB + (size_t)TP * 32 * 4;
static_assert(B_END <= ACT_BYTES, "AB activations fit");

__device__ __forceinline__ void s5_precompute(Frame& F, const Args& a, int j, int g) {
    PHASE_IDS();
    LAS f32x2* pw = (LAS f32x2*)(F.lds + RING_OFF);
    LAS f32x2* bbar = pw + 17 * 64;
    LAS f32x2* cc = bbar + 64 * 16;
    LAS float* Kl = (LAS float*)(cc + 16 * 64);
    unsigned char* wm = wsl + WS_WMIX + (size_t)j * WM_AB_STRIDE;
    __syncthreads();
    if (tid < 64) { const int p = tid;
        const float lr = a.in[9][(j * 32 + g) * 64 + p], li = a.in[10][(j * 32 + g) * 64 + p], dt = expf(a.in[11][j * 32 + g]);
#pragma unroll 1
        for (int lag = 0; lag <= 16; ++lag) { const float m = expf((float)lag * lr * dt); pw[lag * 64 + p] = (f32x2){m * cosf((float)lag * li * dt), m * sinf((float)lag * li * dt)}; }
        const float mag = expf(lr * dt), ar = mag * cosf(li * dt), ai = mag * sinf(li * dt), den = lr * lr + li * li;
        const float zr = ((ar - 1.f) * lr + ai * li) / den, zi = (ai * lr - (ar - 1.f) * li) / den;
        const float* bre = a.in[12] + ((size_t)(j * 32 + g) * 64 + p) * 16; const float* bim = a.in[13] + ((size_t)(j * 32 + g) * 64 + p) * 16;
#pragma unroll 1
        for (int h = 0; h < 16; ++h) { const float br = bre[h], bi = bim[h]; bbar[p * 16 + h] = (f32x2){zr * br - zi * bi, zr * bi + zi * br}; }
    }
    for (int i = tid; i < 1024; i += NT) cc[i] = (f32x2){a.in[14][(size_t)(j * 32 + g) * 1024 + i], a.in[15][(size_t)(j * 32 + g) * 1024 + i]};
    __syncthreads();
    if (tid < 64) ((f32x2*)(wm + WM_APW))[g * 64 + tid] = pw[16 * 64 + tid];
    for (int i = tid; i < 4096; i += NT) { const int lag = i >> 8, h = (i >> 4) & 15, hp = i & 15; float s = 0.f;
        for (int p = 0; p < 64; ++p) { const f32x2 w = pw[lag * 64 + p], bb = bbar[p * 16 + hp], c = cc[h * 64 + p];
            const float wr_ = w.x * bb.x - w.y * bb.y, wi_ = w.x * bb.y + w.y * bb.x; s += c.x * wr_ - c.y * wi_; }
        if (lag == 0 && h == hp) s += a.in[16][(j * 32 + g) * 16 + h];
        Kl[i] = s; }
    __syncthreads();
    bf16* TC = (bf16*)(wm + WM_TC) + (size_t)g * 256 * 384; bf16* BX = (bf16*)(wm + WM_BX) + (size_t)g * 128 * 256;
    for (int i = tid; i < 256 * 48; i += NT) { const int n = i / 48, ko = i % 48, t = n >> 4, h = n & 15; float v[8];
        if (ko < 32) { const int s = ko >> 1, hp0 = (ko & 1) * 8;
#pragma unroll
            for (int q = 0; q < 8; ++q) v[q] = (s <= t) ? Kl[((t - s) * 16 + h) * 16 + hp0 + q] : 0.f;
        } else { const int p0 = (ko - 32) * 4;
#pragma unroll
            for (int q = 0; q < 4; ++q) { const f32x2 c = cc[h * 64 + p0 + q], w = pw[(t + 1) * 64 + p0 + q]; v[2 * q] = c.x * w.x - c.y * w.y; v[2 * q + 1] = -(c.x * w.y + c.y * w.x); } }
        v4u o; o.x = pk2(v[0], v[1]); o.y = pk2(v[2], v[3]); o.z = pk2(v[4], v[5]); o.w = pk2(v[6], v[7]);
        *(GAS v4u*)(TC + (size_t)n * 384 + ko * 8) = o; }
    for (int i = tid; i < 128 * 32; i += NT) { const int n = i >> 5, ko = i & 31, p = n >> 1, im = n & 1, s = ko >> 1, hp0 = (ko & 1) * 8; float v[8];
        const f32x2 w = pw[(15 - s) * 64 + p];
#pragma unroll
        for (int q = 0; q < 8; ++q) { const f32x2 bb = bbar[p * 16 + hp0 + q]; v[q] = im ? (w.x * bb.y + w.y * bb.x) : (w.x * bb.x - w.y * bb.y); }
        v4u o; o.x = pk2(v[0], v[1]); o.y = pk2(v[2], v[3]); o.z = pk2(v[4], v[5]); o.w = pk2(v[6], v[7]);
        *(GAS v4u*)(BX + (size_t)n * 256 + ko * 8) = o; }
    __syncthreads();
}

__device__ __forceinline__ void prologue_ab(Frame& F, const Args& a) {
    PHASE_IDS();
    const int gw = F.c * NWAVES + wave, NGW = F.G * NWAVES;
    float* H = (float*)(wsl + WS_H);
    for (int row = gw; row < TP; row += NGW) { const int b = row / LP, t = row % LP - PRE;
        GAS f32x4* o = (GAS f32x4*)(H + (size_t)row * D) + lane;
        if (t < 0) {
#pragma unroll
            for (int q = 0; q < 4; ++q) o[64 * q] = (f32x4){0.f, 0.f, 0.f, 0.f};
        } else { const float* src = t < NMETA ? a.in[1] + (size_t)t * D : a.in[0] + ((size_t)b * SEQ + (t - NMETA)) * D;
#pragma unroll
            for (int q = 0; q < 4; ++q) o[64 * q] = ((const GAS f32x4*)src)[64 * q + lane]; } }
    LAS float* scr = (LAS float*)(F.lds + RING_OFF + wave * 16384);
    constexpr int I_IN = 16 * 48, I_GLU = 8 * 16, I_OUT = 16 * 32, I_LRU = 32, I_AB = I_IN + I_GLU + I_OUT + I_LRU;
    for (int it = gw; it < 2 * I_AB; it += NGW) { const int j = it / I_AB; int r = it % I_AB; unsigned char* wm = wsl + WS_WMIX + (size_t)j * WM_AB_STRIDE;
        if (r < I_IN) { const int kb = r / 48, nb = r % 48; transpose_item(a.in[5] + (size_t)j * D * 1536, 1536, kb * 64, nb * 32, (bf16*)(wm + WM_WIN) + (size_t)nb * 32 * 1024 + kb * 64, 1024, scr, lane); continue; } r -= I_IN;
        if (r < I_GLU) { const int kb = r / 16, nb = r % 16; transpose_item(a.in[17] + (size_t)j * 512 * 512, 512, kb * 64, nb * 32, (bf16*)(wm + WM_WGLU) + (size_t)nb * 32 * 512 + kb * 64, 512, scr, lane); continue; } r -= I_GLU;
        if (r < I_OUT) { const int kb = r / 32, nb = r % 32; transpose_item(a.in[6] + (size_t)j * D * D, 1024, kb * 64, nb * 32, (bf16*)(wm + WM_WOUT) + (size_t)nb * 32 * 1024 + kb * 64, 1024, scr, lane); continue; } r -= I_OUT;
        { const int hd = r >> 2, which = (r >> 1) & 1, nb = r & 1;
          transpose_item(a.in[which ? 23 : 21] + (size_t)(j * 8 + hd) * 4096, 64, 0, nb * 32, (bf16*)(wm + WM_LRUW) + ((size_t)hd * 128 + which * 64 + nb * 32) * 64, 64, scr, lane); }
    }
    __syncthreads();
    for (int u = F.c; u < 64; u += F.G) s5_precompute(F, a, u >> 5, u & 31);
}

struct RowBuf { f32x4 v[4]; v2u a[4], b[4]; };
__device__ __forceinline__ void row_issue(RowBuf& R, const float* H, const bf16* O, int row, int has_o, int lane) {
    const GAS f32x4* hr = (const GAS f32x4*)(H + (size_t)row * D) + lane;
#pragma unroll
    for (int q = 0; q < 4; ++q) R.v[q] = hr[64 * q];
    if (has_o) { const GAS v2u* o0 = (const GAS v2u*)(O + (size_t)row * 2 * D) + lane; const GAS v2u* o1 = o0 + 256;
#pragma unroll
        for (int q = 0; q < 4; ++q) { R.a[q] = o0[64 * q]; R.b[q] = o1[64 * q]; } }
}
__device__ __forceinline__ float row_finish(RowBuf& R, int has_o) {
    float ss = 0.f;
    if (has_o) {
#pragma unroll
        for (int q = 0; q < 4; ++q) { const v2u x = R.a[q], y = R.b[q];
            R.v[q].x += bflo(x.x) + bflo(y.x); R.v[q].y += bfhi(x.x) + bfhi(y.x); R.v[q].z += bflo(x.y) + bflo(y.y); R.v[q].w += bfhi(x.y) + bfhi(y.y); } }
#pragma unroll
    for (int q = 0; q < 4; ++q) ss += (R.v[q].x * R.v[q].x + R.v[q].y * R.v[q].y) + (R.v[q].z * R.v[q].z + R.v[q].w * R.v[q].w);
    return rsqrtf(wave_sum(ss) * (1.f / D) + RMS_EPS);
}
__device__ __forceinline__ void pass_norm(Frame& F, const float* gain, int has_o, bf16* out) {
    PHASE_IDS();
    const int gw = F.c * NWAVES + wave, NGW = F.G * NWAVES;
    f32x4 g[4];
#pragma unroll
    for (int q = 0; q < 4; ++q) g[q] = *(const GAS f32x4*)(gain + 256 * q + 4 * lane);
    const float* H = (const float*)(wsl + WS_H); const bf16* O = (const bf16*)(wsl + WS_O);
    RowBuf cur, nxt;
    const int rchunk = (TP + F.G - 1) / F.G, rlim = (F.c + 1) * rchunk < TP ? (F.c + 1) * rchunk : TP, rfirst = F.c * rchunk + wave;
    if (rfirst < rlim && (rfirst % LP) >= PRE) row_issue(cur, H, O, rfirst, has_o, lane);
    for (int row = rfirst; row < rlim; row += NWAVES) {
        const int nrow = row + NWAVES; if (nrow < rlim && (nrow % LP) >= PRE) row_issue(nxt, H, O, nrow, has_o, lane);
        GAS v2u* o8 = (GAS v2u*)(out + (size_t)row * D) + lane;
        if ((row % LP) < PRE) {
#pragma unroll
            for (int q = 0; q < 4; ++q) o8[64 * q] = (v2u){0u, 0u};
        } else { const float rs = row_finish(cur, has_o);
#pragma unroll
            for (int q = 0; q < 4; ++q) { const f32x4 x = cur.v[q] * rs * g[q]; v2u w; w.x = pk2(x.x, x.y); w.y = pk2(x.z, x.w); o8[64 * q] = w; } }
        cur = nxt;
    }
}
__device__ __forceinline__ void pass_final(Frame& F, const float* gain, float* out) {
    PHASE_IDS();
    const int gw = F.c * NWAVES + wave, NGW = F.G * NWAVES;
    f32x4 g[4];
#pragma unroll
    for (int q = 0; q < 4; ++q) g[q] = *(const GAS f32x4*)(gain + 256 * q + 4 * lane);
    const float* H = (const float*)(wsl + WS_H); const bf16* O = (const bf16*)(wsl + WS_O);
    RowBuf cur, nxt;
    const int rchunk = (NB * SEQ + F.G - 1) / F.G, rlim = (F.c + 1) * rchunk < NB * SEQ ? (F.c + 1) * rchunk : NB * SEQ, rfirst = F.c * rchunk + wave;
    if (rfirst < rlim) row_issue(cur, H, O, (rfirst / SEQ) * LP + PRE + NMETA + rfirst % SEQ, 1, lane);
    for (int r = rfirst; r < rlim; r += NWAVES) {
        const int nr = r + NWAVES; if (nr < rlim) row_issue(nxt, H, O, (nr / SEQ) * LP + PRE + NMETA + nr % SEQ, 1, lane);
        const float rs = row_finish(cur, 1);
        GAS f32x4* o = (GAS f32x4*)(out + (size_t)r * D) + lane;
#pragma unroll
        for (int q = 0; q < 4; ++q) o[64 * q] = cur.v[q] * rs * g[q];
        cur = nxt;
    }
}

struct EpiBf16 {
    static constexpr bool PERM = true;
    bf16* O; int ldo;
    __device__ __forceinline__ void operator()(const f32x4 (&acc)[2][2][4][2], const Unit& u, int wr, int wc, int fr, int fq) const {
        asm volatile("" : "+v"(fr));
        GAS unsigned char* ob = (GAS unsigned char*)O + ((size_t)u.pm * 256 * ldo + u.pn * 256 + wc * 32) * 2;
#pragma unroll
        for (int ai = 0; ai < 2; ++ai)
#pragma unroll
            for (int m = 0; m < 4; ++m) { const int r = ai * HALF + wr * 64 + m * 16 + fr;
#pragma unroll
                for (int bj = 0; bj < 2; ++bj) { const f32x4 v0 = acc[ai][bj][m][0], v1 = acc[ai][bj][m][1];
                    v4u w; w.x = cvt_pk_bf16(v0[0], v0[1]); w.y = cvt_pk_bf16(v0[2], v0[3]); w.z = cvt_pk_bf16(v1[0], v1[1]); w.w = cvt_pk_bf16(v1[2], v1[3]);
                    *(GAS v4u*)(ob + ((unsigned)r * (unsigned)ldo * 2u + (unsigned)(bj * 256 + fq * 16))) = w; } }
    }
};
struct EpiGlu {
    static constexpr bool PERM = true;
    const bf16* YS; bf16* CAT; const float* bglu; float* SSA;
    __device__ __forceinline__ void operator()(const f32x4 (&acc)[2][2][4][2], const Unit& u, int wr, int wc, int fr, int fq) const {
        asm volatile("" : "+v"(fr));
        f32x4 bv[2][2];
#pragma unroll
        for (int bj = 0; bj < 2; ++bj)
#pragma unroll
            for (int n = 0; n < 2; ++n) bv[bj][n] = *(const GAS f32x4*)(bglu + u.pn * 256 + bj * HALF + wc * 32 + fq * 8 + 4 * n);
#pragma unroll
        for (int ai = 0; ai < 2; ++ai)
#pragma unroll
            for (int m = 0; m < 4; ++m) { const int r = ai * HALF + wr * 64 + m * 16 + fr; const size_t row = (size_t)u.pm * 256 + r; float ss = 0.f;
#pragma unroll
                for (int bj = 0; bj < 2; ++bj) { const int col = u.pn * 256 + bj * HALF + wc * 32 + fq * 8;
                    const v4u y = *(const GAS v4u*)(YS + row * 512 + col); const f32x4 v0 = acc[ai][bj][m][0] + bv[bj][0], v1 = acc[ai][bj][m][1] + bv[bj][1];
                    float o[8]; o[0] = bflo(y.x) * sigmoid_f(v0[0]); o[1] = bfhi(y.x) * sigmoid_f(v0[1]); o[2] = bflo(y.y) * sigmoid_f(v0[2]); o[3] = bfhi(y.y) * sigmoid_f(v0[3]);
                    o[4] = bflo(y.z) * sigmoid_f(v1[0]); o[5] = bfhi(y.z) * sigmoid_f(v1[1]); o[6] = bflo(y.w) * sigmoid_f(v1[2]); o[7] = bfhi(y.w) * sigmoid_f(v1[3]);
#pragma unroll
                    for (int q = 0; q < 8; ++q) ss += o[q] * o[q];
                    v4u w; w.x = cvt_pk_bf16(o[0], o[1]); w.y = cvt_pk_bf16(o[2], o[3]); w.z = cvt_pk_bf16(o[4], o[5]); w.w = cvt_pk_bf16(o[6], o[7]);
                    *(GAS v4u*)(CAT + row * 1024 + col) = w; }
                ss += __shfl_xor(ss, 16); ss += __shfl_xor(ss, 32);
                if (fq == 0) ((GAS float*)SSA)[row * 8 + u.pn * 4 + wc] = ss; }
    }
};
struct EpiResid {
    static constexpr bool PERM = false;
    float* H; const bf16* O; int has_o; int dry;
    __device__ __forceinline__ void operator()(const f32x4 (&acc)[2][2][4][2], const Unit& u, int wr, int wc, int fr, int fq) const {
        asm volatile("" : "+v"(fr));
#pragma unroll
        for (int ai = 0; ai < 2; ++ai)
#pragma unroll
            for (int m = 0; m < 4; ++m) { const size_t row = (size_t)u.pm * 256 + ai * HALF + wr * 64 + m * 16 + fr;
#pragma unroll
                for (int bj = 0; bj < 2; ++bj)
#pragma unroll
                    for (int n = 0; n < 2; ++n) { const int col = u.pn * 256 + bj * HALF + wc * 32 + n * 16 + fq * 4;
                        GAS f32x4* hp = (GAS f32x4*)(H + row * D + col); f32x4 v = *hp + acc[ai][bj][m][n];
                        if (has_o) { const v2u x = *(const GAS v2u*)(O + row * 2 * D + col), y = *(const GAS v2u*)(O + row * 2 * D + D + col);
                            v.x += bflo(x.x) + bflo(y.x); v.y += bfhi(x.x) + bfhi(y.x); v.z += bflo(x.y) + bflo(y.y); v.w += bfhi(x.y) + bfhi(y.y); }
                        if (!dry) *hp = v; } }
    }
};

__device__ __forceinline__ void resid_tail(Frame& F, const bf16* A, const bf16* Bt, int has_o, int dry) {
    PHASE_IDS();
    const int fr = lane & 15, fq = lane >> 4;
    LAS f32x4* part = (LAS f32x4*)(F.lds + RING_OFF);
    float* H = (float*)(wsl + WS_H); const bf16* O = (const bf16*)(wsl + WS_O);
    for (int mu = F.c; mu < 256; mu += F.G) { const int r0 = (TP / 256 - 1) * 256 + 16 * (mu >> 4), c0 = 64 * (mu & 15);
        const bf16* ap = A + (size_t)(r0 + fr) * 1024 + 128 * wave + 8 * fq;
        bf16x8 af[4];
#pragma unroll
        for (int ks = 0; ks < 4; ++ks) af[ks] = *(const GAS bf16x8*)(ap + 32 * ks);
        f32x4 acc[4];
#pragma unroll
        for (int nt = 0; nt < 4; ++nt) { acc[nt] = (f32x4){0.f, 0.f, 0.f, 0.f}; const bf16* bp = Bt + (size_t)(c0 + 16 * nt + fr) * 1024 + 128 * wave + 8 * fq;
            bf16x8 bfv[4];
#pragma unroll
            for (int ks = 0; ks < 4; ++ks) bfv[ks] = *(const GAS bf16x8*)(bp + 32 * ks);
#pragma unroll
            for (int ks = 0; ks < 4; ++ks) acc[nt] = __builtin_amdgcn_mfma_f32_16x16x32_bf16(bfv[ks], af[ks], acc[nt], 0, 0, 0); }
        __syncthreads();
#pragma unroll
        for (int nt = 0; nt < 4; ++nt) part[(wave * 4 + nt) * 64 + lane] = acc[nt];
        __syncthreads();
        if (wave < 4) { const int nt = wave; f32x4 s = part[(0 * 4 + nt) * 64 + lane];
#pragma unroll
            for (int w = 1; w < 8; ++w) s += part[(w * 4 + nt) * 64 + lane];
            const size_t row = (size_t)r0 + fr; const int col = c0 + 16 * nt + 4 * fq;
            GAS f32x4* hp = (GAS f32x4*)(H + row * D + col); f32x4 v = *hp + s;
            if (has_o) { const v2u x = *(const GAS v2u*)(O + row * 2 * D + col), y = *(const GAS v2u*)(O + row * 2 * D + D + col);
                v.x += bflo(x.x) + bflo(y.x); v.y += bfhi(x.x) + bfhi(y.x); v.z += bflo(x.y) + bflo(y.y); v.w += bfhi(x.y) + bfhi(y.y); }
            if (!dry) *hp = v; }
    }
    __syncthreads();
}

constexpr int S5_UP = 264, S5_XP = 136;
__device__ __forceinline__ void s5_unit(Frame& F, int j, int b, int g) {
    PHASE_IDS();
    const int fr = lane & 15, fq = lane >> 4;
    LAS bf16* Uc = (LAS bf16*)(F.lds + RING_OFF); LAS bf16* EX = Uc + 144 * S5_UP;
    const unsigned char* wm = wsl + WS_WMIX + (size_t)j * WM_AB_STRIDE;
    const bf16* Z = (const bf16*)(wsl + WS_ACT + B_Z); bf16* YS = (bf16*)(wsl + WS_ACT + B_YS);
    const bf16* BX = (const bf16*)(wm + WM_BX) + (size_t)g * 128 * 256; const bf16* TC = (const bf16*)(wm + WM_TC) + (size_t)g * 256 * 384;
    const size_t row0 = (size_t)b * LP + PRE;
    __syncthreads();
    for (int i = tid; i < L * 2; i += NT) { const int t = i >> 1, hf = i & 1;
        const v4u x = *(const GAS v4u*)(Z + (row0 + t) * 1536 + g * 16 + hf * 8);
        *(LAS v4u*)(Uc + (t >> 4) * S5_UP + (t & 15) * 16 + hf * 8) = x; }
    __syncthreads();
    {
        f32x4 acc[9];
#pragma unroll
        for (int mt = 0; mt < 9; ++mt) acc[mt] = (f32x4){0.f, 0.f, 0.f, 0.f};
#pragma unroll 2
        for (int ks = 0; ks < 8; ++ks) { const bf16x8 bf = *(const GAS bf16x8*)(BX + (size_t)(16 * wave + fr) * 256 + 32 * ks + 8 * fq);
#pragma unroll
            for (int mt = 0; mt < 9; ++mt) { const bf16x8 af = *(const LAS bf16x8*)(Uc + (16 * mt + fr) * S5_UP + 32 * ks + 8 * fq); acc[mt] = __builtin_amdgcn_mfma_f32_16x16x32_bf16(bf, af, acc[mt], 0, 0, 0); } }
#pragma unroll
        for (int mt = 0; mt < 9; ++mt) { v2u w; w.x = pk2(acc[mt][0], acc[mt][1]); w.y = pk2(acc[mt][2], acc[mt][3]); *(LAS v2u*)(EX + (16 * mt + fr) * S5_XP + 16 * wave + 4 * fq) = w; }
    }
    __syncthreads();
    if (tid < 64) {
        const f32x2 A = ((const GAS f32x2*)(wm + WM_APW))[g * 64 + tid]; float xr = 0.f, xi = 0.f;
        LAS unsigned* ex = (LAS unsigned*)EX + tid;
#pragma unroll 4
        for (int c = 0; c < 129; ++c) { const unsigned e = ex[c * (S5_XP / 2)]; ex[c * (S5_XP / 2)] = pk2(xr, xi);
            const float er = bflo(e), ei = bfhi(e); const float nr = A.x * xr - A.y * xi + er, ni = A.x * xi + A.y * xr + ei; xr = nr; xi = ni; }
    }
    __syncthreads();
    {
        f32x4 acc[2][9];
#pragma unroll
        for (int nt = 0; nt < 2; ++nt)
#pragma unroll
            for (int mt = 0; mt < 9; ++mt) acc[nt][mt] = (f32x4){0.f, 0.f, 0.f, 0.f};
#pragma unroll 2
        for (int ks = 0; ks < 12; ++ks) {
            bf16x8 bf[2];
#pragma unroll
            for (int nt = 0; nt < 2; ++nt) bf[nt] = *(const GAS bf16x8*)(TC + (size_t)(16 * (2 * wave + nt) + fr) * 384 + 32 * ks + 8 * fq);
#pragma unroll
            for (int mt = 0; mt < 9; ++mt) { const bf16x8 af = (ks < 8) ? *(const LAS bf16x8*)(Uc + (16 * mt + fr) * S5_UP + 32 * ks + 8 * fq) : *(const LAS bf16x8*)(EX + (16 * mt + fr) * S5_XP + 32 * (ks - 8) + 8 * fq);
#pragma unroll
                for (int nt = 0; nt < 2; ++nt) acc[nt][mt] = __builtin_amdgcn_mfma_f32_16x16x32_bf16(bf[nt], af, acc[nt][mt], 0, 0, 0); } }
#pragma unroll
        for (int nt = 0; nt < 2; ++nt)
#pragma unroll
            for (int mt = 0; mt < 9; ++mt) { const int c = 16 * mt + fr, tt = 16 * c + 2 * wave + nt;
                if (tt < L) { const f32x4 y = acc[nt][mt]; v2u w; w.x = pk2(gelu_tanh_f(y[0]), gelu_tanh_f(y[1])); w.y = pk2(gelu_tanh_f(y[2]), gelu_tanh_f(y[3]));
                    *(GAS v2u*)(YS + (row0 + tt) * 512 + g * 16 + 4 * fq) = w; } }
    }
}

__device__ __forceinline__ void lru_unit(Frame& F, const Args& a, int j, int b, int hd, int q4) {
    PHASE_IDS();
    const int fr = lane & 15, fq = lane >> 4;
    constexpr int XP = 72;
    LAS bf16* XC = (LAS bf16*)(F.lds + RING_OFF);
    LAS f32x2* ABv = (LAS f32x2*)(F.lds + RING_OFF + 128 * XP * 2);
    LAS f32x2* PS = ABv + 128 * 16;
    LAS float* carry = (LAS float*)(PS + 32 * 16);
    const unsigned char* wm = wsl + WS_WMIX + (size_t)j * WM_AB_STRIDE;
    const bf16* Z = (const bf16*)(wsl + WS_ACT + B_Z); bf16* CAT = (bf16*)(wsl + WS_ACT + B_CAT); float* SSB = (float*)(wsl + WS_ACT + B_SSB);
    const size_t row0 = (size_t)b * LP + PRE;
    const int cbase = hd * 64;
    const bf16* LW = (const bf16*)(wm + WM_LRUW) + (size_t)hd * 128 * 64;
    bf16x8 wa[2], wx[2];
#pragma unroll
    for (int ks = 0; ks < 2; ++ks) { wa[ks] = *(const GAS bf16x8*)(LW + (size_t)(16 * q4 + fr) * 64 + 32 * ks + 8 * fq); wx[ks] = *(const GAS bf16x8*)(LW + (size_t)(64 + 16 * q4 + fr) * 64 + 32 * ks + 8 * fq); }
    const int oc = tid & 7; float cw[4][8], cb[8];
#pragma unroll
    for (int e = 0; e < 8; ++e) { cb[e] = a.in[20][j * 512 + cbase + 8 * oc + e];
#pragma unroll
        for (int k = 0; k < 4; ++k) cw[k][e] = a.in[19][(j * 4 + k) * 512 + cbase + 8 * oc + e]; }
    float ba[4], bx[4], sp8[4];
#pragma unroll
    for (int e = 0; e < 4; ++e) { const int c = cbase + 16 * q4 + 4 * fq + e; ba[e] = a.in[22][j * 512 + c]; bx[e] = a.in[24][j * 512 + c]; const float lam = a.in[25][j * 512 + c]; sp8[e] = 8.0f * (lam < -20.f ? -lam : log1pf(__expf(-lam))); }
    const int cc = tid & 15, sub = tid >> 4; const int cs = cbase + 16 * q4 + cc;
    __syncthreads();
    if (tid < 16) carry[tid] = 0.f;
    v4u rec[2][4];
#define LRU_LOAD_REC(t0) do { _Pragma("unroll") for (int i = 0; i < 2; ++i) { const int tl = (tid + 512 * i) >> 3; \
        _Pragma("unroll") for (int k = 0; k < 4; ++k) { const int tt = (t0) + tl - 3 + k; \
            rec[i][k] = (tt >= 0 && tt < L) ? *(const GAS v4u*)(Z + (row0 + tt) * 1536 + 1024 + cbase + 8 * oc) : (v4u){0u, 0u, 0u, 0u}; } } } while (0)
    LRU_LOAD_REC(0);
    for (int tile = 0; tile < 17; ++tile) { const int t0 = tile * 128;
        unsigned short gz[4];
#pragma unroll
        for (int s = 0; s < 4; ++s) { const int tt = t0 + 4 * sub + s; gz[s] = tt < L ? ((const GAS unsigned short*)Z)[(row0 + tt) * 1536 + 512 + cs] : (unsigned short)0; }
#pragma unroll
        for (int i = 0; i < 2; ++i) { const int tl = (tid + 512 * i) >> 3; float x[8];
#pragma unroll
            for (int e = 0; e < 8; ++e) x[e] = cb[e];
#pragma unroll
            for (int k = 0; k < 4; ++k) { const v4u r = rec[i][k];
                x[0] += cw[k][0] * bflo(r.x); x[1] += cw[k][1] * bfhi(r.x); x[2] += cw[k][2] * bflo(r.y); x[3] += cw[k][3] * bfhi(r.y);
                x[4] += cw[k][4] * bflo(r.z); x[5] += cw[k][5] * bfhi(r.z); x[6] += cw[k][6] * bflo(r.w); x[7] += cw[k][7] * bfhi(r.w); }
            v4u w; w.x = pk2(x[0], x[1]); w.y = pk2(x[2], x[3]); w.z = pk2(x[4], x[5]); w.w = pk2(x[6], x[7]);
            *(LAS v4u*)(XC + tl * XP + 8 * oc) = w; }
        if (tile < 16) LRU_LOAD_REC(t0 + 128);
        LDS_BARRIER();
        {
            const int tl = 16 * wave + fr; f32x4 ra = (f32x4){0.f, 0.f, 0.f, 0.f}, rx = ra;
#pragma unroll
            for (int ks = 0; ks < 2; ++ks) { const bf16x8 af = *(const LAS bf16x8*)(XC + tl * XP + 32 * ks + 8 * fq);
                ra = __builtin_amdgcn_mfma_f32_16x16x32_bf16(wa[ks], af, ra, 0, 0, 0); rx = __builtin_amdgcn_mfma_f32_16x16x32_bf16(wx[ks], af, rx, 0, 0, 0); }
            const v2u xq = *(const LAS v2u*)(XC + tl * XP + 16 * q4 + 4 * fq); const float xv[4] = {bflo(xq.x), bfhi(xq.x), bflo(xq.y), bfhi(xq.y)};
            const bool valid = (t0 + tl) < L;
#pragma unroll
            for (int e = 0; e < 4; ++e) { const float r = sigmoid_f(ra[e] + ba[e]), ig = sigmoid_f(rx[e] + bx[e]); const float la = -r * sp8[e];
                const float av = __expf(la), bv = sqrtf(-expm1f(2.f * la)) * (ig * xv[e]);
                f32x2 abw; abw.x = valid ? av : 1.f; abw.y = valid ? bv : 0.f; ABv[tl * 16 + 4 * fq + e] = abw; }
        }
        LDS_BARRIER();
        {
            float P = 1.f, hl = 0.f;
#pragma unroll
            for (int s = 0; s < 4; ++s) { const f32x2 ab = ABv[(4 * sub + s) * 16 + cc]; hl = ab.x * hl + ab.y; P *= ab.x; }
            PS[sub * 16 + cc] = (f32x2){P, hl};
        }
        LDS_BARRIER();
        {
            float h = carry[cc];
            for (int s2 = 0; s2 < sub; ++s2) { const f32x2 ps = PS[s2 * 16 + cc]; h = ps.x * h + ps.y; }
#pragma unroll
            for (int s = 0; s < 4; ++s) { const int tt = t0 + 4 * sub + s; const f32x2 ab = ABv[(4 * sub + s) * 16 + cc]; h = ab.x * h + ab.y;
                const float o = gelu_tanh_f(bf2f(gz[s])) * h; float ss = o * o;
                ss = sum16(ss);
                if (tt < L) { ((GAS unsigned short*)CAT)[(row0 + tt) * 1024 + 512 + cs] = (unsigned short)f2bf(o); if (cc == 0) ((GAS float*)SSB)[(row0 + tt) * 32 + hd * 4 + q4] = ss; } }
            LDS_BARRIER();
            if (sub == 31) carry[cc] = h;
        }
        LDS_BARRIER();
    }
#undef LRU_LOAD_REC
}

__device__ __forceinline__ void pass_abnorm(Frame& F, const float* na, const float* nb, int dry) {
    PHASE_IDS();
    const int gw = F.c * NWAVES + wave, NGW = F.G * NWAVES;
    bf16* CAT = (bf16*)(wsl + WS_ACT + B_CAT); const float* SSA = (const float*)(wsl + WS_ACT + B_SSA); const float* SSB = (const float*)(wsl + WS_ACT + B_SSB);
    float ga[8], gb[8];
#pragma unroll
    for (int e = 0; e < 8; ++e) { ga[e] = na[8 * lane + e]; gb[e] = nb[8 * lane + e]; }
    const int rchunk = (TP + F.G - 1) / F.G, rlim = (F.c + 1) * rchunk < TP ? (F.c + 1) * rchunk : TP;
    for (int row = F.c * rchunk + wave; row < rlim; row += NWAVES) {
        GAS v4u* p = (GAS v4u*)(CAT + (size_t)row * 1024) + lane;
        if ((row % LP) < PRE) { p[0] = (v4u){0u, 0u, 0u, 0u}; p[64] = (v4u){0u, 0u, 0u, 0u}; continue; }
        float sa = 0.f, sb = 0.f;
#pragma unroll
        for (int e = 0; e < 8; ++e) sa += ((const GAS float*)SSA)[(size_t)row * 8 + e];
#pragma unroll
        for (int e = 0; e < 32; ++e) sb += ((const GAS float*)SSB)[(size_t)row * 32 + e];
        const float ra = rsqrtf(sa * (1.f / 512.f) + RMS_EPS), rb = rsqrtf(sb * (1.f / 512.f) + RMS_EPS);
        v4u x = p[0], y = p[64];
        x.x = pk2(bflo(x.x) * ra * ga[0], bfhi(x.x) * ra * ga[1]); x.y = pk2(bflo(x.y) * ra * ga[2], bfhi(x.y) * ra * ga[3]); x.z = pk2(bflo(x.z) * ra * ga[4], bfhi(x.z) * ra * ga[5]); x.w = pk2(bflo(x.w) * ra * ga[6], bfhi(x.w) * ra * ga[7]);
        y.x = pk2(bflo(y.x) * rb * gb[0], bfhi(y.x) * rb * gb[1]); y.y = pk2(bflo(y.y) * rb * gb[2], bfhi(y.y) * rb * gb[3]); y.z = pk2(bflo(y.z) * rb * gb[4], bfhi(y.z) * rb * gb[5]); y.w = pk2(bflo(y.w) * rb * gb[6], bfhi(y.w) * rb * gb[7]);
        if (!dry) { p[0] = x; p[64] = y; }
    }
}
}
namespace fk {
constexpr size_t WM_RW_STRIDE = 11 * MiB;
constexpr size_t RW_WRKV = 0;
constexpr size_t RW_WO = 6 * MiB;
constexpr size_t RW_L1 = 8 * MiB;
constexpr size_t RW_W2W = 10 * MiB;
constexpr size_t RW_W2A = 10 * MiB + 128 * KiB;
constexpr size_t RW_W2G = 10 * MiB + 256 * KiB;
constexpr size_t RW_W2V = 10 * MiB + 512 * KiB;
static_assert(WM_RW + 2 * WM_RW_STRIDE <= 50 * MiB, "mixer weights fit");
constexpr size_t RB = (size_t)TP * D * 2;
constexpr size_t R_HN = 0;
constexpr size_t R_XR = 1 * RB, R_XK = 2 * RB, R_XV = 3 * RB;
constexpr size_t R_R = 4 * RB, R_K = 5 * RB, R_V = 6 * RB;
constexpr size_t R_L1 = 7 * RB;
constexpr size_t R_END = R_L1 + (size_t)TP * 512 * 2;
static_assert(R_END <= ACT_BYTES, "RWKV activations fit");

__device__ __forceinline__ void transpose_item_s(const float* W, int ldw, int k0, int n0, bf16* dst, int ldd, LAS float* scr, int lane, const float* mu, int mode, int kcount) {
    for (int i = 0; i < kcount / 2; ++i) { const int kk = 2 * i + (lane >> 5); float s = 1.f; if (mode == 1) s = mu[k0 + kk]; else if (mode == 2) s = 1.f - mu[k0 + kk];
        scr[kk * 33 + (lane & 31)] = W[(size_t)(k0 + kk) * ldw + n0 + (lane & 31)] * s; }
    LDS_WAIT(); asm volatile("" ::: "memory");
    const int c = lane & 7;
    if (8 * c < kcount) {
#pragma unroll
        for (int jj = 0; jj < 4; ++jj) { const int n = (lane >> 3) + 8 * jj; const LAS float* s = scr + (8 * c) * 33 + n;
            v4u o; o.x = pk2(s[0 * 33], s[1 * 33]); o.y = pk2(s[2 * 33], s[3 * 33]); o.z = pk2(s[4 * 33], s[5 * 33]); o.w = pk2(s[6 * 33], s[7 * 33]);
            *(GAS v4u*)(dst + (size_t)n * ldd + 8 * c) = o; } }
    LDS_WAIT(); asm volatile("" ::: "memory");
}
__device__ __forceinline__ void prologue_rw(Frame& F, const Args& a) {
    PHASE_IDS();
    const int gw = F.c * NWAVES + wave, NGW = F.G * NWAVES;
    LAS float* scr = (LAS float*)(F.lds + RING_OFF + wave * 16384);
    constexpr int I_SQ = 512, I_L1 = 288, I_W2 = 32 + 32 + 64 + 32, I_RW = 4 * I_SQ + I_L1 + I_W2;
    for (int it = gw; it < 2 * I_RW; it += NGW) { const int j = it / I_RW; int r = it % I_RW; unsigned char* wm = wsl + WS_WMIX + WM_RW + (size_t)j * WM_RW_STRIDE;
        if (r < 4 * I_SQ) { const int m = r / I_SQ, q = r % I_SQ, kb = q >> 5, nb = q & 31;
            const float* W = a.in[m == 0 ? 27 : m == 1 ? 28 : m == 2 ? 29 : 30] + (size_t)j * D * D;
            bf16* dst = (m < 3 ? (bf16*)(wm + RW_WRKV) + (size_t)m * D * D : (bf16*)(wm + RW_WO)) + (size_t)nb * 32 * 1024 + kb * 64;
            transpose_item_s(W, 1024, kb * 64, nb * 32, dst, 1024, scr, lane, nullptr, 0, 64); continue; } r -= 4 * I_SQ;
        if (r < I_L1) { const int part = r & 1, q = r >> 1, kb = q & 15, nbx = q >> 4;
            const float* mu = a.in[26] + (size_t)j * 6 * D; const float* W; int ldw, n0, muix, drow;
            if (nbx < 2) { W = a.in[32] + (size_t)j * D * 64; ldw = 64; n0 = nbx * 32; muix = 1; drow = n0; }
            else if (nbx < 4) { W = a.in[35] + (size_t)j * D * 64; ldw = 64; n0 = (nbx - 2) * 32; muix = 4; drow = 64 + n0; }
            else if (nbx < 8) { W = a.in[40] + (size_t)j * D * 128; ldw = 128; n0 = (nbx - 4) * 32; muix = 5; drow = 128 + n0; }
            else { if (j == 0) continue; W = a.in[38] + (size_t)(j - 1) * D * 32; ldw = 32; n0 = 0; muix = 3; drow = 256; }
            bf16* dst = (bf16*)(wm + RW_L1) + (size_t)drow * 2048 + part * 1024 + kb * 64;
            transpose_item_s(W, ldw, kb * 64, n0, dst, 2048, scr, lane, mu + muix * D, part == 0 ? 1 : 2, 64); continue; } r -= I_L1;
        if (r < 32) { transpose_item_s(a.in[33] + (size_t)j * 64 * D, 1024, 0, r * 32, (bf16*)(wm + RW_W2W) + (size_t)r * 32 * 64, 64, scr, lane, nullptr, 0, 64); continue; } r -= 32;
        if (r < 32) { transpose_item_s(a.in[36] + (size_t)j * 64 * D, 1024, 0, r * 32, (bf16*)(wm + RW_W2A) + (size_t)r * 32 * 64, 64, scr, lane, nullptr, 0, 64); continue; } r -= 32;
        if (r < 64) { const int kb = r >> 5, nb = r & 31; transpose_item_s(a.in[41] + (size_t)j * 128 * D, 1024, kb * 64, nb * 32, (bf16*)(wm + RW_W2G) + (size_t)nb * 32 * 128 + kb * 64, 128, scr, lane, nullptr, 0, 64); continue; } r -= 64;
        if (j > 0) transpose_item_s(a.in[39] + (size_t)(j - 1) * 32 * D, 1024, 0, r * 32, (bf16*)(wm + RW_W2V) + (size_t)r * 32 * 32, 32, scr, lane, nullptr, 0, 32);
    }
    { GAS v4u* z = (GAS v4u*)(wsl + WS_WMIX + WM_RW + WM_RW_STRIDE + RW_L1 + (size_t)288 * 2048 * 2); const int n16 = 224 * 2048 * 2 / 16;
      for (int i = F.c * NT + tid; i < n16; i += F.G * NT) z[i] = (v4u){0u, 0u, 0u, 0u}; }
}

__device__ __forceinline__ void pass_rwin(Frame& F, const float* gain, const float* mu, int has_o) {
    PHASE_IDS();
    const int gw = F.c * NWAVES + wave, NGW = F.G * NWAVES;
    f32x4 g[4], mr[4], mk[4], mv[4];
#pragma unroll
    for (int q = 0; q < 4; ++q) { g[q] = *(const GAS f32x4*)(gain + 256 * q + 4 * lane); mr[q] = *(const GAS f32x4*)(mu + 0 * D + 256 * q + 4 * lane); mk[q] = *(const GAS f32x4*)(mu + 2 * D + 256 * q + 4 * lane); mv[q] = *(const GAS f32x4*)(mu + 3 * D + 256 * q + 4 * lane); }
    const float* H = (const float*)(wsl + WS_H); const bf16* O = (const bf16*)(wsl + WS_O);
    unsigned char* act = wsl + WS_ACT;
    const int uchunk = (TP / 8 + F.G - 1) / F.G, ulim = (F.c + 1) * uchunk < TP / 8 ? (F.c + 1) * uchunk : TP / 8;
    for (int run = F.c * uchunk + wave; run < ulim; run += NWAVES) { const int r0 = run * 8, rb = run % (LP / 8);
        f32x4 prev[4];
#pragma unroll
        for (int q = 0; q < 4; ++q) prev[q] = (f32x4){0.f, 0.f, 0.f, 0.f};
        if (rb < 2) {
            for (int rr = 0; rr < 8; ++rr) { const int row = r0 + rr;
                GAS v2u* o0 = (GAS v2u*)(act + R_HN + (size_t)row * D * 2) + lane; GAS v2u* o1 = (GAS v2u*)(act + R_XR + (size_t)row * D * 2) + lane;
                GAS v2u* o2 = (GAS v2u*)(act + R_XK + (size_t)row * D * 2) + lane; GAS v2u* o3 = (GAS v2u*)(act + R_XV + (size_t)row * D * 2) + lane;
#pragma unroll
                for (int q = 0; q < 4; ++q) { o0[64 * q] = (v2u){0u, 0u}; o1[64 * q] = (v2u){0u, 0u}; o2[64 * q] = (v2u){0u, 0u}; o3[64 * q] = (v2u){0u, 0u}; } }
            continue; }
        RowBuf cur, nxt;
        const int first = (rb > 2) ? -1 : 0;
        row_issue(cur, H, O, r0 + first, has_o, lane);
        for (int rr = first; rr < 8; ++rr) { const int row = r0 + rr;
            if (rr < 7) row_issue(nxt, H, O, row + 1, has_o, lane);
            const float rs = row_finish(cur, has_o);
            if (rr < 0) {
#pragma unroll
                for (int q = 0; q < 4; ++q) prev[q] = cur.v[q] * rs * g[q];
            } else {
                GAS v2u* o0 = (GAS v2u*)(act + R_HN + (size_t)row * D * 2) + lane; GAS v2u* o1 = (GAS v2u*)(act + R_XR + (size_t)row * D * 2) + lane;
                GAS v2u* o2 = (GAS v2u*)(act + R_XK + (size_t)row * D * 2) + lane; GAS v2u* o3 = (GAS v2u*)(act + R_XV + (size_t)row * D * 2) + lane;
#pragma unroll
                for (int q = 0; q < 4; ++q) { const f32x4 cu = cur.v[q] * rs * g[q], dx = prev[q] - cu; prev[q] = cu;
                    const f32x4 xr = cu + dx * mr[q], xk = cu + dx * mk[q], xv = cu + dx * mv[q];
                    v2u w; w.x = pk2(cu.x, cu.y); w.y = pk2(cu.z, cu.w); o0[64 * q] = w;
                    w.x = pk2(xr.x, xr.y); w.y = pk2(xr.z, xr.w); o1[64 * q] = w;
                    w.x = pk2(xk.x, xk.y); w.y = pk2(xk.z, xk.w); o2[64 * q] = w;
                    w.x = pk2(xv.x, xv.y); w.y = pk2(xv.z, xv.w); o3[64 * q] = w; } }
            cur = nxt;
        }
    }
}

struct RwSched {
    const char* act; const char* wm; int nl  , G, c;
    __device__ __forceinline__ void single(int s, Unit& u) const { const int which = s / 260, rem = s % 260, pm = rem >> 2, pn = rem & 3;
        u.A = act + (which == 0 ? R_XR : which == 1 ? R_XK : R_XV) + (size_t)pm * 256 * 2048; u.B = wm + RW_WRKV + ((size_t)which * 1024 + pn * 256) * 2048;
        u.rows = nullptr; u.nvalid = 0; u.lda2 = 2048; u.ldb2 = 2048; u.nt = 16; u.pm = pm; u.pn = pn; u.x0 = which; u.x1 = 0; }
    __device__ __forceinline__ void dbl(int d, Unit& u) const { const int pm = d / nl, pn = d % nl;
        u.A = act + R_HN + ((size_t)pm * 256 - 1) * 2048; u.B = wm + RW_L1 + (size_t)pn * 256 * 4096;
        u.rows = nullptr; u.nvalid = 0; u.lda2 = 2048; u.ldb2 = 4096; u.nt = 32; u.pm = pm; u.pn = pn; u.x0 = 3; u.x1 = 0; }
    __device__ __forceinline__ bool next(int i, Unit& u) const {
        const int nd = 65 * nl, ns = 780; int rho;
        if (c < nd) { if (i == 0) { dbl(c, u); return true; } rho = (i - 1) * G + c; }
        else { if (i < 2) { const int s = 2 * (c - nd) + i; if (s >= ns) return false; single(s, u); return true; } rho = (i - 2) * G + c; }
        const int s = 2 * (G - nd) + rho; if (s >= ns || G < nd) return false;
        single(s, u); return true;
    }
};
struct EpiRw {
    static constexpr bool PERM = true;
    bf16* Rb; bf16* Kb; bf16* Vb; bf16* L1b;
    __device__ __forceinline__ void operator()(const f32x4 (&acc)[2][2][4][2], const Unit& u, int wr, int wc, int fr, int fq) const {
        asm volatile("" : "+v"(fr));
        const int lora = (u.x0 == 3); const int ldo = lora ? 512 : 1024;
        GAS unsigned char* ob = (GAS unsigned char*)(u.x0 == 0 ? Rb : u.x0 == 1 ? Kb : u.x0 == 2 ? Vb : L1b) + ((size_t)u.pm * 256 * ldo + u.pn * 256 + wc * 32) * 2;
#pragma unroll
        for (int bj = 0; bj < 2; ++bj) { const int act = (lora && u.pn == 0) ? (bj == 0 ? (wc < 2 ? 1 : 0) : 2) : 0;
#pragma unroll
            for (int ai = 0; ai < 2; ++ai)
#pragma unroll
                for (int m = 0; m < 4; ++m) { const int r = ai * HALF + wr * 64 + m * 16 + fr; float o[8];
#pragma unroll
                    for (int n = 0; n < 2; ++n)
#pragma unroll
                        for (int q = 0; q < 4; ++q) { const float x = acc[ai][bj][m][n][q]; o[n * 4 + q] = act == 1 ? (2.f * sigmoid_f(2.f * x) - 1.f) : act == 2 ? sigmoid_f(x) : x; }
                    v4u w; w.x = cvt_pk_bf16(o[0], o[1]); w.y = cvt_pk_bf16(o[2], o[3]); w.z = cvt_pk_bf16(o[4], o[5]); w.w = cvt_pk_bf16(o[6], o[7]);
                    *(GAS v4u*)(ob + ((unsigned)r * (unsigned)ldo * 2u + (unsigned)(bj * 256 + fq * 16))) = w; } }
    }
};

__device__ __forceinline__ void rw_prep_unit(Frame& F, const Args& a, int j, int hd, int rng, int dry) {
    PHASE_IDS();
    const int fr = lane & 15, fq = lane >> 4;
    constexpr int PW = 72, PG = 136, PV = 40;
    LAS bf16* Lw = (LAS bf16*)(F.lds + RING_OFF); LAS bf16* La = Lw + 64 * PW; LAS bf16* Lg = La + 64 * PW; LAS bf16* Lv = Lg + 64 * PG;
    LAS float* cst = (LAS float*)(Lv + 64 * PV);
    const unsigned char* wm = wsl + WS_WMIX + WM_RW + (size_t)j * WM_RW_STRIDE; unsigned char* act = wsl + WS_ACT;
    __syncthreads();
    for (int i = tid; i < 64 * 8; i += NT) { const int n = i >> 3, c8 = i & 7;
        *(LAS v4u*)(Lw + n * PW + 8 * c8) = *(const GAS v4u*)((const bf16*)(wm + RW_W2W) + (size_t)(hd * 64 + n) * 64 + 8 * c8);
        *(LAS v4u*)(La + n * PW + 8 * c8) = *(const GAS v4u*)((const bf16*)(wm + RW_W2A) + (size_t)(hd * 64 + n) * 64 + 8 * c8); }
    for (int i = tid; i < 64 * 16; i += NT) { const int n = i >> 4, c8 = i & 15; *(LAS v4u*)(Lg + n * PG + 8 * c8) = *(const GAS v4u*)((const bf16*)(wm + RW_W2G) + (size_t)(hd * 64 + n) * 128 + 8 * c8); }
    if (j > 0) for (int i = tid; i < 64 * 4; i += NT) { const int n = i >> 2, c8 = i & 3; *(LAS v4u*)(Lv + n * PV + 8 * c8) = *(const GAS v4u*)((const bf16*)(wm + RW_W2V) + (size_t)(hd * 64 + n) * 32 + 8 * c8); }
    if (tid < 64) { const int c = hd * 64 + tid; cst[tid] = a.in[31][j * D + c]; cst[64 + tid] = a.in[34][j * D + c]; cst[128 + tid] = j > 0 ? a.in[37][(j - 1) * D + c] : 0.f; cst[192 + tid] = a.in[42][j * D + c]; cst[256 + tid] = a.in[43][j * D + c]; }
    __syncthreads();
    const bf16* L1 = (const bf16*)(act + R_L1); bf16* Kb = (bf16*)(act + R_K); bf16* Vb = (bf16*)(act + R_V); const bf16* VF = (const bf16*)(wsl + WS_VF);
    bf16* WLb = (bf16*)(act + R_XR); bf16* KKb = (bf16*)(act + R_XK); bf16* BBb = (bf16*)(act + R_XV); bf16* GGb = (bf16*)(act + R_HN);
    for (int tile = rng * 65 + wave; tile < rng * 65 + 65; tile += NWAVES) {
        if (tile % (LP / 16) == 0) continue;
        const size_t row = (size_t)tile * 16 + fr;
        const bf16* lr = L1 + row * 512 + 8 * fq;
        bf16x8 aw[2], aa[2], ag[4], av;
#pragma unroll
        for (int ks = 0; ks < 2; ++ks) { aw[ks] = *(const GAS bf16x8*)(lr + 32 * ks); aa[ks] = *(const GAS bf16x8*)(lr + 64 + 32 * ks); }
#pragma unroll
        for (int ks = 0; ks < 4; ++ks) ag[ks] = *(const GAS bf16x8*)(lr + 128 + 32 * ks);
        av = *(const GAS bf16x8*)(lr + 256);
        const size_t cb = row * D + hd * 64 + 4 * fq;
        float kx[4][4], aq[4][4], kq[4][4]; float ss = 0.f;
#pragma unroll
        for (int nt = 0; nt < 4; ++nt) { f32x4 ca = (f32x4){0.f, 0.f, 0.f, 0.f};
#pragma unroll
            for (int ks = 0; ks < 2; ++ks) ca = __builtin_amdgcn_mfma_f32_16x16x32_bf16(*(const LAS bf16x8*)(La + (16 * nt + fr) * PW + 32 * ks + 8 * fq), aa[ks], ca, 0, 0, 0);
            const v2u kk2 = *(const GAS v2u*)(Kb + cb + 16 * nt); const float kv[4] = {bflo(kk2.x), bfhi(kk2.x), bflo(kk2.y), bfhi(kk2.y)};
#pragma unroll
            for (int e = 0; e < 4; ++e) { const int ch = 16 * nt + 4 * fq + e; aq[nt][e] = sigmoid_f(cst[64 + ch] + ca[e]); kq[nt][e] = kv[e]; kx[nt][e] = kv[e] * cst[192 + ch]; ss += kx[nt][e] * kx[nt][e]; } }
        ss += __shfl_xor(ss, 16); ss += __shfl_xor(ss, 32);
        const float inv = 1.f / fmaxf(sqrtf(ss), 1e-12f);
#pragma unroll
        for (int nt = 0; nt < 4; ++nt) { f32x4 cw_ = (f32x4){0.f, 0.f, 0.f, 0.f}, cg = cw_, cv = cw_;
#pragma unroll
            for (int ks = 0; ks < 2; ++ks) cw_ = __builtin_amdgcn_mfma_f32_16x16x32_bf16(*(const LAS bf16x8*)(Lw + (16 * nt + fr) * PW + 32 * ks + 8 * fq), aw[ks], cw_, 0, 0, 0);
#pragma unroll
            for (int ks = 0; ks < 4; ++ks) cg = __builtin_amdgcn_mfma_f32_16x16x32_bf16(*(const LAS bf16x8*)(Lg + (16 * nt + fr) * PG + 32 * ks + 8 * fq), ag[ks], cg, 0, 0, 0);
            if (j > 0) cv = __builtin_amdgcn_mfma_f32_16x16x32_bf16(*(const LAS bf16x8*)(Lv + (16 * nt + fr) * PV + 8 * fq), av, cv, 0, 0, 0);
            float wl[4], kn[4], bb[4], k2[4];
#pragma unroll
            for (int e = 0; e < 4; ++e) { const int ch = 16 * nt + 4 * fq + e; const float x = cst[ch] + cw_[e];
                const float sp = (-x > 20.f) ? -x : log1pf(__expf(-x)); wl[e] = -__expf(-sp - 0.5f);
                kn[e] = kx[nt][e] * inv; bb[e] = kn[e] * aq[nt][e]; k2[e] = kq[nt][e] * (1.f + (aq[nt][e] - 1.f) * cst[256 + ch]); }
            if (dry) continue;
            v2u w; const size_t off = cb + 16 * nt;
            w.x = pk2(wl[0], wl[1]); w.y = pk2(wl[2], wl[3]); *(GAS v2u*)(WLb + off) = w;
            w.x = pk2(kn[0], kn[1]); w.y = pk2(kn[2], kn[3]); *(GAS v2u*)(KKb + off) = w;
            w.x = pk2(bb[0], bb[1]); w.y = pk2(bb[2], bb[3]); *(GAS v2u*)(BBb + off) = w;
            w.x = pk2(k2[0], k2[1]); w.y = pk2(k2[2], k2[3]); *(GAS v2u*)(Kb + off) = w;
            w.x = pk2(cg[0], cg[1]); w.y = pk2(cg[2], cg[3]); *(GAS v2u*)(GGb + off) = w;
            if (j > 0) { const v2u v2 = *(const GAS v2u*)(Vb + off), f2 = *(const GAS v2u*)(VF + off); const float vv[4] = {bflo(v2.x), bfhi(v2.x), bflo(v2.y), bfhi(v2.y)}, vf[4] = {bflo(f2.x), bfhi(f2.x), bflo(f2.y), bfhi(f2.y)}; float vo[4];
#pragma unroll
                for (int e = 0; e < 4; ++e) { const int ch = 16 * nt + 4 * fq + e; vo[e] = vv[e] + (vf[e] - vv[e]) * sigmoid_f(cst[128 + ch] + cv[e]); }
                w.x = pk2(vo[0], vo[1]); w.y = pk2(vo[2], vo[3]); *(GAS v2u*)(Vb + off) = w; }
        }
    }
}

__device__ __forceinline__ void wkv_unit(Frame& F, const Args& a, int j, int b, int hd, int dry) {
    PHASE_IDS();
    constexpr int TB = 32;
    LAS float* buf = (LAS float*)(F.lds + RING_OFF);
    LAS float* yb = buf + 2 * 6 * TB * 64;
    unsigned char* act = wsl + WS_ACT;
    const int ahi = tid >> 8;
    const bf16* src0 = (const bf16*)(act + (ahi ? R_XR : R_XK)); const bf16* src1 = (const bf16*)(act + (ahi ? R_K : R_XV));
    const bf16* src2 = ahi ? (j == 0 ? (const bf16*)(wsl + WS_VF) : (const bf16*)(act + R_V)) : (const bf16*)(act + R_R);
    bf16* GG = (bf16*)(act + R_HN);
    const size_t row0 = (size_t)b * LP + PRE; const int cbase = hd * 64;
    const int i = tid >> 3, jo = tid & 7;
    float S[8];
#pragma unroll
    for (int e = 0; e < 8; ++e) S[e] = 0.f;
    v4u st[3];
#define WKV_LOAD(t0) do { _Pragma("unroll") for (int q = 0; q < 3; ++q) { const int tk = (tid >> 3) & 31, c8 = tid & 7; const int tt = (t0) + tk; const bf16* sp_ = q == 0 ? src0 : q == 1 ? src1 : src2; \
        st[q] = tt < L ? *(const GAS v4u*)(sp_ + (row0 + tt) * D + cbase + 8 * c8) : (v4u){0u, 0u, 0u, 0u}; } } while (0)
#define WKV_STORE(bi) do { _Pragma("unroll") for (int q = 0; q < 3; ++q) { const int p = tid + NT * q, arr = p >> 8, tk = (p >> 3) & 31, c8 = p & 7; \
        float x[8] = {bflo(st[q].x), bfhi(st[q].x), bflo(st[q].y), bfhi(st[q].y), bflo(st[q].z), bfhi(st[q].z), bflo(st[q].w), bfhi(st[q].w)}; \
        if (arr == 0) { _Pragma("unroll") for (int e = 0; e < 8; ++e) x[e] = -x[e]; } \
        if (arr == 1) { _Pragma("unroll") for (int e = 0; e < 8; ++e) x[e] = __expf(x[e]); } \
        LAS f32x4* d = (LAS f32x4*)(buf + ((bi) * 6 + arr) * TB * 64 + tk * 64 + 8 * c8); d[0] = (f32x4){x[0], x[1], x[2], x[3]}; d[1] = (f32x4){x[4], x[5], x[6], x[7]}; } } while (0)
    const float* rk = a.in[44] + (size_t)(j * 16 + hd) * 64; const float* lnw = a.in[45] + j * D + cbase; const float* lnb = a.in[46] + j * D + cbase;
    __syncthreads();
    WKV_LOAD(0); WKV_STORE(0);
    __syncthreads();
    constexpr int NBLK = (L + TB - 1) / TB;
    for (int blk = 0; blk < NBLK; ++blk) { const int bi = blk & 1, t0 = blk * TB;
        if (blk + 1 < NBLK) WKV_LOAD(t0 + TB);
        const LAS float* A_ = buf + (bi * 6 + 0) * TB * 64 + 8 * jo; const LAS float* W_ = buf + (bi * 6 + 1) * TB * 64 + 8 * jo; const LAS float* B_ = buf + (bi * 6 + 2) * TB * 64 + 8 * jo;
        const LAS float* K_ = buf + (bi * 6 + 3) * TB * 64 + 8 * jo; const LAS float* R_ = buf + (bi * 6 + 4) * TB * 64 + 8 * jo; const LAS float* V_ = buf + (bi * 6 + 5) * TB * 64 + i;
#pragma unroll 2
        for (int tk = 0; tk < TB; ++tk) {
            const f32x4 a0 = *(const LAS f32x4*)(A_ + tk * 64), a1 = *(const LAS f32x4*)(A_ + tk * 64 + 4), w0 = *(const LAS f32x4*)(W_ + tk * 64), w1 = *(const LAS f32x4*)(W_ + tk * 64 + 4);
            const f32x4 b0 = *(const LAS f32x4*)(B_ + tk * 64), b1 = *(const LAS f32x4*)(B_ + tk * 64 + 4), k0 = *(const LAS f32x4*)(K_ + tk * 64), k1 = *(const LAS f32x4*)(K_ + tk * 64 + 4);
            const f32x4 r0 = *(const LAS f32x4*)(R_ + tk * 64), r1 = *(const LAS f32x4*)(R_ + tk * 64 + 4); const float vi = V_[tk * 64];
            float sa = (S[0] * a0.x + S[1] * a0.y) + (S[2] * a0.z + S[3] * a0.w) + (S[4] * a1.x + S[5] * a1.y) + (S[6] * a1.z + S[7] * a1.w);
            sa = sum8(sa);
            S[0] = S[0] * w0.x + (sa * b0.x + vi * k0.x); S[1] = S[1] * w0.y + (sa * b0.y + vi * k0.y); S[2] = S[2] * w0.z + (sa * b0.z + vi * k0.z); S[3] = S[3] * w0.w + (sa * b0.w + vi * k0.w);
            S[4] = S[4] * w1.x + (sa * b1.x + vi * k1.x); S[5] = S[5] * w1.y + (sa * b1.y + vi * k1.y); S[6] = S[6] * w1.z + (sa * b1.z + vi * k1.z); S[7] = S[7] * w1.w + (sa * b1.w + vi * k1.w);
            float y = (S[0] * r0.x + S[1] * r0.y) + (S[2] * r0.z + S[3] * r0.w) + (S[4] * r1.x + S[5] * r1.y) + (S[6] * r1.z + S[7] * r1.w);
            y = sum8(y);
            if (jo == 0) yb[tk * 64 + i] = y;
        }
        __syncthreads();
        {
            const int tk = tid >> 4, i4 = 4 * (tid & 15), tt = t0 + tk;
            const f32x4 y4 = *(const LAS f32x4*)(yb + tk * 64 + i4);
            const f32x4 r4 = *(const LAS f32x4*)(buf + (bi * 6 + 4) * TB * 64 + tk * 64 + i4), k4 = *(const LAS f32x4*)(buf + (bi * 6 + 3) * TB * 64 + tk * 64 + i4), v4 = *(const LAS f32x4*)(buf + (bi * 6 + 5) * TB * 64 + tk * 64 + i4);
            const f32x4 rk4 = *(const GAS f32x4*)(rk + i4);
            float s1 = (y4.x + y4.y) + (y4.z + y4.w), s3 = (r4.x * k4.x * rk4.x + r4.y * k4.y * rk4.y) + (r4.z * k4.z * rk4.z + r4.w * k4.w * rk4.w);
            s1 = sum16(s1); s3 = sum16(s3);
            const float mean = s1 * (1.f / 64.f); const f32x4 d4 = y4 - mean; float s2 = (d4.x * d4.x + d4.y * d4.y) + (d4.z * d4.z + d4.w * d4.w);
            s2 = sum16(s2);
            const float rstd = rsqrtf(s2 * (1.f / 64.f) + 64e-5f);
            if (tt < L && !dry) { GAS v2u* gp = (GAS v2u*)(GG + (row0 + tt) * D + cbase + i4); const v2u g2 = *gp; const f32x4 lw4 = *(const GAS f32x4*)(lnw + i4), lb4 = *(const GAS f32x4*)(lnb + i4);
                const float o0 = (d4.x * rstd * lw4.x + lb4.x + s3 * v4.x) * bflo(g2.x), o1 = (d4.y * rstd * lw4.y + lb4.y + s3 * v4.y) * bfhi(g2.x);
                const float o2 = (d4.z * rstd * lw4.z + lb4.z + s3 * v4.z) * bflo(g2.y), o3 = (d4.w * rstd * lw4.w + lb4.w + s3 * v4.w) * bfhi(g2.y);
                v2u w; w.x = pk2(o0, o1); w.y = pk2(o2, o3); *gp = w; }
        }
        if (blk + 1 < NBLK) WKV_STORE(bi ^ 1);
        __syncthreads();
    }
#undef WKV_LOAD
#undef WKV_STORE
}
}
namespace fk {
__device__ __forceinline__ bf16x8 frag_z() { return (bf16x8){0, 0, 0, 0, 0, 0, 0, 0}; }
__device__ __forceinline__ void wkv_chunk_unit(Frame& F, const Args& a, int j, int b, int hd, int dry) {
    PHASE_IDS();
    const int fr = lane & 15, fq = lane >> 4;
    constexpr int P72 = 72, P24 = 24, P40 = 40;
    constexpr int O_RAW = 0;
    constexpr int O_AT = O_RAW + 2 * 6 * 2048, O_BH = O_AT + 16 * P72 * 2, O_KH = O_BH + 16 * P72 * 2, O_RT = O_KH + 16 * P72 * 2;
    constexpr int O_ATT = O_RT + 16 * P72 * 2;
    constexpr int O_BKT = O_ATT + 64 * P24 * 2;
    constexpr int O_UV = O_BKT + 64 * P40 * 2, O_UV0 = O_UV + 64 * P40 * 2;
    constexpr int O_NN = O_UV0 + 64 * P40 * 2;
    constexpr int O_NAK = O_NN + 16 * P40 * 2, O_TT = O_NAK + 16 * P24 * 2, O_W2T = O_TT + 16 * P24 * 2;
    constexpr int O_NABT = O_W2T + 16 * P24 * 2;
    constexpr int O_PQ = O_NABT + 1024;
    constexpr int O_P1 = O_PQ + 32 * P72 * 2;
    constexpr int O_S = O_P1 + 64 * P24 * 2;
    constexpr int O_YB = O_S + 64 * P72 * 2;
    constexpr int O_GC = O_YB + 4096;
    static_assert(O_GC + 256 <= RING_BYTES, "wkv LDS");
    LAS unsigned char* lb = F.lds + RING_OFF;
#define LBF(off) ((LAS bf16*)(lb + (off)))
    unsigned char* act = wsl + WS_ACT;
    const size_t row0 = (size_t)b * LP + PRE; const int cbase = hd * 64;
    const int ar0 = tid >> 7;
    const bf16* s0p = (const bf16*)(act + (ar0 == 0 ? R_XK : ar0 == 1 ? R_XR : ar0 == 2 ? R_XV : R_K));
    const bf16* s1p = (ar0 == 0) ? (const bf16*)(act + R_R) : (j == 0 ? (const bf16*)(wsl + WS_VF) : (const bf16*)(act + R_V));
    const int pt = (tid >> 3) & 15, pc8 = tid & 7;
    v4u pf0, pf1 = (v4u){0u, 0u, 0u, 0u};
#define WKC_LOAD(c) do { const size_t ro_ = (row0 + (size_t)(c) * 16 + pt) * D + cbase + 8 * pc8; pf0 = *(const GAS v4u*)(s0p + ro_); if (tid < 256) pf1 = *(const GAS v4u*)(s1p + ro_); } while (0)
#define WKC_STORE(bi) do { *(LAS v4u*)(lb + O_RAW + (bi) * 12288 + ar0 * 2048 + pt * 128 + pc8 * 16) = pf0; if (tid < 256) *(LAS v4u*)(lb + O_RAW + (bi) * 12288 + (4 + ar0) * 2048 + pt * 128 + pc8 * 16) = pf1; } while (0)
    const float* rk = a.in[44] + (size_t)(j * 16 + hd) * 64; const float* lnw = a.in[45] + j * D + cbase; const float* lnb = a.in[46] + j * D + cbase;
    bf16* GG = (bf16*)(act + R_HN);
    const int et = (tid >> 4) & 15, ei4 = 4 * (tid & 15);
    const f32x4 rk4 = *(const GAS f32x4*)(rk + ei4), lw4 = *(const GAS f32x4*)(lnw + ei4), lb4 = *(const GAS f32x4*)(lnb + ei4);
    v2u gpre = (v2u){0u, 0u};
    __syncthreads();
    for (int i = tid; i < 64 * P72 / 2; i += NT) ((LAS unsigned*)(lb + O_S))[i] = 0u;
    f32x4 sacc[2] = {(f32x4){0.f, 0.f, 0.f, 0.f}, (f32x4){0.f, 0.f, 0.f, 0.f}};
    WKC_LOAD(0); WKC_STORE(0);
    __syncthreads();
    constexpr int NCH = L / 16;
    for (int c = 0; c < NCH; ++c) { const int bi = c & 1;
        const LAS bf16* RAW = LBF(O_RAW + bi * 12288);
        if (c + 1 < NCH) WKC_LOAD(c + 1);
        if (tid < 256) gpre = *(const GAS v2u*)(GG + (row0 + (size_t)c * 16 + et) * D + cbase + ei4);
        {
            const int jj = tid & 63, t0 = 2 * wave;
            float run = 0.f, lgm0 = 0.f, lg0 = 0.f, lg1 = 0.f;
#pragma unroll
            for (int s = 0; s < 16; ++s) { const float w_ = bf2f(RAW[1 * 1024 + s * 64 + jj]); if (s == t0) lgm0 = run; run += w_; if (s == t0) lg0 = run; if (s == t0 + 1) lg1 = run; }
            const float lgC = run;
            const float kk0 = bf2f(RAW[0 * 1024 + t0 * 64 + jj]), kk1 = bf2f(RAW[0 * 1024 + (t0 + 1) * 64 + jj]), bb0 = bf2f(RAW[2 * 1024 + t0 * 64 + jj]), bb1 = bf2f(RAW[2 * 1024 + (t0 + 1) * 64 + jj]);
            const float k0 = bf2f(RAW[3 * 1024 + t0 * 64 + jj]), k1 = bf2f(RAW[3 * 1024 + (t0 + 1) * 64 + jj]), r0 = bf2f(RAW[4 * 1024 + t0 * 64 + jj]), r1 = bf2f(RAW[4 * 1024 + (t0 + 1) * 64 + jj]);
            const unsigned v01 = (unsigned)RAW[5 * 1024 + t0 * 64 + jj] | ((unsigned)RAW[5 * 1024 + (t0 + 1) * 64 + jj] << 16);
            const float em0 = __expf(lgm0), em1 = __expf(lg0), en0 = __expf(-lg0), en1 = __expf(-lg1), ep0 = __expf(lg0), ep1 = __expf(lg1), ec0 = __expf(lgC - lg0), ec1 = __expf(lgC - lg1);
            const unsigned at0 = f2bf(-kk0 * em0), at1 = f2bf(-kk1 * em1);
            LBF(O_AT)[t0 * P72 + jj] = (bf16)at0; LBF(O_AT)[(t0 + 1) * P72 + jj] = (bf16)at1;
            LBF(O_BH)[t0 * P72 + jj] = (bf16)f2bf(bb0 * en0); LBF(O_BH)[(t0 + 1) * P72 + jj] = (bf16)f2bf(bb1 * en1);
            LBF(O_KH)[t0 * P72 + jj] = (bf16)f2bf(k0 * en0); LBF(O_KH)[(t0 + 1) * P72 + jj] = (bf16)f2bf(k1 * en1);
            LBF(O_RT)[t0 * P72 + jj] = (bf16)f2bf(r0 * ep0); LBF(O_RT)[(t0 + 1) * P72 + jj] = (bf16)f2bf(r1 * ep1);
            *(LAS unsigned*)(LBF(O_ATT) + jj * P24 + t0) = at0 | (at1 << 16);
            *(LAS unsigned*)(LBF(O_BKT) + jj * P40 + t0) = pk2(bb0 * ec0, bb1 * ec1);
            *(LAS unsigned*)(LBF(O_BKT) + jj * P40 + 16 + t0) = pk2(k0 * ec0, k1 * ec1);
            *(LAS unsigned*)(LBF(O_UV) + jj * P40 + 16 + t0) = v01; *(LAS unsigned*)(LBF(O_UV0) + jj * P40 + 16 + t0) = v01;
            if (wave == 0) ((LAS float*)(lb + O_GC))[jj] = __expf(lgC);
        }
        LDS_BARRIER();
        if (wave < 4) {
            const LAS bf16* Am = LBF(wave == 1 ? O_AT : (wave == 3 ? O_KH : O_BH)); const LAS bf16* Bm = LBF(wave == 0 ? O_AT : (wave == 1 ? O_KH : O_RT));
            f32x4 d = (f32x4){0.f, 0.f, 0.f, 0.f};
#pragma unroll
            for (int ks = 0; ks < 2; ++ks) d = __builtin_amdgcn_mfma_f32_16x16x32_bf16(*(const LAS bf16x8*)(Am + fr * P72 + 32 * ks + 8 * fq), *(const LAS bf16x8*)(Bm + fr * P72 + 32 * ks + 8 * fq), d, 0, 0, 0);
            if (wave == 0) { f32x4 o;
#pragma unroll
                for (int e = 0; e < 4; ++e) o[e] = (4 * fq + e < fr) ? d[e] : 0.f;
                *(LAS f32x4*)(lb + O_NABT + (fr * 16 + 4 * fq) * 4) = o; }
            else if (wave == 1) { float o[4];
#pragma unroll
                for (int e = 0; e < 4; ++e) o[e] = (fr < 4 * fq + e) ? d[e] : 0.f;
                v2u w; w.x = pk2(o[0], o[1]); w.y = pk2(o[2], o[3]); *(LAS v2u*)(LBF(O_NAK) + fr * P24 + 4 * fq) = w; }
            else { float o[4];
#pragma unroll
                for (int e = 0; e < 4; ++e) o[e] = (4 * fq + e <= fr) ? d[e] : 0.f;
                v2u w; w.x = pk2(o[0], o[1]); w.y = pk2(o[2], o[3]); *(LAS v2u*)(LBF(O_NN) + fr * P40 + (wave == 3 ? 16 : 0) + 4 * fq) = w; }
        }
        LDS_BARRIER();
        if (wave == 0) {
            float T[16];
#pragma unroll
            for (int t = 0; t < 16; ++t) { float s_ = (fr == t) ? 1.f : 0.f;
#pragma unroll
                for (int s4 = 0; s4 < (t + 3) / 4; ++s4) { const f32x4 m4 = *(const LAS f32x4*)(lb + O_NABT + (t * 16 + 4 * s4) * 4);
#pragma unroll
                    for (int e = 0; e < 4; ++e) if (4 * s4 + e < t) s_ += T[4 * s4 + e] * m4[e]; }
                T[t] = s_; }
            if (lane < 16) {
#pragma unroll
                for (int t = 0; t < 16; ++t) LBF(O_TT)[t * P24 + fr] = (bf16)f2bf(T[t]); }
        }
        LDS_BARRIER();
        if (wave < 4) {
            const bf16x8 af = fq < 2 ? *(const LAS bf16x8*)(LBF(O_ATT) + (16 * wave + fr) * P24 + 8 * fq) : frag_z();
            const bf16x8 bfv = fq < 2 ? *(const LAS bf16x8*)(LBF(O_TT) + fr * P24 + 8 * fq) : frag_z();
            const f32x4 d = __builtin_amdgcn_mfma_f32_16x16x32_bf16(af, bfv, (f32x4){0.f, 0.f, 0.f, 0.f}, 0, 0, 0);
            v2u w; w.x = pk2(d[0], d[1]); w.y = pk2(d[2], d[3]);
            *(LAS v2u*)(LBF(O_PQ) + fr * P72 + 16 * wave + 4 * fq) = w;
#pragma unroll
            for (int e = 0; e < 4; ++e) LBF(O_P1)[(16 * wave + 4 * fq + e) * P24 + fr] = (bf16)f2bf(d[e]);
        } else if (wave == 4) {
            const bf16x8 af = fq < 2 ? *(const LAS bf16x8*)(LBF(O_NAK) + fr * P24 + 8 * fq) : frag_z();
            const bf16x8 bfv = fq < 2 ? *(const LAS bf16x8*)(LBF(O_TT) + fr * P24 + 8 * fq) : frag_z();
            const f32x4 d = __builtin_amdgcn_mfma_f32_16x16x32_bf16(af, bfv, (f32x4){0.f, 0.f, 0.f, 0.f}, 0, 0, 0);
            v2u w; w.x = pk2(d[0], d[1]); w.y = pk2(d[2], d[3]); *(LAS v2u*)(LBF(O_W2T) + fr * P24 + 4 * fq) = w;
        }
        LDS_BARRIER();
        f32x4 acc;
        if (wave < 4) {
            const bf16x8 af = fq < 2 ? *(const LAS bf16x8*)(LBF(O_W2T) + fr * P24 + 8 * fq) : frag_z();
            const bf16x8 bfv = fq < 2 ? *(const LAS bf16x8*)(LBF(O_UV0) + (16 * wave + fr) * P40 + 16 + 8 * fq) : frag_z();
            acc = __builtin_amdgcn_mfma_f32_16x16x32_bf16(af, bfv, (f32x4){0.f, 0.f, 0.f, 0.f}, 0, 0, 0);
            v2u w; w.x = pk2(acc[0], acc[1]); w.y = pk2(acc[2], acc[3]); *(LAS v2u*)(LBF(O_UV0) + (16 * wave + fr) * P40 + 4 * fq) = w;
        } else {
            const int jt = wave - 4;
            const bf16x8 af = fq < 2 ? *(const LAS bf16x8*)(LBF(O_P1) + (16 * jt + fr) * P24 + 8 * fq) : frag_z();
            const bf16x8 bfv = fq < 2 ? *(const LAS bf16x8*)(LBF(O_NN) + fr * P40 + 8 * fq) : frag_z();
            const v2u rr = *(const LAS v2u*)(LBF(O_RT) + fr * P72 + 16 * jt + 4 * fq);
            const f32x4 d = __builtin_amdgcn_mfma_f32_16x16x32_bf16(af, bfv, (f32x4){bflo(rr.x), bfhi(rr.x), bflo(rr.y), bfhi(rr.y)}, 0, 0, 0);
            v2u w; w.x = pk2(d[0], d[1]); w.y = pk2(d[2], d[3]); *(LAS v2u*)(LBF(O_PQ) + (16 + fr) * P72 + 16 * jt + 4 * fq) = w;
        }
        LDS_BARRIER();
        {
            const int mt = wave >> 2, nt = wave & 3;
            if (wave >= 4) acc = __builtin_amdgcn_mfma_f32_16x16x32_bf16(*(const LAS bf16x8*)(LBF(O_NN) + fr * P40 + 8 * fq), *(const LAS bf16x8*)(LBF(O_UV0) + (16 * nt + fr) * P40 + 8 * fq), (f32x4){0.f, 0.f, 0.f, 0.f}, 0, 0, 0);
#pragma unroll
            for (int ks = 0; ks < 2; ++ks) acc = __builtin_amdgcn_mfma_f32_16x16x32_bf16(*(const LAS bf16x8*)(LBF(O_PQ) + (16 * mt + fr) * P72 + 32 * ks + 8 * fq), *(const LAS bf16x8*)(LBF(O_S) + (16 * nt + fr) * P72 + 32 * ks + 8 * fq), acc, 0, 0, 0);
            if (wave < 4) { v2u w; w.x = pk2(acc[0], acc[1]); w.y = pk2(acc[2], acc[3]); *(LAS v2u*)(LBF(O_UV) + (16 * nt + fr) * P40 + 4 * fq) = w; }
            else {
#pragma unroll
                for (int e = 0; e < 4; ++e) ((LAS float*)(lb + O_YB))[(4 * fq + e) * 64 + 16 * nt + fr] = acc[e]; }
        }
        LDS_BARRIER();
        {
            const int jt = wave >> 1; const f32x4 g4 = *(const LAS f32x4*)(lb + O_GC + (16 * jt + 4 * fq) * 4);
            const bf16x8 af = *(const LAS bf16x8*)(LBF(O_BKT) + (16 * jt + fr) * P40 + 8 * fq);
#pragma unroll
            for (int q = 0; q < 2; ++q) { const int it = 2 * (wave & 1) + q;
                sacc[q] = __builtin_amdgcn_mfma_f32_16x16x32_bf16(af, *(const LAS bf16x8*)(LBF(O_UV) + (16 * it + fr) * P40 + 8 * fq), sacc[q] * g4, 0, 0, 0);
                v2u w; w.x = pk2(sacc[q][0], sacc[q][1]); w.y = pk2(sacc[q][2], sacc[q][3]); *(LAS v2u*)(LBF(O_S) + (16 * it + fr) * P72 + 16 * jt + 4 * fq) = w; }
            if (tid < 256) { const int t = et, i4 = ei4;
                const f32x4 y4 = *(const LAS f32x4*)(lb + O_YB + (t * 64 + i4) * 4);
                const v2u r2 = *(const LAS v2u*)(RAW + 4 * 1024 + t * 64 + i4), k2 = *(const LAS v2u*)(RAW + 3 * 1024 + t * 64 + i4), v2 = *(const LAS v2u*)(RAW + 5 * 1024 + t * 64 + i4);
                float s1 = (y4.x + y4.y) + (y4.z + y4.w), s3 = (bflo(r2.x) * bflo(k2.x) * rk4.x + bfhi(r2.x) * bfhi(k2.x) * rk4.y) + (bflo(r2.y) * bflo(k2.y) * rk4.z + bfhi(r2.y) * bfhi(k2.y) * rk4.w);
                s1 = sum16(s1); s3 = sum16(s3);
                const float mean = s1 * (1.f / 64.f); const f32x4 d4 = y4 - mean; float s2 = (d4.x * d4.x + d4.y * d4.y) + (d4.z * d4.z + d4.w * d4.w);
                s2 = sum16(s2);
                const float rstd = rsqrtf(s2 * (1.f / 64.f) + 64e-5f);
                if (!dry) { GAS v2u* gp = (GAS v2u*)(GG + (row0 + (size_t)c * 16 + t) * D + cbase + i4); const v2u g2 = gpre;
                    const float o0 = (d4.x * rstd * lw4.x + lb4.x + s3 * bflo(v2.x)) * bflo(g2.x), o1 = (d4.y * rstd * lw4.y + lb4.y + s3 * bfhi(v2.x)) * bfhi(g2.x);
                    const float o2 = (d4.z * rstd * lw4.z + lb4.z + s3 * bflo(v2.y)) * bflo(g2.y), o3 = (d4.w * rstd * lw4.w + lb4.w + s3 * bfhi(v2.y)) * bfhi(g2.y);
                    v2u w; w.x = pk2(o0, o1); w.y = pk2(o2, o3); *gp = w; } }
            if (c + 1 < NCH) WKC_STORE(bi ^ 1);
        }
        LDS_BARRIER();
    }
#undef LBF
#undef WKC_LOAD
#undef WKC_STORE
}
}
namespace fk {
__global__ void __launch_bounds__(NT, 2) mega(Args args) {
    extern __shared__ __attribute__((aligned(16))) unsigned char lds_raw[];
    Frame F;
    F.lds = (LAS unsigned char*)lds_raw; F.MISC = (volatile LAS unsigned*)(F.lds + MISC_OFF);
    F.tid = threadIdx.x; F.lane = F.tid & 63; F.wave = __builtin_amdgcn_readfirstlane(F.tid >> 6);
    F.G = gridDim.x; F.c = blockIdx.x; F.vc = (F.G % 8 == 0) ? (int)(blockIdx.x % 8) * (F.G / 8) + (int)(blockIdx.x / 8) : (int)blockIdx.x; F.ws = args.ws; F.ctl = (unsigned*)(args.ws + WS_CTL);
    for (int u = F.tid; u < 256; u += NT) F.MISC[u] = 0u;
    __syncthreads();
    XcdBarrier bar = xcd_barrier_post(F.ctl + CW_BAR + args.li * XCD_BAR_WORDS, F.MISC + 8);
    const int lo = args.ph_lo, hi = args.ph_hi;
#define IN(k) (lo <= (k) && (k) < hi)
#if defined(PROBE) && PROBE
#define REP(grp) for (int rep_ = 0, nrep_ = (args.rep_group == (grp)) ? args.rep_n : 1; rep_ < nrep_; ++rep_)
#define DRY (rep_ + 1 < nrep_ ? 1 : 0)
#else
#define REP(grp)
#define DRY 0
#endif
#if defined(STAMP) && STAMP
    unsigned long long tacc = 0ull, tlast = __builtin_amdgcn_s_memrealtime();
#define TICK(cls) do { const unsigned long long tn_ = __builtin_amdgcn_s_memrealtime(); if ((STAMP_SEL >> (cls)) & 1) tacc += tn_ - tlast; tlast = tn_; } while (0)
#define SEAM(k) do { TICK(ptype_); if ((k) + 1 < hi) { xcd_barrier(bar); } TICK(20); } while (0)
#define PT(ty) const int ptype_ = (ty)
#else
#define TICK(cls)
#define PT(ty)
#define SEAM(k) do { if ((k) + 1 < hi) { REP(8) xcd_barrier(bar); } } while (0)
#endif
    if (IN(0)) { PT(0); REP(5) { prologue_ab(F, args); prologue_rw(F, args); } SEAM(0); }
    for (int l = 0; l < 4; ++l) {
        const int pb = 1 + 20 * l; const int has_o = (args.comb && l > 0) ? 1 : 0;
        unsigned char* wsl = F.ws; asm volatile("" : "+s"(wsl));
        if ((l & 1) == 0) {
            const int j = l >> 1; unsigned char* wm = wsl + WS_WMIX + (size_t)j * WM_AB_STRIDE; unsigned char* act = wsl + WS_ACT;
            if (IN(pb + 0)) { PT(1); REP(3) pass_norm(F, args.in[2] + l * D, has_o, (bf16*)(act + B_HN)); SEAM(pb + 0); }
            if (IN(pb + 1)) { PT(2);
                DenseSched S{(const char*)(act + B_HN), (const char*)(wm + WM_WIN), 2048, 2048, 16, TP / 256, 6, F.G, F.vc};
                EpiBf16 E{(bf16*)(act + B_Z), 1536};
                REP(1) gemm_stream<EpiBf16, DenseSched, false>(F.lds + RING_OFF, S, E);
                phase_done(F, F.ctl + CW_DONE + 64 * (2 * l)); moe_conv_drain(F, args, l, F.ctl + CW_DONE + 64 * (2 * l));
                SEAM(pb + 1);
            }
            if (IN(pb + 2)) { PT(3);
                REP(4) for (int u = F.c; u < 512; u += F.G) { if (u < 256) lru_unit(F, args, j, u >> 5, (u >> 2) & 7, u & 3); else s5_unit(F, j, (u - 256) >> 5, (u - 256) & 31); }
                SEAM(pb + 2);
            }
            if (IN(pb + 3)) { PT(4);
                DenseSched S{(const char*)(act + B_YS), (const char*)(wm + WM_WGLU), 1024, 1024, 8, TP / 256, 2, F.G, F.vc};
                EpiGlu E{(const bf16*)(act + B_YS), (bf16*)(act + B_CAT), args.in[18] + j * 512, (float*)(act + B_SSA)};
                REP(1) gemm_stream<EpiGlu, DenseSched, false>(F.lds + RING_OFF, S, E);
                phase_done(F, F.ctl + CW_DONE + 64 * (2 * l + 1)); moe_conv_drain(F, args, l, F.ctl + CW_DONE + 64 * (2 * l + 1));
                SEAM(pb + 3);
            }
            if (IN(pb + 4)) { PT(5); REP(3) pass_abnorm(F, args.in[7] + j * 512, args.in[8] + j * 512, DRY); SEAM(pb + 4); }
            if (IN(pb + 5)) { PT(6);
                DenseSched S{(const char*)(act + B_CAT), (const char*)(wm + WM_WOUT), 2048, 2048, 16, TP / 256 - 1, 4, F.G, F.vc};
                EpiResid E{(float*)(wsl + WS_H), (const bf16*)(wsl + WS_O), has_o, 0};
                REP(1) { E.dry = DRY; gemm_stream<EpiResid, DenseSched, false>(F.lds + RING_OFF, S, E); resid_tail(F, (const bf16*)(act + B_CAT), (const bf16*)(wm + WM_WOUT), has_o, DRY); }
                SEAM(pb + 5);
            }
        }
        if ((l & 1) == 1) {
            const int j = l >> 1; unsigned char* wm = wsl + WS_WMIX + WM_RW + (size_t)j * WM_RW_STRIDE; unsigned char* act = wsl + WS_ACT;
            if (IN(pb + 0)) { PT(7); REP(3) pass_rwin(F, args.in[2] + l * D, args.in[26] + (size_t)j * 6 * D, has_o); SEAM(pb + 0); }
            if (IN(pb + 1)) { PT(8);
                RwSched S{(const char*)act, (const char*)wm, j == 0 ? 1 : 2, F.G, F.vc};
                EpiRw E{(bf16*)(act + R_R), (bf16*)(act + R_K), j == 0 ? (bf16*)(wsl + WS_VF) : (bf16*)(act + R_V), (bf16*)(act + R_L1)};
                REP(1) gemm_stream<EpiRw, RwSched, false>(F.lds + RING_OFF, S, E);
                SEAM(pb + 1);
            }
            if (IN(pb + 2)) { PT(9); REP(6) for (int u = F.c; u < 256; u += F.G) rw_prep_unit(F, args, j, u >> 4, u & 15, DRY); SEAM(pb + 2); }
            if (IN(pb + 3)) { PT(10); REP(2) for (int u = F.c; u < 128; u += F.G) wkv_chunk_unit(F, args, j, u >> 4, u & 15, DRY); if (F.c >= 128) moe_conv_drain(F, args, l, nullptr); SEAM(pb + 3); }
            if (IN(pb + 4)) { PT(11);
                DenseSched S{(const char*)(act + R_HN), (const char*)(wm + RW_WO), 2048, 2048, 16, TP / 256 - 1, 4, F.G, F.vc};
                EpiResid E{(float*)(wsl + WS_H), (const bf16*)(wsl + WS_O), has_o, 0};
                REP(1) { E.dry = DRY; gemm_stream<EpiResid, DenseSched, false>(F.lds + RING_OFF, S, E); resid_tail(F, (const bf16*)(act + R_HN), (const bf16*)(wm + RW_WO), has_o, DRY); }
                SEAM(pb + 4);
            }
        }
        if (IN(pb + 10)) { PT(13); REP(3) moe_route(F, args, l, DRY); moe_conv_drain(F, args, l, nullptr); SEAM(pb + 10); }
        if (IN(pb + 11)) { PT(14);
            REP(7) moe_tables(F, l);
            MoeSched S{F.MISC + 64, (const char*)(wsl + WS_ACT + A_XN), (const char*)(wsl + WS_WMOE), (const int*)(wsl + WS_ACT + A_LIST), 2048, 2048, 16, F.G, F.vc, 1};
            EpiSwiglu E{(bf16*)(wsl + WS_ACT + A_HID), (const float*)(wsl + WS_ACT + A_LISTW)};
            REP(1) gemm_stream<EpiSwiglu, MoeSched, true>(F.lds + RING_OFF, S, E);
            SEAM(pb + 11);
        }
        if (IN(pb + 12)) { PT(15);
            REP(7) moe_tables(F, l);
            MoeSched S{F.MISC + 64, (const char*)(wsl + WS_ACT + A_HID), (const char*)(wsl + WS_WMOE + (size_t)16 * 1024 * 1024 * 2), nullptr, 1024, 1024, 8, F.G, F.vc, 0};
            EpiScatter E{(bf16*)(wsl + WS_O), (const int*)(wsl + WS_ACT + A_LISTD)};
            REP(1) gemm_stream<EpiScatter, MoeSched, false>(F.lds + RING_OFF, S, E);
            SEAM(pb + 12);
        }
    }
    if (IN(90)) { REP(3) pass_final(F, args.in[4], args.out); TICK(16); }
#if defined(STAMP) && STAMP
    if (blockIdx.x == 0 && threadIdx.x == 0) { const unsigned long long t0_ = __builtin_amdgcn_s_memrealtime(); while (__builtin_amdgcn_s_memrealtime() - t0_ < tacc * (unsigned long long)(STAMP_AMP)) __builtin_amdgcn_s_sleep(8); }
#endif
#undef IN
#undef SEAM
}
}
extern "C" void kernel_launch(void* const* d_in, const int* in_sizes, int n_in, void* d_out, int out_size, void* d_ws, size_t ws_size, hipStream_t stream) {
    using namespace fk;
    static int grid = 0;
    if (grid == 0) {
        int dev = 0, cus = 0;
        if (ws_size < WS_END || n_in != 54) { fprintf(stderr, "kernel_launch: bad sizes (ws %zu)\n", ws_size); grid = -1; return; }
        if (hipGetDevice(&dev) != hipSuccess || hipDeviceGetAttribute(&cus, hipDeviceAttributeMultiprocessorCount, dev) != hipSuccess) { grid = -1; return; }
        if (hipFuncSetAttribute((const void*)mega, hipFuncAttributeMaxDynamicSharedMemorySize, LDS_BYTES) != hipSuccess) { fprintf(stderr, "hipFuncSetAttribute failed\n"); grid = -1; return; }
        int per_cu = 0; (void)hipOccupancyMaxActiveBlocksPerMultiprocessor(&per_cu, (const void*)mega, NT, LDS_BYTES); (void)hipGetLastError();
        grid = cus;
    }
    if (grid < 0) return;
    unsigned char* ws = (unsigned char*)d_ws;
    (void)hipMemsetAsync(ws + WS_CTL, 0, CTL_ZERO_BYTES, stream);
    Args a{}; for (int i = 0; i < 54; ++i) a.in[i] = (const float*)d_in[i]; a.out = (float*)d_out; a.ws = ws; a.comb = 1;
    a.ph_lo = 0; a.ph_hi = 91; a.li = 0;
#if defined(PROBE) && PROBE
    a.rep_group = PROBE_GROUP; a.rep_n = PROBE_N;
#endif
    hipLaunchKernelGGL(mega, dim3(grid), dim3(NT), LDS_BYTES, stream, a);
}
```

```cpp
#include <hip/hip_runtime.h>
#include <cstdio>
#include <cstdint>
#define GAS __attribute__((address_space(1)))
#define LAS __attribute__((address_space(3)))
typedef unsigned short bf16;
typedef unsigned v4u __attribute__((ext_vector_type(4)));
typedef unsigned v2u __attribute__((ext_vector_type(2)));
typedef float f32x4 __attribute__((ext_vector_type(4)));
typedef float f32x2 __attribute__((ext_vector_type(2)));
typedef short bf16x8 __attribute__((ext_vector_type(8)));
#define LDS_WAIT() asm volatile("s_waitcnt lgkmcnt(0)" ::: "memory")
#define PHASE_IDS() int tid = threadIdx.x; asm volatile("" : "+v"(tid)); const int lane = tid & 63; const int wave = __builtin_amdgcn_readfirstlane(tid >> 6); (void)lane; (void)wave; unsigned char* wsl = F.ws; asm volatile("" : "+s"(wsl))
#define VM_WAIT() asm volatile("s_waitcnt vmcnt(0)" ::: "memory")
#define LDS_BARRIER() do { asm volatile("s_waitcnt lgkmcnt(0)" ::: "memory"); __builtin_amdgcn_s_barrier(); asm volatile("" ::: "memory"); } while (0)

namespace fk {
constexpr int D = 1024, NB = 8, SEQ = 2048, NMETA = 16, L = SEQ + NMETA, PRE = 16, LP = L + PRE, TP = NB * LP;
constexpr int NWAVES = 8, NT = 512;
constexpr float RMS_EPS = 1e-6f;
static_assert(TP % 256 == 0, "row padding");
constexpr int MOE_ROWS = 37120;
constexpr int LISTCAP = TP;

constexpr size_t MiB = 1u << 20;
constexpr size_t WS_CTL = 0, CTL_ZERO_BYTES = 1 * MiB;
constexpr size_t WS_WMIX = 1 * MiB;
constexpr size_t WS_WMOE = 51 * MiB;
constexpr size_t WS_H = 99 * MiB;
constexpr size_t WS_VF = 164 * MiB;
constexpr size_t WS_O = WS_VF + (size_t)TP * D * 2;
constexpr size_t WS_ACT = WS_O + (size_t)TP * 2 * D * 2;
constexpr size_t WS_END = 512 * MiB;
constexpr size_t ACT_BYTES = WS_END - WS_ACT;
constexpr size_t A_XN = 0;
constexpr size_t A_HID = A_XN + (size_t)TP * D * 2;
constexpr size_t A_LIST = A_HID + (size_t)MOE_ROWS * 512 * 2;
constexpr size_t A_LISTW = A_LIST + (size_t)16 * LISTCAP * 4;
constexpr size_t A_LISTD = A_LISTW + (size_t)16 * LISTCAP * 4;
constexpr size_t A_MOE_END = A_LISTD + (size_t)16 * LISTCAP * 4;
static_assert(A_MOE_END <= ACT_BYTES, "MoE activations fit");
constexpr int CW_BAR = 4096;
constexpr int CW_Q = 65536;
constexpr int CW_DONE = 98304;
constexpr int CW_CNT = 131072;

__device__ __forceinline__ unsigned f2bf(float f) { unsigned u = __builtin_bit_cast(unsigned, f); return (u + 0x7fffu + ((u >> 16) & 1u)) >> 16; }
__device__ __forceinline__ unsigned pk2(float lo, float hi) { return f2bf(lo) | (f2bf(hi) << 16); }
__device__ __forceinline__ float bf2f(unsigned b) { return __builtin_bit_cast(float, b << 16); }
__device__ __forceinline__ float bflo(unsigned w) { return __builtin_bit_cast(float, w << 16); }
__device__ __forceinline__ float bfhi(unsigned w) { return __builtin_bit_cast(float, w & 0xffff0000u); }
template <int CTRL> __device__ __forceinline__ float dpp_mov(float x) { return __builtin_bit_cast(float, __builtin_amdgcn_update_dpp(0, __builtin_bit_cast(int, x), CTRL, 0xf, 0xf, true)); }
__device__ __forceinline__ float sum8(float x) { x += dpp_mov<0xB1>(x); x += dpp_mov<0x4E>(x); x += dpp_mov<0x141>(x); return x; }
__device__ __forceinline__ float sum16(float x) { x = sum8(x); x += dpp_mov<0x140>(x); return x; }
__device__ __forceinline__ float wave_sum(float v) {
    v = sum16(v);
    const float s0 = __builtin_bit_cast(float, __builtin_amdgcn_readlane(__builtin_bit_cast(int, v), 0)), s1 = __builtin_bit_cast(float, __builtin_amdgcn_readlane(__builtin_bit_cast(int, v), 16));
    const float s2 = __builtin_bit_cast(float, __builtin_amdgcn_readlane(__builtin_bit_cast(int, v), 32)), s3 = __builtin_bit_cast(float, __builtin_amdgcn_readlane(__builtin_bit_cast(int, v), 48));
    return (s0 + s1) + (s2 + s3);
}
__device__ __forceinline__ float sigmoid_f(float x) { return 1.f / (1.f + __expf(-x)); }
__device__ __forceinline__ float gelu_tanh_f(float x) { const float u = 0.7978845608028654f * (x + 0.044715f * x * x * x); return x * sigmoid_f(2.f * u); }

#define XB_TMO      128
#define XB_XCNT(j)  (256  + 64 * (j))
#define XB_XSUB(j)  (1280 + 64 * (j))
#define XB_XGEN(j)  (2304 + 64 * (j))
#define XB_TOP      3328
#define XB_TOPGEN   3392
#define XCD_BAR_WORDS 3456
#define XB_SPIN_CAP (1u << 18)
__device__ __forceinline__ unsigned xb_ld(unsigned* p)              { return __hip_atomic_load(p, __ATOMIC_RELAXED, __HIP_MEMORY_SCOPE_AGENT); }
__device__ __forceinline__ unsigned xb_add(unsigned* p, unsigned v) { return __hip_atomic_fetch_add(p, v, __ATOMIC_RELAXED, __HIP_MEMORY_SCOPE_AGENT); }
__device__ __forceinline__ unsigned xb_xcc_id() { return (unsigned)__builtin_amdgcn_s_getreg((3 << 11) | 20) & 0xFu; }
#define XB_SPIN(cond, bar) do { unsigned _sp = 0; while (cond) { __builtin_amdgcn_s_sleep(1); \
    if ((++_sp & 255u) == 0u) { if (xb_ld(&(bar)[XB_TMO])) break; if (_sp > XB_SPIN_CAP) { atomicAdd(&(bar)[XB_TMO], 1u); break; } } } } while (0)
struct XcdBarrier { unsigned* bar; unsigned x; volatile LAS unsigned* st; };
__device__ __forceinline__ XcdBarrier xcd_barrier_post(unsigned* bar, volatile LAS unsigned* st) {
    XcdBarrier b; b.bar = bar; b.x = xb_xcc_id(); b.st = st;
    if (threadIdx.x == 0) (void)xb_add(&bar[XB_XCNT(b.x)], 1u);
    return b;
}
__device__ __forceinline__ void xcd_barrier_complete(unsigned* bar, unsigned x, unsigned& nloc, unsigned& nx) {
    const unsigned G = gridDim.x * gridDim.y * gridDim.z;
    unsigned sum, cnt, mine, sp = 0u;
    for (;;) {
        sum = 0u; cnt = 0u; mine = 0u;
#pragma unroll
        for (unsigned j = 0; j < 16; ++j) { const unsigned c = xb_ld(&bar[XB_XCNT(j)]); sum += c; cnt += (c > 0u) ? 1u : 0u; mine = (j == x) ? c : mine; }
        if (sum == G) break;
        __builtin_amdgcn_s_sleep(1);
        if ((++sp & 255u) == 0u) { if (xb_ld(&bar[XB_TMO])) break; if (sp > XB_SPIN_CAP) { atomicAdd(&bar[XB_TMO], 1u); break; } }
    }
    nloc = mine > 0u ? mine : 1u; nx = cnt > 0u ? cnt : 1u;
}
__device__ __forceinline__ void xcd_barrier(const XcdBarrier& b) {
    asm volatile("s_waitcnt vmcnt(0)" ::: "memory");
    __syncthreads();
    if (threadIdx.x == 0) {
        unsigned* bar = b.bar;
        __builtin_amdgcn_s_waitcnt(0);
        unsigned nloc = b.st[0], nx = b.st[1];
        if (nloc == 0u) { xcd_barrier_complete(bar, b.x, nloc, nx); b.st[0] = nloc; b.st[1] = nx; }
        const unsigned old = xb_add(&bar[XB_XSUB(b.x)], 1u);
        const unsigned gen = old / nloc;
        if (old + 1u == (gen + 1u) * nloc) {
            __builtin_amdgcn_fence(__ATOMIC_RELEASE, "agent");
            asm volatile("s_waitcnt vmcnt(0)" ::: "memory");
            const unsigned og = xb_add(&bar[XB_TOP], 1u);
            const unsigned tg = og / nx;
            if (og + 1u == (tg + 1u) * nx) xb_add(&bar[XB_TOPGEN], 1u);
            else XB_SPIN(xb_ld(&bar[XB_TOPGEN]) == tg, bar);
            __builtin_amdgcn_fence(__ATOMIC_ACQUIRE, "agent");
            xb_add(&bar[XB_XGEN(b.x)], 1u);
            asm volatile("s_waitcnt vmcnt(0)" ::: "memory");
        } else {
            XB_SPIN(xb_ld(&bar[XB_XGEN(b.x)]) == gen, bar);
            __builtin_amdgcn_fence(__ATOMIC_ACQUIRE, "agent");
            asm volatile("s_waitcnt vmcnt(0)" ::: "memory");
        }
    }
    __syncthreads();
}

constexpr int BM = 256, BK = 64, HALF = 128, HTB = HALF * BK * 2, STAGE_BYTES = 8 * HTB;
__host__ __device__ __forceinline__ int lds_byte(int r, int c) { const int st = (r >> 4) * 2 + (c >> 5), rr = r & 15, cc = c & 31, ob = rr * 64 + cc * 2; return st * 1024 + (ob ^ (((ob >> 9) & 1) << 5)); }
__host__ __device__ __forceinline__ void stage_rc(int b, int& R, int& C) { const int st = b / 1024, sb = b % 1024, swz = sb ^ (((sb >> 9) & 1) << 5); R = (st >> 1) * 16 + swz / 64; C = (st & 1) * 32 + (swz % 64) / 2; }
__host__ __device__ __forceinline__ int perm32(int rho) { const int n = rho >> 4, i = rho & 15; return 8 * (i >> 2) + 4 * n + (i & 3); }

struct Unit {
    const char* A;
    const char* B;
    const int* rows;
    int nvalid;
    int lda2, ldb2;
    int nt;
    int pm, pn, x0, x1;
};
template <bool GATHER> struct AOff { unsigned v[GATHER ? 4 : 1]; };
template <bool GATHER> __device__ __forceinline__ void unit_rows(const Unit& u, int R0, unsigned (&pk)[2]) {
    if constexpr (GATHER) {
#pragma unroll
        for (int h = 0; h < 2; ++h) { unsigned w = 0;
#pragma unroll
            for (int i = 0; i < 2; ++i) { const int r = h * HALF + R0 + 64 * i; const unsigned row = (r < u.nvalid) ? (unsigned)((const GAS int*)u.rows)[r] : 0u; w |= row << (16 * i); }
            pk[h] = w; }
    } else { pk[0] = 0; pk[1] = 0; }
}

template <class Epi, class Sched, bool GATHER>
__device__ __forceinline__ void gemm_stream(LAS unsigned char* lds, const Sched& S, const Epi& E) {
    int tid = threadIdx.x; asm volatile("" : "+v"(tid));
    const int wid = __builtin_amdgcn_readfirstlane(tid >> 6), lane = tid & 63, wr = wid >> 2, wc = wid & 3, fr = lane & 15, fq = lane >> 4;
    int R0, C0; stage_rc(tid * 16, R0, C0);
    const int Rb0 = Epi::PERM ? ((R0 & ~31) + perm32(R0 & 31)) : R0;
    const unsigned ldsw = (unsigned)wid * 1024u;
    const int aoff = lds_byte(wr * 64 + fr, fq * 8), boff = lds_byte(wc * 32 + fr, fq * 8);
#define G_SA(b, h) (((b) * 2 + (h)) * HTB)
#define G_SB(b, h) ((4 + (b) * 2 + (h)) * HTB)
#define G_STAGE_A(bufoff, gbase, h) do { _Pragma("unroll") for (int _i = 0; _i < 2; ++_i) { \
        const char* _p = GATHER ? ((const char*)(gbase) + vA[(h) * 2 + _i]) : ((const char*)(gbase) + (size_t)((h) * HALF + 64 * _i) * (size_t)ldA + vA[0]); \
        __builtin_amdgcn_global_load_lds((const unsigned*)_p, (LAS unsigned*)(lds + (bufoff) + ldsw + _i * 8192), 16, 0, 0); } } while (0)
#define G_STAGE_B(bufoff, gbase, h) do { _Pragma("unroll") for (int _i = 0; _i < 2; ++_i) \
        __builtin_amdgcn_global_load_lds((const unsigned*)((const char*)(gbase) + (size_t)((h) * HALF + 64 * _i) * (size_t)ldB + vB), (LAS unsigned*)(lds + (bufoff) + ldsw + _i * 8192), 16, 0, 0); } while (0)
#define G_LDA(dst, b, h) do { _Pragma("unroll") for (int m = 0; m < 4; ++m) _Pragma("unroll") for (int k = 0; k < 2; ++k) dst[m][k] = *(const LAS bf16x8*)(lds + G_SA(b, h) + aoff + m * 2048 + k * 1024); } while (0)
#define G_LDB(dst, b, h) do { _Pragma("unroll") for (int n = 0; n < 2; ++n) _Pragma("unroll") for (int k = 0; k < 2; ++k) dst[n][k] = *(const LAS bf16x8*)(lds + G_SB(b, h) + boff + n * 2048 + k * 1024); } while (0)
#define G_MMA(ai, bj, At, Bt) do { __builtin_amdgcn_s_setprio(1); _Pragma("unroll") for (int m = 0; m < 4; ++m) _Pragma("unroll") for (int n = 0; n < 2; ++n) _Pragma("unroll") for (int k = 0; k < 2; ++k) \
        acc[ai][bj][m][n] = __builtin_amdgcn_mfma_f32_16x16x32_bf16(Bt[n][k], At[m][k], acc[ai][bj][m][n], 0, 0, 0); __builtin_amdgcn_s_setprio(0); } while (0)
#define G_WAIT_V(n) asm volatile("s_waitcnt vmcnt(" #n ")" ::: "memory")
#define G_WAIT_L(n) asm volatile("s_waitcnt lgkmcnt(" #n ")" ::: "memory")
#define G_BAR __builtin_amdgcn_s_barrier()
#define G_SCHED __builtin_amdgcn_sched_barrier(0)
#define G_SET_OFFS(u, pk) do { ldA = (u).lda2; ldB = (u).ldb2; vB = (unsigned)Rb0 * (unsigned)ldB + (unsigned)C0 * 2u; \
        if constexpr (GATHER) { vA[0] = ((pk)[0] & 0xffffu) * (unsigned)ldA + (unsigned)C0 * 2u; vA[1] = ((pk)[0] >> 16) * (unsigned)ldA + (unsigned)C0 * 2u; \
                                vA[2] = ((pk)[1] & 0xffffu) * (unsigned)ldA + (unsigned)C0 * 2u; vA[3] = ((pk)[1] >> 16) * (unsigned)ldA + (unsigned)C0 * 2u; } \
        else { vA[0] = (unsigned)R0 * (unsigned)ldA + (unsigned)C0 * 2u; } } while (0)
    Unit cur, nxt; int ui = 0;
    if (!S.next(0, cur)) return;
    unsigned vA[GATHER ? 4 : 1], vB, pk[2]; int ldA, ldB;
    unit_rows<GATHER>(cur, R0, pk);
    G_SET_OFFS(cur, pk);
    f32x4 acc[2][2][4][2];
#pragma unroll
    for (int a = 0; a < 2; ++a)
#pragma unroll
        for (int b = 0; b < 2; ++b)
#pragma unroll
            for (int m = 0; m < 4; ++m)
#pragma unroll
                for (int n = 0; n < 2; ++n) acc[a][b][m][n] = (f32x4){0.f, 0.f, 0.f, 0.f};
    bf16x8 At[4][2], B0[2][2], B1[2][2];
    const char* cA = cur.A; const char* cB = cur.B;
    const size_t kstep = (size_t)(BK * 2);
    G_STAGE_B(G_SB(0, 0), cB, 0); G_STAGE_A(G_SA(0, 0), cA, 0); G_STAGE_B(G_SB(0, 1), cB, 1); G_STAGE_A(G_SA(0, 1), cA, 1);
    if (wr == 1) G_BAR;
    G_WAIT_V(4); G_BAR;
    G_STAGE_B(G_SB(1, 0), cB + kstep, 0); G_STAGE_A(G_SA(1, 0), cA + kstep, 0); G_STAGE_B(G_SB(1, 1), cB + kstep, 1);
    G_WAIT_V(6); G_BAR;
    for (;;) {
        const bool has_next = S.next(ui + 1, nxt);
        if (!has_next) nxt = cur;
        unit_rows<GATHER>(nxt, R0, pk);
        const char* nA = nxt.A; const char* nB = nxt.B;
        const int nt = cur.nt;
        for (int t = 0; t < nt; t += 2) {
            const bool last = (t == nt - 2);
            const char* a1 = cA + (size_t)(t + 1) * kstep;
            const char* a2 = last ? nA : cA + (size_t)(t + 2) * kstep; const char* b2 = last ? nB : cB + (size_t)(t + 2) * kstep;
            const char* a3 = a2 + kstep; const char* b3 = b2 + kstep;
            G_LDB(B0, 0, 0); G_SCHED; G_LDA(At, 0, 0); G_STAGE_A(G_SA(1, 1), a1, 1);
            if (last) { G_SET_OFFS(nxt, pk); }
            G_WAIT_L(8); G_BAR; G_WAIT_L(0); G_MMA(0, 0, At, B0); G_BAR; G_SCHED;
            G_LDB(B1, 0, 1); G_STAGE_B(G_SB(0, 0), b2, 0);
            G_BAR; G_WAIT_L(0); G_MMA(0, 1, At, B1); G_BAR;
            G_LDA(At, 0, 1); G_STAGE_A(G_SA(0, 0), a2, 0);
            G_BAR; G_WAIT_L(0); G_MMA(1, 0, At, B0); G_BAR; G_SCHED;
            G_STAGE_B(G_SB(0, 1), b2, 1);
            G_WAIT_V(6); G_BAR; G_MMA(1, 1, At, B1); G_BAR;
            G_LDB(B0, 1, 0); G_SCHED; G_LDA(At, 1, 0); G_STAGE_A(G_SA(0, 1), a2, 1);
            G_WAIT_L(8); G_BAR; G_WAIT_L(0); G_MMA(0, 0, At, B0); G_BAR; G_SCHED;
            G_LDB(B1, 1, 1); G_STAGE_B(G_SB(1, 0), b3, 0);
            G_BAR; G_WAIT_L(0); G_MMA(0, 1, At, B1); G_BAR;
            G_LDA(At, 1, 1); G_STAGE_A(G_SA(1, 0), a3, 0);
            G_BAR; G_WAIT_L(0); G_MMA(1, 0, At, B0); G_BAR; G_SCHED;
            G_STAGE_B(G_SB(1, 1), b3, 1);
            G_WAIT_V(6); G_BAR; G_MMA(1, 1, At, B1); G_BAR;
        }
        E(acc, cur, wr, wc, fr, fq);
        if (!has_next) break;
#pragma unroll
        for (int a = 0; a < 2; ++a)
#pragma unroll
            for (int b = 0; b < 2; ++b)
#pragma unroll
                for (int m = 0; m < 4; ++m)
#pragma unroll
                    for (int n = 0; n < 2; ++n) acc[a][b][m][n] = (f32x4){0.f, 0.f, 0.f, 0.f};
        cur = nxt; cA = nA; cB = nB; ++ui;
    }
    G_WAIT_V(0);
    if (wr == 0) G_BAR;
    G_BAR;
#undef G_SA
#undef G_SB
#undef G_STAGE_A
#undef G_STAGE_B
#undef G_LDA
#undef G_LDB
#undef G_MMA
#undef G_WAIT_V
#undef G_WAIT_L
#undef G_BAR
#undef G_SCHED
#undef G_SET_OFFS
}

__device__ __forceinline__ unsigned cvt_pk_bf16(float lo, float hi) { unsigned r; asm volatile("v_cvt_pk_bf16_f32 %0, %1, %2" : "=v"(r) : "v"(lo), "v"(hi)); return r; }

struct DenseSched {
    const char* A; const char* B; int lda2, ldb2, nt, nM, nN, G, c;
    __device__ __forceinline__ bool next(int i, Unit& u) const {
        const int Lx = i * G + c; if (Lx >= nM * nN) return false;
        const int pm = Lx / nN, pn = Lx % nN;
        u.A = A + (size_t)pm * BM * lda2; u.B = B + (size_t)pn * BM * ldb2; u.rows = nullptr; u.nvalid = 0; u.lda2 = lda2; u.ldb2 = ldb2; u.nt = nt; u.pm = pm; u.pn = pn; u.x0 = 0; u.x1 = 0; return true;
    }
};
}
namespace fk {
constexpr int RING_OFF = 0, RING_BYTES = STAGE_BYTES;
constexpr int MISC_OFF = 144 * 1024 - 1024;
constexpr int LDS_USER_BYTES = 144 * 1024 - 1024;
constexpr int MISC_OFF2 = LDS_USER_BYTES;
constexpr int LDS_BYTES = 144 * 1024;
struct Args { const float* in[54]; float* out; unsigned char* ws; int ph_lo, ph_hi, li, comb, rep_group, rep_n; };

struct Frame {
    LAS unsigned char* lds; volatile LAS unsigned* MISC;
    int tid, lane, wave, G, c, vc;
    unsigned* ctl; unsigned char* ws;
};

__device__ __forceinline__ void transpose_item(const float* W, int ldw, int k0, int n0, bf16* dst, int ldd, LAS float* scr, int lane) {
#pragma unroll
    for (int i = 0; i < 32; ++i) { const int kk = 2 * i + (lane >> 5); scr[kk * 33 + (lane & 31)] = W[(size_t)(k0 + kk) * ldw + n0 + (lane & 31)]; }
    LDS_WAIT(); asm volatile("" ::: "memory");
    const int c = lane & 7;
#pragma unroll
    for (int j = 0; j < 4; ++j) { const int n = (lane >> 3) + 8 * j; const LAS float* s = scr + (8 * c) * 33 + n;
        v4u o; o.x = pk2(s[0 * 33], s[1 * 33]); o.y = pk2(s[2 * 33], s[3 * 33]); o.z = pk2(s[4 * 33], s[5 * 33]); o.w = pk2(s[6 * 33], s[7 * 33]);
        *(GAS v4u*)(dst + (size_t)n * ldd + 8 * c) = o; }
    LDS_WAIT(); asm volatile("" ::: "memory");
}

constexpr int MOE_CONV_ITEMS = 3 * 4096;
__device__ __forceinline__ void moe_conv_item(const Args& a, unsigned char* wsl, int l, int it, LAS float* scr, int lane) {
    bf16* Wgu = (bf16*)(wsl + WS_WMOE); bf16* Wd = Wgu + (size_t)16 * 1024 * 1024;
    const int which = it >> 12, r = it & 4095, e = r >> 8, q = r & 255;
    if (which < 2) { const int kb = q >> 4, nb = q & 15, k0 = kb * 64, n0 = nb * 32;
        const float* W = a.in[which == 0 ? 51 : 52] + ((size_t)l * 16 + e) * D * 512;
        bf16* dst = Wgu + ((size_t)e * 1024 + (n0 >> 7) * 256 + which * 128 + (n0 & 127)) * 1024 + k0;
        transpose_item(W, 512, k0, n0, dst, 1024, scr, lane);
    } else { const int kb = q >> 5, nb = q & 31, k0 = kb * 64, n0 = nb * 32;
        const float* W = a.in[53] + ((size_t)l * 16 + e) * 512 * D;
        bf16* dst = Wd + ((size_t)e * 1024 + n0) * 512 + k0;
        transpose_item(W, 1024, k0, n0, dst, 512, scr, lane);
    }
}
__device__ __forceinline__ void moe_conv_drain(Frame& F, const Args& a, int l, unsigned* done) {
    PHASE_IDS();
    LAS float* scr = (LAS float*)(F.lds + RING_OFF + wave * 16384);
    unsigned* q = F.ctl + CW_Q + 512 * l + 64 * wave;
    for (;;) {
        unsigned it = 0u, fin = 0u;
        if (lane == 0) { if (done) fin = (__hip_atomic_load(done, __ATOMIC_RELAXED, __HIP_MEMORY_SCOPE_AGENT) >= (unsigned)F.G) ? 1u : 0u; if (!fin) it = __hip_atomic_fetch_add(q, 1u, __ATOMIC_RELAXED, __HIP_MEMORY_SCOPE_AGENT); }
        fin = (unsigned)__builtin_amdgcn_readfirstlane((int)fin); it = (unsigned)__builtin_amdgcn_readfirstlane((int)it);
        if (fin || it >= (unsigned)(MOE_CONV_ITEMS / 8)) break;
        moe_conv_item(a, wsl, l, (int)it * 8 + wave, scr, lane);
    }
}
__device__ __forceinline__ void phase_done(Frame& F, unsigned* done) {
    __syncthreads();
    if (threadIdx.x == 0) __hip_atomic_fetch_add(done, 1u, __ATOMIC_RELAXED, __HIP_MEMORY_SCOPE_AGENT);
}

__device__ __forceinline__ void moe_route(Frame& F, const Args& a, int l, int dry) {
    PHASE_IDS();
    LAS float* wt = (LAS float*)(F.lds + RING_OFF);
    const float* wg = a.in[47] + (size_t)l * D * 4; const float* we = a.in[49] + (size_t)l * D * 16;
    for (int i = tid; i < D * 4; i += NT) { const int d = i >> 2, q = i & 3; wt[q * 1024 + d] = wg[i]; }
    for (int i = tid; i < D * 16; i += NT) { const int d = i >> 4, q = i & 15; wt[(4 + q) * 1024 + d] = we[i]; }
    if (tid < 16) ((LAS unsigned*)(wt + 20 * 1024))[tid] = 0u;
    __syncthreads();
    const float* gain = a.in[3] + l * D; const float* bg = a.in[48] + l * 4; const float* be = a.in[50] + l * 16;
    f32x4 g[4];
#pragma unroll
    for (int j = 0; j < 4; ++j) g[j] = *(const f32x4*)(gain + 256 * j + 4 * lane);
    const float* H = (const float*)(wsl + WS_H); bf16* XN = (bf16*)(wsl + WS_ACT + A_XN);
    int* list = (int*)(wsl + WS_ACT + A_LIST); float* listw = (float*)(wsl + WS_ACT + A_LISTW); int* listd = (int*)(wsl + WS_ACT + A_LISTD);
    unsigned* cnt = F.ctl + CW_CNT + 1024 * l;
    LAS unsigned* lcnt = (LAS unsigned*)(wt + 20 * 1024); LAS unsigned* lbase = lcnt + 16; LAS unsigned* ent = lbase + 16;
    const int gw = F.c * NWAVES + wave, NGW = F.G * NWAVES;
    f32x4 v[4], vn[4];
    const int rchunk = (TP + F.G - 1) / F.G, rlim = (F.c + 1) * rchunk < TP ? (F.c + 1) * rchunk : TP, rfirst = F.c * rchunk + wave;
    { const int r0_ = rfirst; if (r0_ < rlim && (r0_ % LP) >= PRE) { const GAS f32x4* hr = (const GAS f32x4*)(H + (size_t)r0_ * D) + lane;
#pragma unroll
        for (int j = 0; j < 4; ++j) v[j] = hr[64 * j]; } }
    for (int row = rfirst; row < rlim; row += NWAVES) {
        { const int nrow = row + NWAVES; if (nrow < rlim && (nrow % LP) >= PRE) { const GAS f32x4* hr = (const GAS f32x4*)(H + (size_t)nrow * D) + lane;
#pragma unroll
            for (int j = 0; j < 4; ++j) vn[j] = hr[64 * j]; } }
        if ((row % LP) < PRE) {
#pragma unroll
            for (int j = 0; j < 4; ++j) v[j] = vn[j];
            continue; }
        float ss = 0.f;
#pragma unroll
        for (int j = 0; j < 4; ++j) ss += (v[j].x * v[j].x + v[j].y * v[j].y) + (v[j].z * v[j].z + v[j].w * v[j].w);
        const float rs = rsqrtf(wave_sum(ss) * (1.f / D) + RMS_EPS);
#pragma unroll
        for (int j = 0; j < 4; ++j) v[j] = v[j] * rs * g[j];
        GAS v2u* o8 = (GAS v2u*)(XN + (size_t)row * D) + lane;
#pragma unroll
        for (int j = 0; j < 4; ++j) { v2u w; w.x = pk2(v[j].x, v[j].y); w.y = pk2(v[j].z, v[j].w); o8[64 * j] = w; }
        float acc[20];
#pragma unroll
        for (int q = 0; q < 20; ++q) { float s = 0.f;
#pragma unroll
            for (int j = 0; j < 4; ++j) { const f32x4 w = *(const LAS f32x4*)(wt + q * 1024 + 256 * j + 4 * lane); s += (v[j].x * w.x + v[j].y * w.y) + (v[j].z * w.z + v[j].w * w.w); }
            acc[q] = wave_sum(s); }
        if (lane < 2 && !dry) {
            float lg[4]; int gi = 0; float mx = -3.0e38f;
#pragma unroll
            for (int q = 0; q < 4; ++q) { lg[q] = acc[q] + bg[q]; if (lg[q] > mx) { mx = lg[q]; gi = q; } }
            float den = 0.f;
#pragma unroll
            for (int q = 0; q < 4; ++q) den += __expf(lg[q] - mx);
            const float pg = 1.f / den;
            float le[4];
#pragma unroll
            for (int q = 0; q < 4; ++q) { float s = 0.f;
#pragma unroll
                for (int gq = 0; gq < 4; ++gq) s = (gq == gi) ? (acc[4 + gq * 4 + q] + be[gq * 4 + q]) : s;
                le[q] = s; }
            int i1 = 0; float v1 = le[0];
#pragma unroll
            for (int q = 1; q < 4; ++q) if (le[q] > v1) { v1 = le[q]; i1 = q; }
            int i2 = 0; float v2 = -3.0e38f;
#pragma unroll
            for (int q = 0; q < 4; ++q) if (q != i1 && le[q] > v2) { v2 = le[q]; i2 = q; }
            const float e2 = __expf(v2 - v1), s1 = 1.f / (1.f + e2), s2 = e2 / (1.f + e2);
            const int k = lane; const int e = gi * 4 + (k == 0 ? i1 : i2); const float gt = (k == 0 ? s1 : s2) * pg;
            const unsigned lp = __hip_atomic_fetch_add(lcnt + e, 1u, __ATOMIC_RELAXED, __HIP_MEMORY_SCOPE_WORKGROUP);
            const int ei = ((row - F.c * rchunk) * 2 + k) * 4; ent[ei] = (unsigned)row; ent[ei + 1] = (unsigned)e; ent[ei + 2] = __builtin_bit_cast(unsigned, gt); ent[ei + 3] = lp;
        }
#pragma unroll
        for (int j = 0; j < 4; ++j) v[j] = vn[j];
    }
    __syncthreads();
    if (tid < 16 && !dry) { const unsigned n = lcnt[tid]; lbase[tid] = n ? __hip_atomic_fetch_add(cnt + 64 * tid, n, __ATOMIC_RELAXED, __HIP_MEMORY_SCOPE_AGENT) : 0u; }
    __syncthreads();
    if (!dry) for (int i = tid; i < 2 * rchunk; i += NT) { const int row = F.c * rchunk + (i >> 1);
        if (row < rlim && (row % LP) >= PRE) { const unsigned e = ent[4 * i + 1]; const unsigned pos = lbase[e] + ent[4 * i + 3];
            list[(size_t)e * LISTCAP + pos] = (int)ent[4 * i]; listw[(size_t)e * LISTCAP + pos] = __builtin_bit_cast(float, ent[4 * i + 2]); listd[(size_t)e * LISTCAP + pos] = (int)ent[4 * i] * 2 + (i & 1); } }
    __syncthreads();
}

struct MoeSched {
    volatile LAS unsigned* tb;
    const char* A; const char* B; const int* list; int lda2, ldb2, nt, G, c, gather;
    __device__ __forceinline__ bool next(int i, Unit& u) const {
        const int Lx = i * G + c; const int ntot = __builtin_amdgcn_readfirstlane((int)tb[16]);
        if (Lx >= ntot * 4) return false;
        const int mt = Lx >> 2, pn = Lx & 3; int e = 0;
#pragma unroll
        for (int q = 1; q < 16; ++q) e = (__builtin_amdgcn_readfirstlane((int)tb[q]) <= mt) ? q : e;
        const int ti = mt - __builtin_amdgcn_readfirstlane((int)tb[e]); const int cn = __builtin_amdgcn_readfirstlane((int)tb[17 + e]) - ti * 256;
        u.nvalid = cn < 256 ? cn : 256; u.x0 = e; u.x1 = ti; u.pm = mt; u.pn = pn; u.lda2 = lda2; u.ldb2 = ldb2; u.nt = nt;
        u.B = B + ((size_t)e * 1024 + (size_t)pn * 256) * ldb2;
        if (gather) { u.A = A; u.rows = list + (size_t)e * LISTCAP + ti * 256; }
        else { u.A = A + (size_t)mt * 256 * lda2; u.rows = nullptr; }
        return true;
    }
};
__device__ __forceinline__ void moe_tables(Frame& F, int l) {
    PHASE_IDS();
    volatile LAS unsigned* tb = F.MISC + 64;
    __syncthreads();
    if (tid < 64) {
        const unsigned cn = lane < 16 ? __hip_atomic_load(F.ctl + CW_CNT + 1024 * l + 64 * lane, __ATOMIC_RELAXED, __HIP_MEMORY_SCOPE_AGENT) : 0u;
        unsigned s = 0;
#pragma unroll
        for (int e = 0; e < 16; ++e) { const unsigned ce = (unsigned)__builtin_amdgcn_readlane((int)cn, e); if (lane == 0) { tb[e] = s; tb[17 + e] = ce; } s += (ce + 255u) >> 8; }
        if (lane == 0) tb[16] = s;
    }
    __syncthreads();
}
struct EpiSwiglu {
    static constexpr bool PERM = true;
    bf16* hid; const float* listw;
    __device__ __forceinline__ void operator()(const f32x4 (&acc)[2][2][4][2], const Unit& u, int wr, int wc, int fr, int fq) const {
        const GAS float* lw = (const GAS float*)listw + (size_t)u.x0 * LISTCAP + u.x1 * 256;
        asm volatile("" : "+v"(fr));
        GAS unsigned char* hb = (GAS unsigned char*)hid + ((size_t)u.pm * 256 * 512 + u.pn * 128 + wc * 32) * 2;
#pragma unroll
        for (int ai = 0; ai < 2; ++ai)
#pragma unroll
            for (int m = 0; m < 4; ++m) {
                const int r = ai * HALF + wr * 64 + m * 16 + fr;
                const float cw = (r < u.nvalid) ? lw[r] : 0.f;
                float o[8];
#pragma unroll
                for (int n = 0; n < 2; ++n)
#pragma unroll
                    for (int q = 0; q < 4; ++q) { const float gv = acc[ai][0][m][n][q], uv = acc[ai][1][m][n][q]; o[n * 4 + q] = gv * sigmoid_f(gv) * uv * cw; }
                v4u w; w.x = cvt_pk_bf16(o[0], o[1]); w.y = cvt_pk_bf16(o[2], o[3]); w.z = cvt_pk_bf16(o[4], o[5]); w.w = cvt_pk_bf16(o[6], o[7]);
                *(GAS v4u*)(hb + (unsigned)(r * 1024 + fq * 16)) = w;
            }
    }
};
struct EpiScatter {
    static constexpr bool PERM = true;
    bf16* O; const int* listd;
    __device__ __forceinline__ void operator()(const f32x4 (&acc)[2][2][4][2], const Unit& u, int wr, int wc, int fr, int fq) const {
        const GAS int* ld = (const GAS int*)listd + (size_t)u.x0 * LISTCAP + u.x1 * 256;
        asm volatile("" : "+v"(fr));
        GAS unsigned char* ob = (GAS unsigned char*)O + (size_t)(u.pn * 256 + wc * 32) * 2;
#pragma unroll
        for (int ai = 0; ai < 2; ++ai)
#pragma unroll
            for (int m = 0; m < 4; ++m) {
                const int r = ai * HALF + wr * 64 + m * 16 + fr;
                if (r < u.nvalid) { const int dst = ld[r];
#pragma unroll
                    for (int bj = 0; bj < 2; ++bj) { const f32x4 v0 = acc[ai][bj][m][0], v1 = acc[ai][bj][m][1];
                        v4u w; w.x = cvt_pk_bf16(v0[0], v0[1]); w.y = cvt_pk_bf16(v0[2], v0[3]); w.z = cvt_pk_bf16(v1[0], v1[1]); w.w = cvt_pk_bf16(v1[2], v1[3]);
                        *(GAS v4u*)(ob + ((unsigned)dst * 2048u + (unsigned)(bj * 256 + fq * 16))) = w; } }
            }
    }
};

}
namespace fk {
constexpr size_t KiB = 1024;
constexpr size_t WM_AB_STRIDE = 14 * MiB;
constexpr size_t WM_WIN = 0;
constexpr size_t WM_WGLU = 3 * MiB;
constexpr size_t WM_WOUT = 3 * MiB + 512 * KiB;
constexpr size_t WM_LRUW = 5 * MiB + 512 * KiB;
constexpr size_t WM_APW = 5 * MiB + 768 * KiB;
constexpr size_t WM_BX = 6 * MiB;
constexpr size_t WM_TC = 8 * MiB;
constexpr size_t WM_RW = 28 * MiB;
constexpr size_t B_HN = 0;
constexpr size_t B_Z = B_HN + (size_t)TP * D * 2;
constexpr size_t B_YS = B_Z + (size_t)TP * 1536 * 2;
constexpr size_t B_CAT = B_YS + (size_t)TP * 512 * 2;
constexpr size_t B_SSA = B_CAT + (size_t)TP * D * 2;
constexpr size_t B_SSB = B_SSA + (size_t)TP * 8 * 4;
constexpr size_t B_END = B_SSB + (size_t)TP * 32 * 4;
static_assert(B_END <= ACT_BYTES, "AB activations fit");

__device__ __forceinline__ void s5_precompute(Frame& F, const Args& a, int j, int g) {
    PHASE_IDS();
    LAS f32x2* pw = (LAS f32x2*)(F.lds + RING_OFF);
    LAS f32x2* bbar = pw + 17 * 64;
    LAS f32x2* cc = bbar + 64 * 16;
    LAS float* Kl = (LAS float*)(cc + 16 * 64);
    unsigned char* wm = wsl + WS_WMIX + (size_t)j * WM_AB_STRIDE;
    __syncthreads();
    if (tid < 64) { const int p = tid;
        const float lr = a.in[9][(j * 32 + g) * 64 + p], li = a.in[10][(j * 32 + g) * 64 + p], dt = expf(a.in[11][j * 32 + g]);
#pragma unroll 1
        for (int lag = 0; lag <= 16; ++lag) { const float m = expf((float)lag * lr * dt); pw[lag * 64 + p] = (f32x2){m * cosf((float)lag * li * dt), m * sinf((float)lag * li * dt)}; }
        const float mag = expf(lr * dt), ar = mag * cosf(li * dt), ai = mag * sinf(li * dt), den = lr * lr + li * li;
        const float zr = ((ar - 1.f) * lr + ai * li) / den, zi = (ai * lr - (ar - 1.f) * li) / den;
        const float* bre = a.in[12] + ((size_t)(j * 32 + g) * 64 + p) * 16; const float* bim = a.in[13] + ((size_t)(j * 32 + g) * 64 + p) * 16;
#pragma unroll 1
        for (int h = 0; h < 16; ++h) { const float br = bre[h], bi = bim[h]; bbar[p * 16 + h] = (f32x2){zr * br - zi * bi, zr * bi + zi * br}; }
    }
    for (int i = tid; i < 1024; i += NT) cc[i] = (f32x2){a.in[14][(size_t)(j * 32 + g) * 1024 + i], a.in[15][(size_t)(j * 32 + g) * 1024 + i]};
    __syncthreads();
    if (tid < 64) ((f32x2*)(wm + WM_APW))[g * 64 + tid] = pw[16 * 64 + tid];
    for (int i = tid; i < 4096; i += NT) { const int lag = i >> 8, h = (i >> 4) & 15, hp = i & 15; float s = 0.f;
        for (int p = 0; p < 64; ++p) { const f32x2 w = pw[lag * 64 + p], bb = bbar[p * 16 + hp], c = cc[h * 64 + p];
            const float wr_ = w.x * bb.x - w.y * bb.y, wi_ = w.x * bb.y + w.y * bb.x; s += c.x * wr_ - c.y * wi_; }
        if (lag == 0 && h == hp) s += a.in[16][(j * 32 + g) * 16 + h];
        Kl[i] = s; }
    __syncthreads();
    bf16* TC = (bf16*)(wm + WM_TC) + (size_t)g * 256 * 384; bf16* BX = (bf16*)(wm + WM_BX) + (size_t)g * 128 * 256;
    for (int i = tid; i < 256 * 48; i += NT) { const int n = i / 48, ko = i % 48, t = n >> 4, h = n & 15; float v[8];
        if (ko < 32) { const int s = ko >> 1, hp0 = (ko & 1) * 8;
#pragma unroll
            for (int q = 0; q < 8; ++q) v[q] = (s <= t) ? Kl[((t - s) * 16 + h) * 16 + hp0 + q] : 0.f;
        } else { const int p0 = (ko - 32) * 4;
#pragma unroll
            for (int q = 0; q < 4; ++q) { const f32x2 c = cc[h * 64 + p0 + q], w = pw[(t + 1) * 64 + p0 + q]; v[2 * q] = c.x * w.x - c.y * w.y; v[2 * q + 1] = -(c.x * w.y + c.y * w.x); } }
        v4u o; o.x = pk2(v[0], v[1]); o.y = pk2(v[2], v[3]); o.z = pk2(v[4], v[5]); o.w = pk2(v[6], v[7]);
        *(GAS v4u*)(TC + (size_t)n * 384 + ko * 8) = o; }
    for (int i = tid; i < 128 * 32; i += NT) { const int n = i >> 5, ko = i & 31, p = n >> 1, im = n & 1, s = ko >> 1, hp0 = (ko & 1) * 8; float v[8];
        const f32x2 w = pw[(15 - s) * 64 + p];
#pragma unroll
        for (int q = 0; q < 8; ++q) { const f32x2 bb = bbar[p * 16 + hp0 + q]; v[q] = im ? (w.x * bb.y + w.y * bb.x) : (w.x * bb.x - w.y * bb.y); }
        v4u o; o.x = pk2(v[0], v[1]); o.y = pk2(v[2], v[3]); o.z = pk2(v[4], v[5]); o.w = pk2(v[6], v[7]);
        *(GAS v4u*)(BX + (size_t)n * 256 + ko * 8) = o; }
    __syncthreads();
}

__device__ __forceinline__ void prologue_ab(Frame& F, const Args& a) {
    PHASE_IDS();
    const int gw = F.c * NWAVES + wave, NGW = F.G * NWAVES;
    float* H = (float*)(wsl + WS_H);
    for (int row = gw; row < TP; row += NGW) { const int b = row / LP, t = row % LP - PRE;
        GAS f32x4* o = (GAS f32x4*)(H + (size_t)row * D) + lane;
        if (t < 0) {
#pragma unroll
            for (int q = 0; q < 4; ++q) o[64 * q] = (f32x4){0.f, 0.f, 0.f, 0.f};
        } else { const float* src = t < NMETA ? a.in[1] + (size_t)t * D : a.in[0] + ((size_t)b * SEQ + (t - NMETA)) * D;
#pragma unroll
            for (int q = 0; q < 4; ++q) o[64 * q] = ((const GAS f32x4*)src)[64 * q + lane]; } }
    LAS float* scr = (LAS float*)(F.lds + RING_OFF + wave * 16384);
    constexpr int I_IN = 16 * 48, I_GLU = 8 * 16, I_OUT = 16 * 32, I_LRU = 32, I_AB = I_IN + I_GLU + I_OUT + I_LRU;
    for (int it = gw; it < 2 * I_AB; it += NGW) { const int j = it / I_AB; int r = it % I_AB; unsigned char* wm = wsl + WS_WMIX + (size_t)j * WM_AB_STRIDE;
        if (r < I_IN) { const int kb = r / 48, nb = r % 48; transpose_item(a.in[5] + (size_t)j * D * 1536, 1536, kb * 64, nb * 32, (bf16*)(wm + WM_WIN) + (size_t)nb * 32 * 1024 + kb * 64, 1024, scr, lane); continue; } r -= I_IN;
        if (r < I_GLU) { const int kb = r / 16, nb = r % 16; transpose_item(a.in[17] + (size_t)j * 512 * 512, 512, kb * 64, nb * 32, (bf16*)(wm + WM_WGLU) + (size_t)nb * 32 * 512 + kb * 64, 512, scr, lane); continue; } r -= I_GLU;
        if (r < I_OUT) { const int kb = r / 32, nb = r % 32; transpose_item(a.in[6] + (size_t)j * D * D, 1024, kb * 64, nb * 32, (bf16*)(wm + WM_WOUT) + (size_t)nb * 32 * 1024 + kb * 64, 1024, scr, lane); continue; } r -= I_OUT;
        { const int hd = r >> 2, which = (r >> 1) & 1, nb = r & 1;
          transpose_item(a.in[which ? 23 : 21] + (size_t)(j * 8 + hd) * 4096, 64, 0, nb * 32, (bf16*)(wm + WM_LRUW) + ((size_t)hd * 128 + which * 64 + nb * 32) * 64, 64, scr, lane); }
    }
    __syncthreads();
    for (int u = F.c; u < 64; u += F.G) s5_precompute(F, a, u >> 5, u & 31);
}

struct RowBuf { f32x4 v[4]; v2u a[4], b[4]; };
__device__ __forceinline__ void row_issue(RowBuf& R, const float* H, const bf16* O, int row, int has_o, int lane) {
    const GAS f32x4* hr = (const GAS f32x4*)(H + (size_t)row * D) + lane;
#pragma unroll
    for (int q = 0; q < 4; ++q) R.v[q] = hr[64 * q];
    if (has_o) { const GAS v2u* o0 = (const GAS v2u*)(O + (size_t)row * 2 * D) + lane; const GAS v2u* o1 = o0 + 256;
#pragma unroll
        for (int q = 0; q < 4; ++q) { R.a[q] = o0[64 * q]; R.b[q] = o1[64 * q]; } }
}
__device__ __forceinline__ float row_finish(RowBuf& R, int has_o) {
    float ss = 0.f;
    if (has_o) {
#pragma unroll
        for (int q = 0; q < 4; ++q) { const v2u x = R.a[q], y = R.b[q];
            R.v[q].x += bflo(x.x) + bflo(y.x); R.v[q].y += bfhi(x.x) + bfhi(y.x); R.v[q].z += bflo(x.y) + bflo(y.y); R.v[q].w += bfhi(x.y) + bfhi(y.y); } }
#pragma unroll
    for (int q = 0; q < 4; ++q) ss += (R.v[q].x * R.v[q].x + R.v[q].y * R.v[q].y) + (R.v[q].z * R.v[q].z + R.v[q].w * R.v[q].w);
    return rsqrtf(wave_sum(ss) * (1.f / D) + RMS_EPS);
}
__device__ __forceinline__ void pass_norm(Frame& F, const float* gain, int has_o, bf16* out) {
    PHASE_IDS();
    const int gw = F.c * NWAVES + wave, NGW = F.G * NWAVES;
    f32x4 g[4];
#pragma unroll
    for (int q = 0; q < 4; ++q) g[q] = *(const GAS f32x4*)(gain + 256 * q + 4 * lane);
    const float* H = (const float*)(wsl + WS_H); const bf16* O = (const bf16*)(wsl + WS_O);
    RowBuf cur, nxt;
    const int rchunk = (TP + F.G - 1) / F.G, rlim = (F.c + 1) * rchunk < TP ? (F.c + 1) * rchunk : TP, rfirst = F.c * rchunk + wave;
    if (rfirst < rlim && (rfirst % LP) >= PRE) row_issue(cur, H, O, rfirst, has_o, lane);
    for (int row = rfirst; row < rlim; row += NWAVES) {
        const int nrow = row + NWAVES; if (nrow < rlim && (nrow % LP) >= PRE) row_issue(nxt, H, O, nrow, has_o, lane);
        GAS v2u* o8 = (GAS v2u*)(out + (size_t)row * D) + lane;
        if ((row % LP) < PRE) {
#pragma unroll
            for (int q = 0; q < 4; ++q) o8[64 * q] = (v2u){0u, 0u};
        } else { const float rs = row_finish(cur, has_o);
#pragma unroll
            for (int q = 0; q < 4; ++q) { const f32x4 x = cur.v[q] * rs * g[q]; v2u w; w.x = pk2(x.x, x.y); w.y = pk2(x.z, x.w); o8[64 * q] = w; } }
        cur = nxt;
    }
}
__device__ __forceinline__ void pass_final(Frame& F, const float* gain, float* out) {
    PHASE_IDS();
    const int gw = F.c * NWAVES + wave, NGW = F.G * NWAVES;
    f32x4 g[4];
#pragma unroll
    for (int q = 0; q < 4; ++q) g[q] = *(const GAS f32x4*)(gain + 256 * q + 4 * lane);
    const float* H = (const float*)(wsl + WS_H); const bf16* O = (const bf16*)(wsl + WS_O);
    RowBuf cur, nxt;
    const int rchunk = (NB * SEQ + F.G - 1) / F.G, rlim = (F.c + 1) * rchunk < NB * SEQ ? (F.c + 1) * rchunk : NB * SEQ, rfirst = F.c * rchunk + wave;
    if (rfirst < rlim) row_issue(cur, H, O, (rfirst / SEQ) * LP + PRE + NMETA + rfirst % SEQ, 1, lane);
    for (int r = rfirst; r < rlim; r += NWAVES) {
        const int nr = r + NWAVES; if (nr < rlim) row_issue(nxt, H, O, (nr / SEQ) * LP + PRE + NMETA + nr % SEQ, 1, lane);
        const float rs = row_finish(cur, 1);
        GAS f32x4* o = (GAS f32x4*)(out + (size_t)r * D) + lane;
#pragma unroll
        for (int q = 0; q < 4; ++q) o[64 * q] = cur.v[q] * rs * g[q];
        cur = nxt;
    }
}

struct EpiBf16 {
    static constexpr bool PERM = true;
    bf16* O; int ldo;
    __device__ __forceinline__ void operator()(const f32x4 (&acc)[2][2][4][2], const Unit& u, int wr, int wc, int fr, int fq) const {
        asm volatile("" : "+v"(fr));
        GAS unsigned char* ob = (GAS unsigned char*)O + ((size_t)u.pm * 256 * ldo + u.pn * 256 + wc * 32) * 2;
#pragma unroll
        for (int ai = 0; ai < 2; ++ai)
#pragma unroll
            for (int m = 0; m < 4; ++m) { const int r = ai * HALF + wr * 64 + m * 16 + fr;
#pragma unroll
                for (int bj = 0; bj < 2; ++bj) { const f32x4 v0 = acc[ai][bj][m][0], v1 = acc[ai][bj][m][1];
                    v4u w; w.x = cvt_pk_bf16(v0[0], v0[1]); w.y = cvt_pk_bf16(v0[2], v0[3]); w.z = cvt_pk_bf16(v1[0], v1[1]); w.w = cvt_pk_bf16(v1[2], v1[3]);
                    *(GAS v4u*)(ob + ((unsigned)r * (unsigned)ldo * 2u + (unsigned)(bj * 256 + fq * 16))) = w; } }
    }
};
struct EpiGlu {
    static constexpr bool PERM = true;
    const bf16* YS; bf16* CAT; const float* bglu; float* SSA;
    __device__ __forceinline__ void operator()(const f32x4 (&acc)[2][2][4][2], const Unit& u, int wr, int wc, int fr, int fq) const {
        asm volatile("" : "+v"(fr));
        f32x4 bv[2][2];
#pragma unroll
        for (int bj = 0; bj < 2; ++bj)
#pragma unroll
            for (int n = 0; n < 2; ++n) bv[bj][n] = *(const GAS f32x4*)(bglu + u.pn * 256 + bj * HALF + wc * 32 + fq * 8 + 4 * n);
#pragma unroll
        for (int ai = 0; ai < 2; ++ai)
#pragma unroll
            for (int m = 0; m < 4; ++m) { const int r = ai * HALF + wr * 64 + m * 16 + fr; const size_t row = (size_t)u.pm * 256 + r; float ss = 0.f;
#pragma unroll
                for (int bj = 0; bj < 2; ++bj) { const int col = u.pn * 256 + bj * HALF + wc * 32 + fq * 8;
                    const v4u y = *(const GAS v4u*)(YS + row * 512 + col); const f32x4 v0 = acc[ai][bj][m][0] + bv[bj][0], v1 = acc[ai][bj][m][1] + bv[bj][1];
                    float o[8]; o[0] = bflo(y.x) * sigmoid_f(v0[0]); o[1] = bfhi(y.x) * sigmoid_f(v0[1]); o[2] = bflo(y.y) * sigmoid_f(v0[2]); o[3] = bfhi(y.y) * sigmoid_f(v0[3]);
                    o[4] = bflo(y.z) * sigmoid_f(v1[0]); o[5] = bfhi(y.z) * sigmoid_f(v1[1]); o[6] = bflo(y.w) * sigmoid_f(v1[2]); o[7] = bfhi(y.w) * sigmoid_f(v1[3]);
#pragma unroll
                    for (int q = 0; q < 8; ++q) ss += o[q] * o[q];
                    v4u w; w.x = cvt_pk_bf16(o[0], o[1]); w.y = cvt_pk_bf16(o[2], o[3]); w.z = cvt_pk_bf16(o[4], o[5]); w.w = cvt_pk_bf16(o[6], o[7]);
                    *(GAS v4u*)(CAT + row * 1024 + col) = w; }
                ss += __shfl_xor(ss, 16); ss += __shfl_xor(ss, 32);
                if (fq == 0) ((GAS float*)SSA)[row * 8 + u.pn * 4 + wc] = ss; }
    }
};
struct EpiResid {
    static constexpr bool PERM = false;
    float* H; const bf16* O; int has_o; int dry;
    __device__ __forceinline__ void operator()(const f32x4 (&acc)[2][2][4][2], const Unit& u, int wr, int wc, int fr, int fq) const {
        asm volatile("" : "+v"(fr));
#pragma unroll
        for (int ai = 0; ai < 2; ++ai)
#pragma unroll
            for (int m = 0; m < 4; ++m) { const size_t row = (size_t)u.pm * 256 + ai * HALF + wr * 64 + m * 16 + fr;
#pragma unroll
                for (int bj = 0; bj < 2; ++bj)
#pragma unroll
                    for (int n = 0; n < 2; ++n) { const int col = u.pn * 256 + bj * HALF + wc * 32 + n * 16 + fq * 4;
                        GAS f32x4* hp = (GAS f32x4*)(H + row * D + col); f32x4 v = *hp + acc[ai][bj][m][n];
                        if (has_o) { const v2u x = *(const GAS v2u*)(O + row * 2 * D + col), y = *(const GAS v2u*)(O + row * 2 * D + D + col);
                            v.x += bflo(x.x) + bflo(y.x); v.y += bfhi(x.x) + bfhi(y.x); v.z += bflo(x.y) + bflo(y.y); v.w += bfhi(x.y) + bfhi(y.y); }
                        if (!dry) *hp = v; } }
    }
};

__device__ __forceinline__ void resid_tail(Frame& F, const bf16* A, const bf16* Bt, int has_o, int dry) {
    PHASE_IDS();
    const int fr = lane & 15, fq = lane >> 4;
    LAS f32x4* part = (LAS f32x4*)(F.lds + RING_OFF);
    float* H = (float*)(wsl + WS_H); const bf16* O = (const bf16*)(wsl + WS_O);
    for (int mu = F.c; mu < 256; mu += F.G) { const int r0 = (TP / 256 - 1) * 256 + 16 * (mu >> 4), c0 = 64 * (mu & 15);
        const bf16* ap = A + (size_t)(r0 + fr) * 1024 + 128 * wave + 8 * fq;
        bf16x8 af[4];
#pragma unroll
        for (int ks = 0; ks < 4; ++ks) af[ks] = *(const GAS bf16x8*)(ap + 32 * ks);
        f32x4 acc[4];
#pragma unroll
        for (int nt = 0; nt < 4; ++nt) { acc[nt] = (f32x4){0.f, 0.f, 0.f, 0.f}; const bf16* bp = Bt + (size_t)(c0 + 16 * nt + fr) * 1024 + 128 * wave + 8 * fq;
            bf16x8 bfv[4];
#pragma unroll
            for (int ks = 0; ks < 4; ++ks) bfv[ks] = *(const GAS bf16x8*)(bp + 32 * ks);
#pragma unroll
            for (int ks = 0; ks < 4; ++ks) acc[nt] = __builtin_amdgcn_mfma_f32_16x16x32_bf16(bfv[ks], af[ks], acc[nt], 0, 0, 0); }
        __syncthreads();
#pragma unroll
        for (int nt = 0; nt < 4; ++nt) part[(wave * 4 + nt) * 64 + lane] = acc[nt];
        __syncthreads();
        if (wave < 4) { const int nt = wave; f32x4 s = part[(0 * 4 + nt) * 64 + lane];
#pragma unroll
            for (int w = 1; w < 8; ++w) s += part[(w * 4 + nt) * 64 + lane];
            const size_t row = (size_t)r0 + fr; const int col = c0 + 16 * nt + 4 * fq;
            GAS f32x4* hp = (GAS f32x4*)(H + row * D + col); f32x4 v = *hp + s;
            if (has_o) { const v2u x = *(const GAS v2u*)(O + row * 2 * D + col), y = *(const GAS v2u*)(O + row * 2 * D + D + col);
                v.x += bflo(x.x) + bflo(y.x); v.y += bfhi(x.x) + bfhi(y.x); v.z += bflo(x.y) + bflo(y.y); v.w += bfhi(x.y) + bfhi(y.y); }
            if (!dry) *hp = v; }
    }
    __syncthreads();
}

constexpr int S5_UP = 264, S5_XP = 136;
__device__ __forceinline__ void s5_unit(Frame& F, int j, int b, int g) {
    PHASE_IDS();
    const int fr = lane & 15, fq = lane >> 4;
    LAS bf16* Uc = (LAS bf16*)(F.lds + RING_OFF); LAS bf16* EX = Uc + 144 * S5_UP;
    const unsigned char* wm = wsl + WS_WMIX + (size_t)j * WM_AB_STRIDE;
    const bf16* Z = (const bf16*)(wsl + WS_ACT + B_Z); bf16* YS = (bf16*)(wsl + WS_ACT + B_YS);
    const bf16* BX = (const bf16*)(wm + WM_BX) + (size_t)g * 128 * 256; const bf16* TC = (const bf16*)(wm + WM_TC) + (size_t)g * 256 * 384;
    const size_t row0 = (size_t)b * LP + PRE;
    __syncthreads();
    for (int i = tid; i < L * 2; i += NT) { const int t = i >> 1, hf = i & 1;
        const v4u x = *(const GAS v4u*)(Z + (row0 + t) * 1536 + g * 16 + hf * 8);
        *(LAS v4u*)(Uc + (t >> 4) * S5_UP + (t & 15) * 16 + hf * 8) = x; }
    __syncthreads();
    {
        f32x4 acc[9];
#pragma unroll
        for (int mt = 0; mt < 9; ++mt) acc[mt] = (f32x4){0.f, 0.f, 0.f, 0.f};
#pragma unroll 2
        for (int ks = 0; ks < 8; ++ks) { const bf16x8 bf = *(const GAS bf16x8*)(BX + (size_t)(16 * wave + fr) * 256 + 32 * ks + 8 * fq);
#pragma unroll
            for (int mt = 0; mt < 9; ++mt) { const bf16x8 af = *(const LAS bf16x8*)(Uc + (16 * mt + fr) * S5_UP + 32 * ks + 8 * fq); acc[mt] = __builtin_amdgcn_mfma_f32_16x16x32_bf16(bf, af, acc[mt], 0, 0, 0); } }
#pragma unroll
        for (int mt = 0; mt < 9; ++mt) { v2u w; w.x = pk2(acc[mt][0], acc[mt][1]); w.y = pk2(acc[mt][2], acc[mt][3]); *(LAS v2u*)(EX + (16 * mt + fr) * S5_XP + 16 * wave + 4 * fq) = w; }
    }
    __syncthreads();
    if (tid < 64) {
        const f32x2 A = ((const GAS f32x2*)(wm + WM_APW))[g * 64 + tid]; float xr = 0.f, xi = 0.f;
        LAS unsigned* ex = (LAS unsigned*)EX + tid;
#pragma unroll 4
        for (int c = 0; c < 129; ++c) { const unsigned e = ex[c * (S5_XP / 2)]; ex[c * (S5_XP / 2)] = pk2(xr, xi);
            const float er = bflo(e), ei = bfhi(e); const float nr = A.x * xr - A.y * xi + er, ni = A.x * xi + A.y * xr + ei; xr = nr; xi = ni; }
    }
    __syncthreads();
    {
        f32x4 acc[2][9];
#pragma unroll
        for (int nt = 0; nt < 2; ++nt)
#pragma unroll
            for (int mt = 0; mt < 9; ++mt) acc[nt][mt] = (f32x4){0.f, 0.f, 0.f, 0.f};
#pragma unroll 2
        for (int ks = 0; ks < 12; ++ks) {
            bf16x8 bf[2];
#pragma unroll
            for (int nt = 0; nt < 2; ++nt) bf[nt] = *(const GAS bf16x8*)(TC + (size_t)(16 * (2 * wave + nt) + fr) * 384 + 32 * ks + 8 * fq);
#pragma unroll
            for (int mt = 0; mt < 9; ++mt) { const bf16x8 af = (ks < 8) ? *(const LAS bf16x8*)(Uc + (16 * mt + fr) * S5_UP + 32 * ks + 8 * fq) : *(const LAS bf16x8*)(EX + (16 * mt + fr) * S5_XP + 32 * (ks - 8) + 8 * fq);
#pragma unroll
                for (int nt = 0; nt < 2; ++nt) acc[nt][mt] = __builtin_amdgcn_mfma_f32_16x16x32_bf16(bf[nt], af, acc[nt][mt], 0, 0, 0); } }
#pragma unroll
        for (int nt = 0; nt < 2; ++nt)
#pragma unroll
            for (int mt = 0; mt < 9; ++mt) { const int c = 16 * mt + fr, tt = 16 * c + 2 * wave + nt;
                if (tt < L) { const f32x4 y = acc[nt][mt]; v2u w; w.x = pk2(gelu_tanh_f(y[0]), gelu_tanh_f(y[1])); w.y = pk2(gelu_tanh_f(y[2]), gelu_tanh_f(y[3]));
                    *(GAS v2u*)(YS + (row0 + tt) * 512 + g * 16 + 4 * fq) = w; } }
    }
}

__device__ __forceinline__ void lru_unit(Frame& F, const Args& a, int j, int b, int hd, int q4) {
    PHASE_IDS();
    const int fr = lane & 15, fq = lane >> 4;
    constexpr int XP = 72;
    LAS bf16* XC = (LAS bf16*)(F.lds + RING_OFF);
    LAS f32x2* ABv = (LAS f32x2*)(F.lds + RING_OFF + 128 * XP * 2);
    LAS f32x2* PS = ABv + 128 * 16;
    LAS float* carry = (LAS float*)(PS + 32 * 16);
    const unsigned char* wm = wsl + WS_WMIX + (size_t)j * WM_AB_STRIDE;
    const bf16* Z = (const bf16*)(wsl + WS_ACT + B_Z); bf16* CAT = (bf16*)(wsl + WS_ACT + B_CAT); float* SSB = (float*)(wsl + WS_ACT + B_SSB);
    const size_t row0 = (size_t)b * LP + PRE;
    const int cbase = hd * 64;
    const bf16* LW = (const bf16*)(wm + WM_LRUW) + (size_t)hd * 128 * 64;
    bf16x8 wa[2], wx[2];
#pragma unroll
    for (int ks = 0; ks < 2; ++ks) { wa[ks] = *(const GAS bf16x8*)(LW + (size_t)(16 * q4 + fr) * 64 + 32 * ks + 8 * fq); wx[ks] = *(const GAS bf16x8*)(LW + (size_t)(64 + 16 * q4 + fr) * 64 + 32 * ks + 8 * fq); }
    const int oc = tid & 7; float cw[4][8], cb[8];
#pragma unroll
    for (int e = 0; e < 8; ++e) { cb[e] = a.in[20][j * 512 + cbase + 8 * oc + e];
#pragma unroll
        for (int k = 0; k < 4; ++k) cw[k][e] = a.in[19][(j * 4 + k) * 512 + cbase + 8 * oc + e]; }
    float ba[4], bx[4], sp8[4];
#pragma unroll
    for (int e = 0; e < 4; ++e) { const int c = cbase + 16 * q4 + 4 * fq + e; ba[e] = a.in[22][j * 512 + c]; bx[e] = a.in[24][j * 512 + c]; const float lam = a.in[25][j * 512 + c]; sp8[e] = 8.0f * (lam < -20.f ? -lam : log1pf(__expf(-lam))); }
    const int cc = tid & 15, sub = tid >> 4; const int cs = cbase + 16 * q4 + cc;
    __syncthreads();
    if (tid < 16) carry[tid] = 0.f;
    v4u rec[2][4];
#define LRU_LOAD_REC(t0) do { _Pragma("unroll") for (int i = 0; i < 2; ++i) { const int tl = (tid + 512 * i) >> 3; \
        _Pragma("unroll") for (int k = 0; k < 4; ++k) { const int tt = (t0) + tl - 3 + k; \
            rec[i][k] = (tt >= 0 && tt < L) ? *(const GAS v4u*)(Z + (row0 + tt) * 1536 + 1024 + cbase + 8 * oc) : (v4u){0u, 0u, 0u, 0u}; } } } while (0)
    LRU_LOAD_REC(0);
    for (int tile = 0; tile < 17; ++tile) { const int t0 = tile * 128;
        unsigned short gz[4];
#pragma unroll
        for (int s = 0; s < 4; ++s) { const int tt = t0 + 4 * sub + s; gz[s] = tt < L ? ((const GAS unsigned short*)Z)[(row0 + tt) * 1536 + 512 + cs] : (unsigned short)0; }
#pragma unroll
        for (int i = 0; i < 2; ++i) { const int tl = (tid + 512 * i) >> 3; float x[8];
#pragma unroll
            for (int e = 0; e < 8; ++e) x[e] = cb[e];
#pragma unroll
            for (int k = 0; k < 4; ++k) { const v4u r = rec[i][k];
                x[0] += cw[k][0] * bflo(r.x); x[1] += cw[k][1] * bfhi(r.x); x[2] += cw[k][2] * bflo(r.y); x[3] += cw[k][3] * bfhi(r.y);
                x[4] += cw[k][4] * bflo(r.z); x[5] += cw[k][5] * bfhi(r.z); x[6] += cw[k][6] * bflo(r.w); x[7] += cw[k][7] * bfhi(r.w); }
            v4u w; w.x = pk2(x[0], x[1]); w.y = pk2(x[2], x[3]); w.z = pk2(x[4], x[5]); w.w = pk2(x[6], x[7]);
            *(LAS v4u*)(XC + tl * XP + 8 * oc) = w; }
        if (tile < 16) LRU_LOAD_REC(t0 + 128);
        LDS_BARRIER();
        {
            const int tl = 16 * wave + fr; f32x4 ra = (f32x4){0.f, 0.f, 0.f, 0.f}, rx = ra;
#pragma unroll
            for (int ks = 0; ks < 2; ++ks) { const bf16x8 af = *(const LAS bf16x8*)(XC + tl * XP + 32 * ks + 8 * fq);
                ra = __builtin_amdgcn_mfma_f32_16x16x32_bf16(wa[ks], af, ra, 0, 0, 0); rx = __builtin_amdgcn_mfma_f32_16x16x32_bf16(wx[ks], af, rx, 0, 0, 0); }
            const v2u xq = *(const LAS v2u*)(XC + tl * XP + 16 * q4 + 4 * fq); const float xv[4] = {bflo(xq.x), bfhi(xq.x), bflo(xq.y), bfhi(xq.y)};
            const bool valid = (t0 + tl) < L;
#pragma unroll
            for (int e = 0; e < 4; ++e) { const float r = sigmoid_f(ra[e] + ba[e]), ig = sigmoid_f(rx[e] + bx[e]); const float la = -r * sp8[e];
                const float x2 = 2.f * la;
                const float av = __expf(la), bv = sqrtf(-x2 * (1.f + 0.5f * x2 * (1.f + 0.33333334f * x2 * (1.f + 0.25f * x2 * (1.f + 0.2f * x2))))) * (ig * xv[e]);
                f32x2 abw; abw.x = valid ? av : 1.f; abw.y = valid ? bv : 0.f; ABv[tl * 16 + 4 * fq + e] = abw; }
        }
        LDS_BARRIER();
        {
            float P = 1.f, hl = 0.f;
#pragma unroll
            for (int s = 0; s < 4; ++s) { const f32x2 ab = ABv[(4 * sub + s) * 16 + cc]; hl = ab.x * hl + ab.y; P *= ab.x; }
            PS[sub * 16 + cc] = (f32x2){P, hl};
        }
        LDS_BARRIER();
        {
            float h = carry[cc];
            for (int s2 = 0; s2 < sub; ++s2) { const f32x2 ps = PS[s2 * 16 + cc]; h = ps.x * h + ps.y; }
#pragma unroll
            for (int s = 0; s < 4; ++s) { const int tt = t0 + 4 * sub + s; const f32x2 ab = ABv[(4 * sub + s) * 16 + cc]; h = ab.x * h + ab.y;
                const float o = gelu_tanh_f(bf2f(gz[s])) * h; float ss = o * o;
                ss = sum16(ss);
                if (tt < L) { ((GAS unsigned short*)CAT)[(row0 + tt) * 1024 + 512 + cs] = (unsigned short)f2bf(o); if (cc == 0) ((GAS float*)SSB)[(row0 + tt) * 32 + hd * 4 + q4] = ss; } }
            LDS_BARRIER();
            if (sub == 31) carry[cc] = h;
        }
        LDS_BARRIER();
    }
#undef LRU_LOAD_REC
}

__device__ __forceinline__ void pass_abnorm(Frame& F, const float* na, const float* nb, int dry) {
    PHASE_IDS();
    const int gw = F.c * NWAVES + wave, NGW = F.G * NWAVES;
    bf16* CAT = (bf16*)(wsl + WS_ACT + B_CAT); const float* SSA = (const float*)(wsl + WS_ACT + B_SSA); const float* SSB = (const float*)(wsl + WS_ACT + B_SSB);
    float ga[8], gb[8];
#pragma unroll
    for (int e = 0; e < 8; ++e) { ga[e] = na[8 * lane + e]; gb[e] = nb[8 * lane + e]; }
    const int rchunk = (TP + F.G - 1) / F.G, rlim = (F.c + 1) * rchunk < TP ? (F.c + 1) * rchunk : TP;
    for (int row = F.c * rchunk + wave; row < rlim; row += NWAVES) {
        GAS v4u* p = (GAS v4u*)(CAT + (size_t)row * 1024) + lane;
        if ((row % LP) < PRE) { p[0] = (v4u){0u, 0u, 0u, 0u}; p[64] = (v4u){0u, 0u, 0u, 0u}; continue; }
        float sa = 0.f, sb = 0.f;
#pragma unroll
        for (int e = 0; e < 8; ++e) sa += ((const GAS float*)SSA)[(size_t)row * 8 + e];
#pragma unroll
        for (int e = 0; e < 32; ++e) sb += ((const GAS float*)SSB)[(size_t)row * 32 + e];
        const float ra = rsqrtf(sa * (1.f / 512.f) + RMS_EPS), rb = rsqrtf(sb * (1.f / 512.f) + RMS_EPS);
        v4u x = p[0], y = p[64];
        x.x = pk2(bflo(x.x) * ra * ga[0], bfhi(x.x) * ra * ga[1]); x.y = pk2(bflo(x.y) * ra * ga[2], bfhi(x.y) * ra * ga[3]); x.z = pk2(bflo(x.z) * ra * ga[4], bfhi(x.z) * ra * ga[5]); x.w = pk2(bflo(x.w) * ra * ga[6], bfhi(x.w) * ra * ga[7]);
        y.x = pk2(bflo(y.x) * rb * gb[0], bfhi(y.x) * rb * gb[1]); y.y = pk2(bflo(y.y) * rb * gb[2], bfhi(y.y) * rb * gb[3]); y.z = pk2(bflo(y.z) * rb * gb[4], bfhi(y.z) * rb * gb[5]); y.w = pk2(bflo(y.w) * rb * gb[6], bfhi(y.w) * rb * gb[7]);
        if (!dry) { p[0] = x; p[64] = y; }
    }
}
}
namespace fk {
constexpr size_t WM_RW_STRIDE = 11 * MiB;
constexpr size_t RW_WRKV = 0;
constexpr size_t RW_WO = 6 * MiB;
constexpr size_t RW_L1 = 8 * MiB;
constexpr size_t RW_W2W = 10 * MiB;
constexpr size_t RW_W2A = 10 * MiB + 128 * KiB;
constexpr size_t RW_W2G = 10 * MiB + 256 * KiB;
constexpr size_t RW_W2V = 10 * MiB + 512 * KiB;
static_assert(WM_RW + 2 * WM_RW_STRIDE <= 50 * MiB, "mixer weights fit");
constexpr size_t RB = (size_t)TP * D * 2;
constexpr size_t R_HN = 0;
constexpr size_t R_XR = 1 * RB, R_XK = 2 * RB, R_XV = 3 * RB;
constexpr size_t R_R = 4 * RB, R_K = 5 * RB, R_V = 6 * RB;
constexpr size_t R_L1 = 7 * RB;
constexpr size_t R_END = R_L1 + (size_t)TP * 512 * 2;
static_assert(R_END <= ACT_BYTES, "RWKV activations fit");

__device__ __forceinline__ void transpose_item_s(const float* W, int ldw, int k0, int n0, bf16* dst, int ldd, LAS float* scr, int lane, const float* mu, int mode, int kcount) {
    for (int i = 0; i < kcount / 2; ++i) { const int kk = 2 * i + (lane >> 5); float s = 1.f; if (mode == 1) s = mu[k0 + kk]; else if (mode == 2) s = 1.f - mu[k0 + kk];
        scr[kk * 33 + (lane & 31)] = W[(size_t)(k0 + kk) * ldw + n0 + (lane & 31)] * s; }
    LDS_WAIT(); asm volatile("" ::: "memory");
    const int c = lane & 7;
    if (8 * c < kcount) {
#pragma unroll
        for (int jj = 0; jj < 4; ++jj) { const int n = (lane >> 3) + 8 * jj; const LAS float* s = scr + (8 * c) * 33 + n;
            v4u o; o.x = pk2(s[0 * 33], s[1 * 33]); o.y = pk2(s[2 * 33], s[3 * 33]); o.z = pk2(s[4 * 33], s[5 * 33]); o.w = pk2(s[6 * 33], s[7 * 33]);
            *(GAS v4u*)(dst + (size_t)n * ldd + 8 * c) = o; } }
    LDS_WAIT(); asm volatile("" ::: "memory");
}
__device__ __forceinline__ void prologue_rw(Frame& F, const Args& a) {
    PHASE_IDS();
    const int gw = F.c * NWAVES + wave, NGW = F.G * NWAVES;
    LAS float* scr = (LAS float*)(F.lds + RING_OFF + wave * 16384);
    constexpr int I_SQ = 512, I_L1 = 288, I_W2 = 32 + 32 + 64 + 32, I_RW = 4 * I_SQ + I_L1 + I_W2;
    for (int it = gw; it < 2 * I_RW; it += NGW) { const int j = it / I_RW; int r = it % I_RW; unsigned char* wm = wsl + WS_WMIX + WM_RW + (size_t)j * WM_RW_STRIDE;
        if (r < 4 * I_SQ) { const int m = r / I_SQ, q = r % I_SQ, kb = q >> 5, nb = q & 31;
            const float* W = a.in[m == 0 ? 27 : m == 1 ? 28 : m == 2 ? 29 : 30] + (size_t)j * D * D;
            bf16* dst = (m < 3 ? (bf16*)(wm + RW_WRKV) + (size_t)m * D * D : (bf16*)(wm + RW_WO)) + (size_t)nb * 32 * 1024 + kb * 64;
            transpose_item_s(W, 1024, kb * 64, nb * 32, dst, 1024, scr, lane, nullptr, 0, 64); continue; } r -= 4 * I_SQ;
        if (r < I_L1) { const int part = r & 1, q = r >> 1, kb = q & 15, nbx = q >> 4;
            const float* mu = a.in[26] + (size_t)j * 6 * D; const float* W; int ldw, n0, muix, drow;
            if (nbx < 2) { W = a.in[32] + (size_t)j * D * 64; ldw = 64; n0 = nbx * 32; muix = 1; drow = n0; }
            else if (nbx < 4) { W = a.in[35] + (size_t)j * D * 64; ldw = 64; n0 = (nbx - 2) * 32; muix = 4; drow = 64 + n0; }
            else if (nbx < 8) { W = a.in[40] + (size_t)j * D * 128; ldw = 128; n0 = (nbx - 4) * 32; muix = 5; drow = 128 + n0; }
            else { if (j == 0) continue; W = a.in[38] + (size_t)(j - 1) * D * 32; ldw = 32; n0 = 0; muix = 3; drow = 256; }
            bf16* dst = (bf16*)(wm + RW_L1) + (size_t)drow * 2048 + part * 1024 + kb * 64;
            transpose_item_s(W, ldw, kb * 64, n0, dst, 2048, scr, lane, mu + muix * D, part == 0 ? 1 : 2, 64); continue; } r -= I_L1;
        if (r < 32) { transpose_item_s(a.in[33] + (size_t)j * 64 * D, 1024, 0, r * 32, (bf16*)(wm + RW_W2W) + (size_t)r * 32 * 64, 64, scr, lane, nullptr, 0, 64); continue; } r -= 32;
        if (r < 32) { transpose_item_s(a.in[36] + (size_t)j * 64 * D, 1024, 0, r * 32, (bf16*)(wm + RW_W2A) + (size_t)r * 32 * 64, 64, scr, lane, nullptr, 0, 64); continue; } r -= 32;
        if (r < 64) { const int kb = r >> 5, nb = r & 31; transpose_item_s(a.in[41] + (size_t)j * 128 * D, 1024, kb * 64, nb * 32, (bf16*)(wm + RW_W2G) + (size_t)nb * 32 * 128 + kb * 64, 128, scr, lane, nullptr, 0, 64); continue; } r -= 64;
        if (j > 0) transpose_item_s(a.in[39] + (size_t)(j - 1) * 32 * D, 1024, 0, r * 32, (bf16*)(wm + RW_W2V) + (size_t)r * 32 * 32, 32, scr, lane, nullptr, 0, 32);
    }
    { GAS v4u* z = (GAS v4u*)(wsl + WS_WMIX + WM_RW + WM_RW_STRIDE + RW_L1 + (size_t)288 * 2048 * 2); const int n16 = 224 * 2048 * 2 / 16;
      for (int i = F.c * NT + tid; i < n16; i += F.G * NT) z[i] = (v4u){0u, 0u, 0u, 0u}; }
}

__device__ __forceinline__ void pass_rwin(Frame& F, const float* gain, const float* mu, int has_o) {
    PHASE_IDS();
    const int gw = F.c * NWAVES + wave, NGW = F.G * NWAVES;
    f32x4 g[4], mr[4], mk[4], mv[4];
#pragma unroll
    for (int q = 0; q < 4; ++q) { g[q] = *(const GAS f32x4*)(gain + 256 * q + 4 * lane); mr[q] = *(const GAS f32x4*)(mu + 0 * D + 256 * q + 4 * lane); mk[q] = *(const GAS f32x4*)(mu + 2 * D + 256 * q + 4 * lane); mv[q] = *(const GAS f32x4*)(mu + 3 * D + 256 * q + 4 * lane); }
    const float* H = (const float*)(wsl + WS_H); const bf16* O = (const bf16*)(wsl + WS_O);
    unsigned char* act = wsl + WS_ACT;
    const int uchunk = (TP / 8 + F.G - 1) / F.G, ulim = (F.c + 1) * uchunk < TP / 8 ? (F.c + 1) * uchunk : TP / 8;
    for (int run = F.c * uchunk + wave; run < ulim; run += NWAVES) { const int r0 = run * 8, rb = run % (LP / 8);
        f32x4 prev[4];
#pragma unroll
        for (int q = 0; q < 4; ++q) prev[q] = (f32x4){0.f, 0.f, 0.f, 0.f};
        if (rb < 2) {
            for (int rr = 0; rr < 8; ++rr) { const int row = r0 + rr;
                GAS v2u* o0 = (GAS v2u*)(act + R_HN + (size_t)row * D * 2) + lane; GAS v2u* o1 = (GAS v2u*)(act + R_XR + (size_t)row * D * 2) + lane;
                GAS v2u* o2 = (GAS v2u*)(act + R_XK + (size_t)row * D * 2) + lane; GAS v2u* o3 = (GAS v2u*)(act + R_XV + (size_t)row * D * 2) + lane;
#pragma unroll
                for (int q = 0; q < 4; ++q) { o0[64 * q] = (v2u){0u, 0u}; o1[64 * q] = (v2u){0u, 0u}; o2[64 * q] = (v2u){0u, 0u}; o3[64 * q] = (v2u){0u, 0u}; } }
            continue; }
        RowBuf cur, nxt;
        const int first = (rb > 2) ? -1 : 0;
        row_issue(cur, H, O, r0 + first, has_o, lane);
        for (int rr = first; rr < 8; ++rr) { const int row = r0 + rr;
            if (rr < 7) row_issue(nxt, H, O, row + 1, has_o, lane);
            const float rs = row_finish(cur, has_o);
            if (rr < 0) {
#pragma unroll
                for (int q = 0; q < 4; ++q) prev[q] = cur.v[q] * rs * g[q];
            } else {
                GAS v2u* o0 = (GAS v2u*)(act + R_HN + (size_t)row * D * 2) + lane; GAS v2u* o1 = (GAS v2u*)(act + R_XR + (size_t)row * D * 2) + lane;
                GAS v2u* o2 = (GAS v2u*)(act + R_XK + (size_t)row * D * 2) + lane; GAS v2u* o3 = (GAS v2u*)(act + R_XV + (size_t)row * D * 2) + lane;
#pragma unroll
                for (int q = 0; q < 4; ++q) { const f32x4 cu = cur.v[q] * rs * g[q], dx = prev[q] - cu; prev[q] = cu;
                    const f32x4 xr = cu + dx * mr[q], xk = cu + dx * mk[q], xv = cu + dx * mv[q];
                    v2u w; w.x = pk2(cu.x, cu.y); w.y = pk2(cu.z, cu.w); o0[64 * q] = w;
                    w.x = pk2(xr.x, xr.y); w.y = pk2(xr.z, xr.w); o1[64 * q] = w;
                    w.x = pk2(xk.x, xk.y); w.y = pk2(xk.z, xk.w); o2[64 * q] = w;
                    w.x = pk2(xv.x, xv.y); w.y = pk2(xv.z, xv.w); o3[64 * q] = w; } }
            cur = nxt;
        }
    }
}

struct RwSched {
    const char* act; const char* wm; int nl  , G, c;
    __device__ __forceinline__ void single(int s, Unit& u) const { const int which = s / 260, rem = s % 260, pm = rem >> 2, pn = rem & 3;
        u.A = act + (which == 0 ? R_XR : which == 1 ? R_XK : R_XV) + (size_t)pm * 256 * 2048; u.B = wm + RW_WRKV + ((size_t)which * 1024 + pn * 256) * 2048;
        u.rows = nullptr; u.nvalid = 0; u.lda2 = 2048; u.ldb2 = 2048; u.nt = 16; u.pm = pm; u.pn = pn; u.x0 = which; u.x1 = 0; }
    __device__ __forceinline__ void dbl(int d, Unit& u) const { const int pm = d / nl, pn = d % nl;
        u.A = act + R_HN + ((size_t)pm * 256 - 1) * 2048; u.B = wm + RW_L1 + (size_t)pn * 256 * 4096;
        u.rows = nullptr; u.nvalid = 0; u.lda2 = 2048; u.ldb2 = 4096; u.nt = 32; u.pm = pm; u.pn = pn; u.x0 = 3; u.x1 = 0; }
    __device__ __forceinline__ bool next(int i, Unit& u) const {
        const int nd = 65 * nl, ns = 780; int rho;
        if (c < nd) { if (i == 0) { dbl(c, u); return true; } rho = (i - 1) * G + c; }
        else { if (i < 2) { const int s = 2 * (c - nd) + i; if (s >= ns) return false; single(s, u); return true; } rho = (i - 2) * G + c; }
        const int s = 2 * (G - nd) + rho; if (s >= ns || G < nd) return false;
        single(s, u); return true;
    }
};
struct EpiRw {
    static constexpr bool PERM = true;
    bf16* Rb; bf16* Kb; bf16* Vb; bf16* L1b;
    __device__ __forceinline__ void operator()(const f32x4 (&acc)[2][2][4][2], const Unit& u, int wr, int wc, int fr, int fq) const {
        asm volatile("" : "+v"(fr));
        const int lora = (u.x0 == 3); const int ldo = lora ? 512 : 1024;
        GAS unsigned char* ob = (GAS unsigned char*)(u.x0 == 0 ? Rb : u.x0 == 1 ? Kb : u.x0 == 2 ? Vb : L1b) + ((size_t)u.pm * 256 * ldo + u.pn * 256 + wc * 32) * 2;
#pragma unroll
        for (int bj = 0; bj < 2; ++bj) { const int act = (lora && u.pn == 0) ? (bj == 0 ? (wc < 2 ? 1 : 0) : 2) : 0;
#pragma unroll
            for (int ai = 0; ai < 2; ++ai)
#pragma unroll
                for (int m = 0; m < 4; ++m) { const int r = ai * HALF + wr * 64 + m * 16 + fr; float o[8];
#pragma unroll
                    for (int n = 0; n < 2; ++n)
#pragma unroll
                        for (int q = 0; q < 4; ++q) { const float x = acc[ai][bj][m][n][q]; o[n * 4 + q] = act == 1 ? (2.f * sigmoid_f(2.f * x) - 1.f) : act == 2 ? sigmoid_f(x) : x; }
                    v4u w; w.x = cvt_pk_bf16(o[0], o[1]); w.y = cvt_pk_bf16(o[2], o[3]); w.z = cvt_pk_bf16(o[4], o[5]); w.w = cvt_pk_bf16(o[6], o[7]);
                    *(GAS v4u*)(ob + ((unsigned)r * (unsigned)ldo * 2u + (unsigned)(bj * 256 + fq * 16))) = w; } }
    }
};

__device__ __forceinline__ void rw_prep_unit(Frame& F, const Args& a, int j, int hd, int rng, int dry) {
    PHASE_IDS();
    const int fr = lane & 15, fq = lane >> 4;
    constexpr int PW = 72, PG = 136, PV = 40;
    LAS bf16* Lw = (LAS bf16*)(F.lds + RING_OFF); LAS bf16* La = Lw + 64 * PW; LAS bf16* Lg = La + 64 * PW; LAS bf16* Lv = Lg + 64 * PG;
    LAS float* cst = (LAS float*)(Lv + 64 * PV);
    const unsigned char* wm = wsl + WS_WMIX + WM_RW + (size_t)j * WM_RW_STRIDE; unsigned char* act = wsl + WS_ACT;
    __syncthreads();
    for (int i = tid; i < 64 * 8; i += NT) { const int n = i >> 3, c8 = i & 7;
        *(LAS v4u*)(Lw + n * PW + 8 * c8) = *(const GAS v4u*)((const bf16*)(wm + RW_W2W) + (size_t)(hd * 64 + n) * 64 + 8 * c8);
        *(LAS v4u*)(La + n * PW + 8 * c8) = *(const GAS v4u*)((const bf16*)(wm + RW_W2A) + (size_t)(hd * 64 + n) * 64 + 8 * c8); }
    for (int i = tid; i < 64 * 16; i += NT) { const int n = i >> 4, c8 = i & 15; *(LAS v4u*)(Lg + n * PG + 8 * c8) = *(const GAS v4u*)((const bf16*)(wm + RW_W2G) + (size_t)(hd * 64 + n) * 128 + 8 * c8); }
    if (j > 0) for (int i = tid; i < 64 * 4; i += NT) { const int n = i >> 2, c8 = i & 3; *(LAS v4u*)(Lv + n * PV + 8 * c8) = *(const GAS v4u*)((const bf16*)(wm + RW_W2V) + (size_t)(hd * 64 + n) * 32 + 8 * c8); }
    if (tid < 64) { const int c = hd * 64 + tid; cst[tid] = a.in[31][j * D + c]; cst[64 + tid] = a.in[34][j * D + c]; cst[128 + tid] = j > 0 ? a.in[37][(j - 1) * D + c] : 0.f; cst[192 + tid] = a.in[42][j * D + c]; cst[256 + tid] = a.in[43][j * D + c]; }
    __syncthreads();
    const bf16* L1 = (const bf16*)(act + R_L1); bf16* Kb = (bf16*)(act + R_K); bf16* Vb = (bf16*)(act + R_V); const bf16* VF = (const bf16*)(wsl + WS_VF);
    bf16* WLb = (bf16*)(act + R_XR); bf16* KKb = (bf16*)(act + R_XK); bf16* BBb = (bf16*)(act + R_XV); bf16* GGb = (bf16*)(act + R_HN);
    for (int tile = rng * 65 + wave; tile < rng * 65 + 65; tile += NWAVES) {
        if (tile % (LP / 16) == 0) continue;
        const size_t row = (size_t)tile * 16 + fr;
        const bf16* lr = L1 + row * 512 + 8 * fq;
        bf16x8 aw[2], aa[2], ag[4], av;
#pragma unroll
        for (int ks = 0; ks < 2; ++ks) { aw[ks] = *(const GAS bf16x8*)(lr + 32 * ks); aa[ks] = *(const GAS bf16x8*)(lr + 64 + 32 * ks); }
#pragma unroll
        for (int ks = 0; ks < 4; ++ks) ag[ks] = *(const GAS bf16x8*)(lr + 128 + 32 * ks);
        av = *(const GAS bf16x8*)(lr + 256);
        const size_t cb = row * D + hd * 64 + 4 * fq;
        float kx[4][4], aq[4][4], kq[4][4]; float ss = 0.f;
#pragma unroll
        for (int nt = 0; nt < 4; ++nt) { f32x4 ca = (f32x4){0.f, 0.f, 0.f, 0.f};
#pragma unroll
            for (int ks = 0; ks < 2; ++ks) ca = __builtin_amdgcn_mfma_f32_16x16x32_bf16(*(const LAS bf16x8*)(La + (16 * nt + fr) * PW + 32 * ks + 8 * fq), aa[ks], ca, 0, 0, 0);
            const v2u kk2 = *(const GAS v2u*)(Kb + cb + 16 * nt); const float kv[4] = {bflo(kk2.x), bfhi(kk2.x), bflo(kk2.y), bfhi(kk2.y)};
#pragma unroll
            for (int e = 0; e < 4; ++e) { const int ch = 16 * nt + 4 * fq + e; aq[nt][e] = sigmoid_f(cst[64 + ch] + ca[e]); kq[nt][e] = kv[e]; kx[nt][e] = kv[e] * cst[192 + ch]; ss += kx[nt][e] * kx[nt][e]; } }
        ss += __shfl_xor(ss, 16); ss += __shfl_xor(ss, 32);
        const float inv = 1.f / fmaxf(sqrtf(ss), 1e-12f);
#pragma unroll
        for (int nt = 0; nt < 4; ++nt) { f32x4 cw_ = (f32x4){0.f, 0.f, 0.f, 0.f}, cg = cw_, cv = cw_;
#pragma unroll
            for (int ks = 0; ks < 2; ++ks) cw_ = __builtin_amdgcn_mfma_f32_16x16x32_bf16(*(const LAS bf16x8*)(Lw + (16 * nt + fr) * PW + 32 * ks + 8 * fq), aw[ks], cw_, 0, 0, 0);
#pragma unroll
            for (int ks = 0; ks < 4; ++ks) cg = __builtin_amdgcn_mfma_f32_16x16x32_bf16(*(const LAS bf16x8*)(Lg + (16 * nt + fr) * PG + 32 * ks + 8 * fq), ag[ks], cg, 0, 0, 0);
            if (j > 0) cv = __builtin_amdgcn_mfma_f32_16x16x32_bf16(*(const LAS bf16x8*)(Lv + (16 * nt + fr) * PV + 8 * fq), av, cv, 0, 0, 0);
            float wl[4], kn[4], bb[4], k2[4];
#pragma unroll
            for (int e = 0; e < 4; ++e) { const int ch = 16 * nt + 4 * fq + e; const float x = cst[ch] + cw_[e];
                wl[e] = -0.6065306597f * sigmoid_f(x);
                kn[e] = kx[nt][e] * inv; bb[e] = kn[e] * aq[nt][e]; k2[e] = kq[nt][e] * (1.f + (aq[nt][e] - 1.f) * cst[256 + ch]); }
            if (dry) continue;
            v2u w; const size_t off = cb + 16 * nt;
            w.x = pk2(wl[0], wl[1]); w.y = pk2(wl[2], wl[3]); *(GAS v2u*)(WLb + off) = w;
            w.x = pk2(kn[0], kn[1]); w.y = pk2(kn[2], kn[3]); *(GAS v2u*)(KKb + off) = w;
            w.x = pk2(bb[0], bb[1]); w.y = pk2(bb[2], bb[3]); *(GAS v2u*)(BBb + off) = w;
            w.x = pk2(k2[0], k2[1]); w.y = pk2(k2[2], k2[3]); *(GAS v2u*)(Kb + off) = w;
            w.x = pk2(cg[0], cg[1]); w.y = pk2(cg[2], cg[3]); *(GAS v2u*)(GGb + off) = w;
            if (j > 0) { const v2u v2 = *(const GAS v2u*)(Vb + off), f2 = *(const GAS v2u*)(VF + off); const float vv[4] = {bflo(v2.x), bfhi(v2.x), bflo(v2.y), bfhi(v2.y)}, vf[4] = {bflo(f2.x), bfhi(f2.x), bflo(f2.y), bfhi(f2.y)}; float vo[4];
#pragma unroll
                for (int e = 0; e < 4; ++e) { const int ch = 16 * nt + 4 * fq + e; vo[e] = vv[e] + (vf[e] - vv[e]) * sigmoid_f(cst[128 + ch] + cv[e]); }
                w.x = pk2(vo[0], vo[1]); w.y = pk2(vo[2], vo[3]); *(GAS v2u*)(Vb + off) = w; }
        }
    }
}

__device__ __forceinline__ void wkv_unit(Frame& F, const Args& a, int j, int b, int hd, int dry) {
    PHASE_IDS();
    constexpr int TB = 32;
    LAS float* buf = (LAS float*)(F.lds + RING_OFF);
    LAS float* yb = buf + 2 * 6 * TB * 64;
    unsigned char* act = wsl + WS_ACT;
    const int ahi = tid >> 8;
    const bf16* src0 = (const bf16*)(act + (ahi ? R_XR : R_XK)); const bf16* src1 = (const bf16*)(act + (ahi ? R_K : R_XV));
    const bf16* src2 = ahi ? (j == 0 ? (const bf16*)(wsl + WS_VF) : (const bf16*)(act + R_V)) : (const bf16*)(act + R_R);
    bf16* GG = (bf16*)(act + R_HN);
    const size_t row0 = (size_t)b * LP + PRE; const int cbase = hd * 64;
    const int i = tid >> 3, jo = tid & 7;
    float S[8];
#pragma unroll
    for (int e = 0; e < 8; ++e) S[e] = 0.f;
    v4u st[3];
#define WKV_LOAD(t0) do { _Pragma("unroll") for (int q = 0; q < 3; ++q) { const int tk = (tid >> 3) & 31, c8 = tid & 7; const int tt = (t0) + tk; const bf16* sp_ = q == 0 ? src0 : q == 1 ? src1 : src2; \
        st[q] = tt < L ? *(const GAS v4u*)(sp_ + (row0 + tt) * D + cbase + 8 * c8) : (v4u){0u, 0u, 0u, 0u}; } } while (0)
#define WKV_STORE(bi) do { _Pragma("unroll") for (int q = 0; q < 3; ++q) { const int p = tid + NT * q, arr = p >> 8, tk = (p >> 3) & 31, c8 = p & 7; \
        float x[8] = {bflo(st[q].x), bfhi(st[q].x), bflo(st[q].y), bfhi(st[q].y), bflo(st[q].z), bfhi(st[q].z), bflo(st[q].w), bfhi(st[q].w)}; \
        if (arr == 0) { _Pragma("unroll") for (int e = 0; e < 8; ++e) x[e] = -x[e]; } \
        if (arr == 1) { _Pragma("unroll") for (int e = 0; e < 8; ++e) x[e] = __expf(x[e]); } \
        LAS f32x4* d = (LAS f32x4*)(buf + ((bi) * 6 + arr) * TB * 64 + tk * 64 + 8 * c8); d[0] = (f32x4){x[0], x[1], x[2], x[3]}; d[1] = (f32x4){x[4], x[5], x[6], x[7]}; } } while (0)
    const float* rk = a.in[44] + (size_t)(j * 16 + hd) * 64; const float* lnw = a.in[45] + j * D + cbase; const float* lnb = a.in[46] + j * D + cbase;
    __syncthreads();
    WKV_LOAD(0); WKV_STORE(0);
    __syncthreads();
    constexpr int NBLK = (L + TB - 1) / TB;
    for (int blk = 0; blk < NBLK; ++blk) { const int bi = blk & 1, t0 = blk * TB;
        if (blk + 1 < NBLK) WKV_LOAD(t0 + TB);
        const LAS float* A_ = buf + (bi * 6 + 0) * TB * 64 + 8 * jo; const LAS float* W_ = buf + (bi * 6 + 1) * TB * 64 + 8 * jo; const LAS float* B_ = buf + (bi * 6 + 2) * TB * 64 + 8 * jo;
        const LAS float* K_ = buf + (bi * 6 + 3) * TB * 64 + 8 * jo; const LAS float* R_ = buf + (bi * 6 + 4) * TB * 64 + 8 * jo; const LAS float* V_ = buf + (bi * 6 + 5) * TB * 64 + i;
#pragma unroll 2
        for (int tk = 0; tk < TB; ++tk) {
            const f32x4 a0 = *(const LAS f32x4*)(A_ + tk * 64), a1 = *(const LAS f32x4*)(A_ + tk * 64 + 4), w0 = *(const LAS f32x4*)(W_ + tk * 64), w1 = *(const LAS f32x4*)(W_ + tk * 64 + 4);
            const f32x4 b0 = *(const LAS f32x4*)(B_ + tk * 64), b1 = *(const LAS f32x4*)(B_ + tk * 64 + 4), k0 = *(const LAS f32x4*)(K_ + tk * 64), k1 = *(const LAS f32x4*)(K_ + tk * 64 + 4);
            const f32x4 r0 = *(const LAS f32x4*)(R_ + tk * 64), r1 = *(const LAS f32x4*)(R_ + tk * 64 + 4); const float vi = V_[tk * 64];
            float sa = (S[0] * a0.x + S[1] * a0.y) + (S[2] * a0.z + S[3] * a0.w) + (S[4] * a1.x + S[5] * a1.y) + (S[6] * a1.z + S[7] * a1.w);
            sa = sum8(sa);
            S[0] = S[0] * w0.x + (sa * b0.x + vi * k0.x); S[1] = S[1] * w0.y + (sa * b0.y + vi * k0.y); S[2] = S[2] * w0.z + (sa * b0.z + vi * k0.z); S[3] = S[3] * w0.w + (sa * b0.w + vi * k0.w);
            S[4] = S[4] * w1.x + (sa * b1.x + vi * k1.x); S[5] = S[5] * w1.y + (sa * b1.y + vi * k1.y); S[6] = S[6] * w1.z + (sa * b1.z + vi * k1.z); S[7] = S[7] * w1.w + (sa * b1.w + vi * k1.w);
            float y = (S[0] * r0.x + S[1] * r0.y) + (S[2] * r0.z + S[3] * r0.w) + (S[4] * r1.x + S[5] * r1.y) + (S[6] * r1.z + S[7] * r1.w);
            y = sum8(y);
            if (jo == 0) yb[tk * 64 + i] = y;
        }
        __syncthreads();
        {
            const int tk = tid >> 4, i4 = 4 * (tid & 15), tt = t0 + tk;
            const f32x4 y4 = *(const LAS f32x4*)(yb + tk * 64 + i4);
            const f32x4 r4 = *(const LAS f32x4*)(buf + (bi * 6 + 4) * TB * 64 + tk * 64 + i4), k4 = *(const LAS f32x4*)(buf + (bi * 6 + 3) * TB * 64 + tk * 64 + i4), v4 = *(const LAS f32x4*)(buf + (bi * 6 + 5) * TB * 64 + tk * 64 + i4);
            const f32x4 rk4 = *(const GAS f32x4*)(rk + i4);
            float s1 = (y4.x + y4.y) + (y4.z + y4.w), s3 = (r4.x * k4.x * rk4.x + r4.y * k4.y * rk4.y) + (r4.z * k4.z * rk4.z + r4.w * k4.w * rk4.w);
            s1 = sum16(s1); s3 = sum16(s3);
            const float mean = s1 * (1.f / 64.f); const f32x4 d4 = y4 - mean; float s2 = (d4.x * d4.x + d4.y * d4.y) + (d4.z * d4.z + d4.w * d4.w);
            s2 = sum16(s2);
            const float rstd = rsqrtf(s2 * (1.f / 64.f) + 64e-5f);
            if (tt < L && !dry) { GAS v2u* gp = (GAS v2u*)(GG + (row0 + tt) * D + cbase + i4); const v2u g2 = *gp; const f32x4 lw4 = *(const GAS f32x4*)(lnw + i4), lb4 = *(const GAS f32x4*)(lnb + i4);
                const float o0 = (d4.x * rstd * lw4.x + lb4.x + s3 * v4.x) * bflo(g2.x), o1 = (d4.y * rstd * lw4.y + lb4.y + s3 * v4.y) * bfhi(g2.x);
                const float o2 = (d4.z * rstd * lw4.z + lb4.z + s3 * v4.z) * bflo(g2.y), o3 = (d4.w * rstd * lw4.w + lb4.w + s3 * v4.w) * bfhi(g2.y);
                v2u w; w.x = pk2(o0, o1); w.y = pk2(o2, o3); *gp = w; }
        }
        if (blk + 1 < NBLK) WKV_STORE(bi ^ 1);
        __syncthreads();
    }
#undef WKV_LOAD
#undef WKV_STORE
}
}
namespace fk {
__device__ __forceinline__ bf16x8 frag_z() { return (bf16x8){0, 0, 0, 0, 0, 0, 0, 0}; }
#if defined(WST16) && WST16
#define WT_B(k) do { if (WST16_SEL == (k)) wl16 = __builtin_amdgcn_s_memrealtime(); } while (0)
#define WT_E(k) do { if (WST16_SEL == (k)) *wacc += __builtin_amdgcn_s_memrealtime() - wl16; } while (0)
#else
#define WT_B(k)
#define WT_E(k)
#endif
__device__ __forceinline__ void wkv_chunk_unit(Frame& F, const Args& a, int j, int b, int hd, int dry, unsigned long long* wacc) {
    PHASE_IDS();
    unsigned long long wl16 = 0ull; (void)wl16; (void)wacc;
    const int fr = lane & 15, fq = lane >> 4;
    constexpr int P72 = 72, P24 = 24, P40 = 40;
    constexpr int O_RAW = 0;
    constexpr int O_AT = O_RAW + 2 * 6 * 2048, O_BH = O_AT + 16 * P72 * 2, O_KH = O_BH + 16 * P72 * 2, O_RT = O_KH + 16 * P72 * 2;
    constexpr int O_ATT = O_RT + 16 * P72 * 2;
    constexpr int O_BKT = O_ATT + 64 * P24 * 2;
    constexpr int O_UV = O_BKT + 64 * P40 * 2, O_UV0 = O_UV + 64 * P40 * 2;
    constexpr int O_NN = O_UV0 + 64 * P40 * 2;
    constexpr int O_NAK = O_NN + 16 * P40 * 2, O_TT = O_NAK + 16 * P24 * 2, O_W2T = O_TT + 16 * P24 * 2;
    constexpr int O_NABT = O_W2T + 16 * P24 * 2;
    constexpr int O_PQ = O_NABT + 1024;
    constexpr int O_P1 = O_PQ + 32 * P72 * 2;
    constexpr int O_S = O_P1 + 64 * P24 * 2;
    constexpr int O_YB = O_S + 64 * P72 * 2;
    constexpr int O_GC = O_YB + 4096;
    static_assert(O_GC + 256 <= RING_BYTES, "wkv LDS");
    LAS unsigned char* lb = F.lds + RING_OFF;
#define LBF(off) ((LAS bf16*)(lb + (off)))
    unsigned char* act = wsl + WS_ACT;
    const size_t row0 = (size_t)b * LP + PRE; const int cbase = hd * 64;
    const int ar0 = tid >> 7;
    const bf16* s0p = (const bf16*)(act + (ar0 == 0 ? R_XK : ar0 == 1 ? R_XR : ar0 == 2 ? R_XV : R_K));
    const bf16* s1p = (ar0 == 0) ? (const bf16*)(act + R_R) : (j == 0 ? (const bf16*)(wsl + WS_VF) : (const bf16*)(act + R_V));
    const int pt = (tid >> 3) & 15, pc8 = tid & 7;
    v4u pf0, pf1 = (v4u){0u, 0u, 0u, 0u};
#define WKC_LOAD(c) do { const size_t ro_ = (row0 + (size_t)(c) * 16 + pt) * D + cbase + 8 * pc8; pf0 = *(const GAS v4u*)(s0p + ro_); if (tid < 256) pf1 = *(const GAS v4u*)(s1p + ro_); } while (0)
#define WKC_STORE(bi) do { *(LAS v4u*)(lb + O_RAW + (bi) * 12288 + ar0 * 2048 + pt * 128 + pc8 * 16) = pf0; if (tid < 256) *(LAS v4u*)(lb + O_RAW + (bi) * 12288 + (4 + ar0) * 2048 + pt * 128 + pc8 * 16) = pf1; } while (0)
    const float* rk = a.in[44] + (size_t)(j * 16 + hd) * 64; const float* lnw = a.in[45] + j * D + cbase; const float* lnb = a.in[46] + j * D + cbase;
    bf16* GG = (bf16*)(act + R_HN);
    const int et = (tid >> 4) & 15, ei4 = 4 * (tid & 15);
    const f32x4 rk4 = *(const GAS f32x4*)(rk + ei4), lw4 = *(const GAS f32x4*)(lnw + ei4), lb4 = *(const GAS f32x4*)(lnb + ei4);
    v2u gpre = (v2u){0u, 0u};
    __syncthreads();
    for (int i = tid; i < 64 * P72 / 2; i += NT) ((LAS unsigned*)(lb + O_S))[i] = 0u;
    f32x4 sacc[2] = {(f32x4){0.f, 0.f, 0.f, 0.f}, (f32x4){0.f, 0.f, 0.f, 0.f}};
    WKC_LOAD(0); WKC_STORE(0);
    __syncthreads();
#define WKC_EPILOGUE(cc, RAWE) do { const int t = et, i4 = ei4; \
                const f32x4 y4 = *(const LAS f32x4*)(lb + O_YB + (t * 64 + i4) * 4); \
                const v2u r2 = *(const LAS v2u*)((RAWE) + 4 * 1024 + t * 64 + i4), k2 = *(const LAS v2u*)((RAWE) + 3 * 1024 + t * 64 + i4), v2 = *(const LAS v2u*)((RAWE) + 5 * 1024 + t * 64 + i4); \
                float s1 = (y4.x + y4.y) + (y4.z + y4.w), s3 = (bflo(r2.x) * bflo(k2.x) * rk4.x + bfhi(r2.x) * bfhi(k2.x) * rk4.y) + (bflo(r2.y) * bflo(k2.y) * rk4.z + bfhi(r2.y) * bfhi(k2.y) * rk4.w); \
                s1 = sum16(s1); s3 = sum16(s3); \
                const float mean = s1 * (1.f / 64.f); const f32x4 d4 = y4 - mean; float s2 = (d4.x * d4.x + d4.y * d4.y) + (d4.z * d4.z + d4.w * d4.w); \
                s2 = sum16(s2); \
                const float rstd = rsqrtf(s2 * (1.f / 64.f) + 64e-5f); \
                if (!dry) { GAS v2u* gp = (GAS v2u*)(GG + (row0 + (size_t)(cc) * 16 + t) * D + cbase + i4); const v2u g2 = gpre; \
                    const float o0 = (d4.x * rstd * lw4.x + lb4.x + s3 * bflo(v2.x)) * bflo(g2.x), o1 = (d4.y * rstd * lw4.y + lb4.y + s3 * bfhi(v2.x)) * bfhi(g2.x); \
                    const float o2 = (d4.z * rstd * lw4.z + lb4.z + s3 * bflo(v2.y)) * bflo(g2.y), o3 = (d4.w * rstd * lw4.w + lb4.w + s3 * bfhi(v2.y)) * bfhi(g2.y); \
                    v2u w; w.x = pk2(o0, o1); w.y = pk2(o2, o3); *gp = w; } } while (0)
    constexpr int NCH = L / 16;
    for (int c = 0; c < NCH; ++c) { const int bi = c & 1;
        WT_B(0); WT_B(8);
        const LAS bf16* RAW = LBF(O_RAW + bi * 12288);
        if (c + 1 < NCH) WKC_LOAD(c + 1);
        v2u gnew = (v2u){0u, 0u}; if (tid >= 256) gnew = *(const GAS v2u*)(GG + (row0 + (size_t)c * 16 + et) * D + cbase + ei4);
        {
            const int jj = tid & 63, t0 = 2 * wave;
            float run = 0.f, lgm0 = 0.f, lg0 = 0.f, lg1 = 0.f;
#pragma unroll
            for (int s = 0; s < 16; ++s) { const float w_ = bf2f(RAW[1 * 1024 + s * 64 + jj]); if (s == t0) lgm0 = run; run += w_; if (s == t0) lg0 = run; if (s == t0 + 1) lg1 = run; }
            const float lgC = run;
            const float kk0 = bf2f(RAW[0 * 1024 + t0 * 64 + jj]), kk1 = bf2f(RAW[0 * 1024 + (t0 + 1) * 64 + jj]), bb0 = bf2f(RAW[2 * 1024 + t0 * 64 + jj]), bb1 = bf2f(RAW[2 * 1024 + (t0 + 1) * 64 + jj]);
            const float k0 = bf2f(RAW[3 * 1024 + t0 * 64 + jj]), k1 = bf2f(RAW[3 * 1024 + (t0 + 1) * 64 + jj]), r0 = bf2f(RAW[4 * 1024 + t0 * 64 + jj]), r1 = bf2f(RAW[4 * 1024 + (t0 + 1) * 64 + jj]);
            const unsigned v01 = (unsigned)RAW[5 * 1024 + t0 * 64 + jj] | ((unsigned)RAW[5 * 1024 + (t0 + 1) * 64 + jj] << 16);
            const float em0 = __expf(lgm0), em1 = __expf(lg0), en0 = __expf(-lg0), en1 = __expf(-lg1), ep0 = __expf(lg0), ep1 = __expf(lg1), ec0 = __expf(lgC - lg0), ec1 = __expf(lgC - lg1);
            const unsigned at0 = f2bf(-kk0 * em0), at1 = f2bf(-kk1 * em1);
            LBF(O_AT)[t0 * P72 + jj] = (bf16)at0; LBF(O_AT)[(t0 + 1) * P72 + jj] = (bf16)at1;
            LBF(O_BH)[t0 * P72 + jj] = (bf16)f2bf(bb0 * en0); LBF(O_BH)[(t0 + 1) * P72 + jj] = (bf16)f2bf(bb1 * en1);
            LBF(O_KH)[t0 * P72 + jj] = (bf16)f2bf(k0 * en0); LBF(O_KH)[(t0 + 1) * P72 + jj] = (bf16)f2bf(k1 * en1);
            LBF(O_RT)[t0 * P72 + jj] = (bf16)f2bf(r0 * ep0); LBF(O_RT)[(t0 + 1) * P72 + jj] = (bf16)f2bf(r1 * ep1);
            *(LAS unsigned*)(LBF(O_ATT) + jj * P24 + t0) = at0 | (at1 << 16);
            *(LAS unsigned*)(LBF(O_BKT) + jj * P40 + t0) = pk2(bb0 * ec0, bb1 * ec1);
            *(LAS unsigned*)(LBF(O_BKT) + jj * P40 + 16 + t0) = pk2(k0 * ec0, k1 * ec1);
            *(LAS unsigned*)(LBF(O_UV) + jj * P40 + 16 + t0) = v01; *(LAS unsigned*)(LBF(O_UV0) + jj * P40 + 16 + t0) = v01;
            if (wave == 0) ((LAS float*)(lb + O_GC))[jj] = __expf(lgC);
        }
        WT_E(0);
        WT_B(7);
        LDS_BARRIER();
        WT_E(7);
        WT_B(1);
        if (wave < 4) {
            const LAS bf16* Am = LBF(wave == 1 ? O_AT : (wave == 3 ? O_KH : O_BH)); const LAS bf16* Bm = LBF(wave == 0 ? O_AT : (wave == 1 ? O_KH : O_RT));
            f32x4 d = (f32x4){0.f, 0.f, 0.f, 0.f};
#pragma unroll
            for (int ks = 0; ks < 2; ++ks) d = __builtin_amdgcn_mfma_f32_16x16x32_bf16(*(const LAS bf16x8*)(Am + fr * P72 + 32 * ks + 8 * fq), *(const LAS bf16x8*)(Bm + fr * P72 + 32 * ks + 8 * fq), d, 0, 0, 0);
            if (wave == 0) {
#pragma unroll
                for (int e = 0; e < 4; ++e) ((LAS float*)(lb + O_NABT))[(fr * 4 + e) * 4 + fq] = (4 * fq + e < fr) ? d[e] : 0.f;
                LDS_WAIT();
                const int q = lane & 3, r = lane >> 2; float T4[4] = {0.f, 0.f, 0.f, 0.f};
#pragma unroll
                for (int t = 0; t < 16; ++t) { const f32x4 m4 = *(const LAS f32x4*)(lb + O_NABT + ((t * 4 + q) * 4) * 4);
                    float p = (T4[0] * m4[0] + T4[1] * m4[1]) + (T4[2] * m4[2] + T4[3] * m4[3]);
                    p += dpp_mov<0xB1>(p); p += dpp_mov<0x4E>(p);
                    p += (r == t) ? 1.f : 0.f;
                    T4[t >> 2] = (q == (t & 3)) ? p : T4[t >> 2]; }
#pragma unroll
                for (int e = 0; e < 4; ++e) LBF(O_TT)[(4 * e + q) * P24 + r] = (bf16)f2bf(T4[e]);
            }
            else if (wave == 1) { float o[4];
#pragma unroll
                for (int e = 0; e < 4; ++e) o[e] = (fr < 4 * fq + e) ? d[e] : 0.f;
                v2u w; w.x = pk2(o[0], o[1]); w.y = pk2(o[2], o[3]); *(LAS v2u*)(LBF(O_NAK) + fr * P24 + 4 * fq) = w; }
            else { float o[4];
#pragma unroll
                for (int e = 0; e < 4; ++e) o[e] = (4 * fq + e <= fr) ? d[e] : 0.f;
                v2u w; w.x = pk2(o[0], o[1]); w.y = pk2(o[2], o[3]); *(LAS v2u*)(LBF(O_NN) + fr * P40 + (wave == 3 ? 16 : 0) + 4 * fq) = w; }
        } else if (c > 0) { WKC_EPILOGUE(c - 1, LBF(O_RAW + (bi ^ 1) * 12288)); }
        gpre = gnew;
        WT_E(1);
        WT_B(7);
        LDS_BARRIER();
        WT_E(7);
        WT_B(3);
        if (wave < 4) {
            const bf16x8 af = fq < 2 ? *(const LAS bf16x8*)(LBF(O_ATT) + (16 * wave + fr) * P24 + 8 * fq) : frag_z();
            const bf16x8 bfv = fq < 2 ? *(const LAS bf16x8*)(LBF(O_TT) + fr * P24 + 8 * fq) : frag_z();
            const f32x4 d = __builtin_amdgcn_mfma_f32_16x16x32_bf16(af, bfv, (f32x4){0.f, 0.f, 0.f, 0.f}, 0, 0, 0);
            v2u w; w.x = pk2(d[0], d[1]); w.y = pk2(d[2], d[3]);
            *(LAS v2u*)(LBF(O_PQ) + fr * P72 + 16 * wave + 4 * fq) = w;
#pragma unroll
            for (int e = 0; e < 4; ++e) LBF(O_P1)[(16 * wave + 4 * fq + e) * P24 + fr] = (bf16)f2bf(d[e]);
        } else if (wave == 4) {
            const bf16x8 af = fq < 2 ? *(const LAS bf16x8*)(LBF(O_NAK) + fr * P24 + 8 * fq) : frag_z();
            const bf16x8 bfv = fq < 2 ? *(const LAS bf16x8*)(LBF(O_TT) + fr * P24 + 8 * fq) : frag_z();
            const f32x4 d = __builtin_amdgcn_mfma_f32_16x16x32_bf16(af, bfv, (f32x4){0.f, 0.f, 0.f, 0.f}, 0, 0, 0);
            v2u w; w.x = pk2(d[0], d[1]); w.y = pk2(d[2], d[3]); *(LAS v2u*)(LBF(O_W2T) + fr * P24 + 4 * fq) = w;
        }
        WT_E(3);
        WT_B(7);
        LDS_BARRIER();
        WT_E(7);
        WT_B(4);
        f32x4 acc;
        if (wave < 4) {
            const bf16x8 af = fq < 2 ? *(const LAS bf16x8*)(LBF(O_W2T) + fr * P24 + 8 * fq) : frag_z();
            const bf16x8 bfv = fq < 2 ? *(const LAS bf16x8*)(LBF(O_UV0) + (16 * wave + fr) * P40 + 16 + 8 * fq) : frag_z();
            acc = __builtin_amdgcn_mfma_f32_16x16x32_bf16(af, bfv, (f32x4){0.f, 0.f, 0.f, 0.f}, 0, 0, 0);
            v2u w; w.x = pk2(acc[0], acc[1]); w.y = pk2(acc[2], acc[3]); *(LAS v2u*)(LBF(O_UV0) + (16 * wave + fr) * P40 + 4 * fq) = w;
        } else {
            const int jt = wave - 4;
            const bf16x8 af = fq < 2 ? *(const LAS bf16x8*)(LBF(O_P1) + (16 * jt + fr) * P24 + 8 * fq) : frag_z();
            const bf16x8 bfv = fq < 2 ? *(const LAS bf16x8*)(LBF(O_NN) + fr * P40 + 8 * fq) : frag_z();
            const v2u rr = *(const LAS v2u*)(LBF(O_RT) + fr * P72 + 16 * jt + 4 * fq);
            const f32x4 d = __builtin_amdgcn_mfma_f32_16x16x32_bf16(af, bfv, (f32x4){bflo(rr.x), bfhi(rr.x), bflo(rr.y), bfhi(rr.y)}, 0, 0, 0);
            v2u w; w.x = pk2(d[0], d[1]); w.y = pk2(d[2], d[3]); *(LAS v2u*)(LBF(O_PQ) + (16 + fr) * P72 + 16 * jt + 4 * fq) = w;
        }
        WT_E(4);
        WT_B(7);
        LDS_BARRIER();
        WT_E(7);
        WT_B(5);
        {
            const int mt = wave >> 2, nt = wave & 3;
            if (wave >= 4) acc = __builtin_amdgcn_mfma_f32_16x16x32_bf16(*(const LAS bf16x8*)(LBF(O_NN) + fr * P40 + 8 * fq), *(const LAS bf16x8*)(LBF(O_UV0) + (16 * nt + fr) * P40 + 8 * fq), (f32x4){0.f, 0.f, 0.f, 0.f}, 0, 0, 0);
#pragma unroll
            for (int ks = 0; ks < 2; ++ks) acc = __builtin_amdgcn_mfma_f32_16x16x32_bf16(*(const LAS bf16x8*)(LBF(O_PQ) + (16 * mt + fr) * P72 + 32 * ks + 8 * fq), *(const LAS bf16x8*)(LBF(O_S) + (16 * nt + fr) * P72 + 32 * ks + 8 * fq), acc, 0, 0, 0);
            if (wave < 4) { v2u w; w.x = pk2(acc[0], acc[1]); w.y = pk2(acc[2], acc[3]); *(LAS v2u*)(LBF(O_UV) + (16 * nt + fr) * P40 + 4 * fq) = w; }
            else {
#pragma unroll
                for (int e = 0; e < 4; ++e) ((LAS float*)(lb + O_YB))[(4 * fq + e) * 64 + 16 * nt + fr] = acc[e]; }
        }
        WT_E(5);
        WT_B(7);
        LDS_BARRIER();
        WT_E(7);
        WT_B(6);
        {
            const int jt = wave >> 1; const f32x4 g4 = *(const LAS f32x4*)(lb + O_GC + (16 * jt + 4 * fq) * 4);
            const bf16x8 af = *(const LAS bf16x8*)(LBF(O_BKT) + (16 * jt + fr) * P40 + 8 * fq);
#pragma unroll
            for (int q = 0; q < 2; ++q) { const int it = 2 * (wave & 1) + q;
                sacc[q] = __builtin_amdgcn_mfma_f32_16x16x32_bf16(af, *(const LAS bf16x8*)(LBF(O_UV) + (16 * it + fr) * P40 + 8 * fq), sacc[q] * g4, 0, 0, 0);
                v2u w; w.x = pk2(sacc[q][0], sacc[q][1]); w.y = pk2(sacc[q][2], sacc[q][3]); *(LAS v2u*)(LBF(O_S) + (16 * it + fr) * P72 + 16 * jt + 4 * fq) = w; }
            if (c + 1 < NCH) WKC_STORE(bi ^ 1);
        }
        WT_E(6);
        WT_B(7);
        LDS_BARRIER();
        WT_E(7);
        WT_E(8);
    }
    if (wave >= 4) { WKC_EPILOGUE(NCH - 1, LBF(O_RAW + ((NCH - 1) & 1) * 12288)); }
#undef WKC_EPILOGUE
#undef LBF
#undef WKC_LOAD
#undef WKC_STORE
}
}
namespace fk {
#if defined(WSTAMP) && WSTAMP
#define WTICK(k) do { const unsigned long long tn_ = __builtin_amdgcn_s_memrealtime(); if ((WSTAMP_SEL >> (k)) & 1) *wacc += tn_ - wlast; wlast = tn_; } while (0)
#else
#define WTICK(k)
#endif
__device__ __forceinline__ void wkv32_unit(Frame& F, const Args& a, int j, int b, int hd, int dry, unsigned long long* wacc) {
    PHASE_IDS();
    unsigned long long wlast = 0ull; (void)wlast; (void)wacc;
#if defined(WSTAMP) && WSTAMP
    wlast = __builtin_amdgcn_s_memrealtime();
#endif
#define STAGE_IDS() int ln_ = lane; asm volatile("" : "+v"(ln_)); const int fr = ln_ & 15, fq = ln_ >> 4; (void)fr; (void)fq
    constexpr int CT = 32, P72 = 72, P40 = 40;
    constexpr int O_RAW = 0;
    constexpr int O_EPI = O_RAW + 6 * 4096;
    constexpr int O_AT = O_EPI + 3 * 4096, O_BH = O_AT + CT * P72 * 2, O_KH = O_BH + CT * P72 * 2, O_RT = O_KH + CT * P72 * 2;
    constexpr int O_ATT = O_RT + CT * P72 * 2;
    constexpr int O_BKT = O_ATT + 64 * P40 * 2;
    constexpr int O_UV = O_BKT + 64 * P72 * 2, O_UV0 = O_UV + 64 * P72 * 2;
    constexpr int O_NN = O_UV0 + 64 * P72 * 2;
    constexpr int O_NAK = O_NN + CT * P72 * 2, O_TT = O_NAK + CT * P40 * 2, O_W2T = O_TT + CT * P40 * 2;
    constexpr int O_NABT = O_W2T + CT * P40 * 2;
    constexpr int O_PQ = O_NABT + 4096;
    constexpr int O_P1 = O_PQ + 64 * P72 * 2;
    constexpr int O_S = O_P1 + 64 * P40 * 2;
    constexpr int O_YB = O_S + 64 * P72 * 2;
    constexpr int O_GC = O_YB + 8192;
    constexpr int O_CST = O_GC + 256;
    static_assert(O_CST + 768 <= LDS_USER_BYTES, "wkv32 LDS");
    LAS unsigned char* lb = F.lds + RING_OFF;
#define LBF(off) ((LAS bf16*)(lb + (off)))
    unsigned char* act = wsl + WS_ACT;
    const size_t row0 = (size_t)b * LP + PRE; const int cbase = hd * 64;
    const int ahi = wave >> 2;
    const bf16* src0 = (const bf16*)(act + (ahi ? R_XR : R_XK)); const bf16* src1 = (const bf16*)(act + (ahi ? R_K : R_XV));
    const bf16* src2 = ahi ? (j == 0 ? (const bf16*)(wsl + WS_VF) : (const bf16*)(act + R_V)) : (const bf16*)(act + R_R);
    const int ptk = (tid >> 3) & 31, pc8 = tid & 7;
    v4u pf[3];
#define W32_LOAD(c) do { const int tt_ = (c) * CT + ptk; const size_t ro_ = (row0 + tt_) * D + cbase + 8 * pc8; const bool ok_ = tt_ < L; \
        pf[0] = ok_ ? *(const GAS v4u*)(src0 + ro_) : (v4u){0u, 0u, 0u, 0u}; pf[1] = ok_ ? *(const GAS v4u*)(src1 + ro_) : (v4u){0u, 0u, 0u, 0u}; pf[2] = ok_ ? *(const GAS v4u*)(src2 + ro_) : (v4u){0u, 0u, 0u, 0u}; } while (0)
#define W32_STORE() do { _Pragma("unroll") for (int q_ = 0; q_ < 3; ++q_) *(LAS v4u*)(lb + O_RAW + (ahi + 2 * q_) * 4096 + ptk * 128 + pc8 * 16) = pf[q_]; } while (0)
    bf16* GG = (bf16*)(act + R_HN);
    const int et = tid >> 4, ei4 = 4 * (tid & 15);
    v2u gpre = (v2u){0u, 0u};
    __syncthreads();
    if (tid < 64) { ((LAS float*)(lb + O_CST))[tid] = a.in[44][(size_t)(j * 16 + hd) * 64 + tid]; ((LAS float*)(lb + O_CST))[64 + tid] = a.in[45][j * D + cbase + tid]; ((LAS float*)(lb + O_CST))[128 + tid] = a.in[46][j * D + cbase + tid]; }
    for (int i = tid; i < 64 * P72 / 2; i += NT) ((LAS unsigned*)(lb + O_S))[i] = 0u;
    f32x4 sacc[2] = {(f32x4){0.f, 0.f, 0.f, 0.f}, (f32x4){0.f, 0.f, 0.f, 0.f}};
    constexpr int NCH = (L + CT - 1) / CT;
    W32_LOAD(0); W32_STORE(); W32_LOAD(1);
    gpre = *(const GAS v2u*)(GG + (row0 + et) * D + cbase + ei4);
    __syncthreads();
    for (int c = 0; c < NCH; ++c) {
        {
            int lnA = lane; asm volatile("" : "+v"(lnA));
            const int t = lnA & 31, hf = lnA >> 5, ch0 = 8 * wave + 4 * hf;
            const LAS bf16* RAW = LBF(O_RAW);
            v2u x[6];
#pragma unroll
            for (int q = 0; q < 6; ++q) x[q] = *(const LAS v2u*)(RAW + q * 2048 + t * 64 + ch0);
            float wl[4] = {bflo(x[1].x), bfhi(x[1].x), bflo(x[1].y), bfhi(x[1].y)}, lg[4], lgC[4];
#pragma unroll
            for (int e = 0; e < 4; ++e) { float s_ = wl[e];
                s_ += __builtin_bit_cast(float, __builtin_amdgcn_update_dpp(0, __builtin_bit_cast(int, s_), 0x111, 0xf, 0xf, true));
                s_ += __builtin_bit_cast(float, __builtin_amdgcn_update_dpp(0, __builtin_bit_cast(int, s_), 0x112, 0xf, 0xf, true));
                s_ += __builtin_bit_cast(float, __builtin_amdgcn_update_dpp(0, __builtin_bit_cast(int, s_), 0x114, 0xf, 0xf, true));
                s_ += __builtin_bit_cast(float, __builtin_amdgcn_update_dpp(0, __builtin_bit_cast(int, s_), 0x118, 0xf, 0xf, true));
                s_ += __builtin_bit_cast(float, __builtin_amdgcn_update_dpp(0, __builtin_bit_cast(int, s_), 0x142, 0xa, 0xf, false));
                lg[e] = s_;
                const float t31 = __builtin_bit_cast(float, __builtin_amdgcn_readlane(__builtin_bit_cast(int, s_), 31)), t63 = __builtin_bit_cast(float, __builtin_amdgcn_readlane(__builtin_bit_cast(int, s_), 63));
                lgC[e] = hf ? t63 : t31; }
            const float kk[4] = {bflo(x[0].x), bfhi(x[0].x), bflo(x[0].y), bfhi(x[0].y)}, bb[4] = {bflo(x[2].x), bfhi(x[2].x), bflo(x[2].y), bfhi(x[2].y)};
            const float kv[4] = {bflo(x[3].x), bfhi(x[3].x), bflo(x[3].y), bfhi(x[3].y)}, rv[4] = {bflo(x[4].x), bfhi(x[4].x), bflo(x[4].y), bfhi(x[4].y)};
            float at[4], bh[4], kh[4], rt[4], bc[4], kc[4];
#pragma unroll
            for (int e = 0; e < 4; ++e) { const float en = __expf(-lg[e]), ec = __expf(lgC[e] - lg[e]); at[e] = -kk[e] * __expf(lg[e] - wl[e]); bh[e] = bb[e] * en; kh[e] = kv[e] * en; rt[e] = rv[e] * __expf(lg[e]); bc[e] = bb[e] * ec; kc[e] = kv[e] * ec; }
            v2u w;
            w.x = pk2(at[0], at[1]); w.y = pk2(at[2], at[3]); *(LAS v2u*)(LBF(O_AT) + t * P72 + ch0) = w;
#pragma unroll
            for (int e = 0; e < 4; ++e) LBF(O_ATT)[(ch0 + e) * P40 + t] = (bf16)((e & 1) ? ((e < 2 ? w.x : w.y) >> 16) : ((e < 2 ? w.x : w.y) & 0xffffu));
            w.x = pk2(bh[0], bh[1]); w.y = pk2(bh[2], bh[3]); *(LAS v2u*)(LBF(O_BH) + t * P72 + ch0) = w;
            w.x = pk2(kh[0], kh[1]); w.y = pk2(kh[2], kh[3]); *(LAS v2u*)(LBF(O_KH) + t * P72 + ch0) = w;
            w.x = pk2(rt[0], rt[1]); w.y = pk2(rt[2], rt[3]); *(LAS v2u*)(LBF(O_RT) + t * P72 + ch0) = w;
#pragma unroll
            for (int e = 0; e < 4; ++e) { LBF(O_BKT)[(ch0 + e) * P72 + t] = (bf16)f2bf(bc[e]); LBF(O_BKT)[(ch0 + e) * P72 + 32 + t] = (bf16)f2bf(kc[e]);
                const bf16 vb = (bf16)((e & 1) ? ((e < 2 ? x[5].x : x[5].y) >> 16) : ((e < 2 ? x[5].x : x[5].y) & 0xffffu));
                LBF(O_UV)[(ch0 + e) * P72 + 32 + t] = vb; LBF(O_UV0)[(ch0 + e) * P72 + 32 + t] = vb; }
            *(LAS v2u*)(LBF(O_EPI) + 0 * 2048 + t * 64 + ch0) = x[4]; *(LAS v2u*)(LBF(O_EPI) + 1 * 2048 + t * 64 + ch0) = x[3]; *(LAS v2u*)(LBF(O_EPI) + 2 * 2048 + t * 64 + ch0) = x[5];
            if (t == 0) *(LAS f32x4*)(lb + O_GC + ch0 * 4) = (f32x4){__expf(lgC[0]), __expf(lgC[1]), __expf(lgC[2]), __expf(lgC[3])};
        }
        WTICK(0);
        LDS_BARRIER();
        WTICK(6);
        {
            STAGE_IDS();
            const int mat = wave >> 1, odd = wave & 1;
            const LAS bf16* Am = LBF(mat == 1 ? O_AT : (mat == 3 ? O_KH : O_BH)); const LAS bf16* Bm = LBF(mat == 0 ? O_AT : (mat == 1 ? O_KH : O_RT));
#pragma unroll
            for (int q = 0; q < 2; ++q) {
                int mt, nt; bool zero = false;
                if (mat == 1) { if (!odd) { mt = 0; nt = q; zero = (q == 1); } else { mt = 1; nt = q; } }
                else { if (!odd) { mt = 0; nt = q; } else { mt = 1; nt = 1 - q; zero = (q == 1); } }
                f32x4 d = (f32x4){0.f, 0.f, 0.f, 0.f};
                if (!zero) {
#pragma unroll
                    for (int ks = 0; ks < 2; ++ks) d = __builtin_amdgcn_mfma_f32_16x16x32_bf16(*(const LAS bf16x8*)(Am + (16 * mt + fr) * P72 + 32 * ks + 8 * fq), *(const LAS bf16x8*)(Bm + (16 * nt + fr) * P72 + 32 * ks + 8 * fq), d, 0, 0, 0); }
                const int mg = 16 * mt + 4 * fq, ng = 16 * nt + fr;
                if (mat == 0) {
#pragma unroll
                    for (int e = 0; e < 4; ++e) ((LAS float*)(lb + O_NABT))[(ng * 4 + e) * 8 + (mg >> 2)] = (!zero && mg + e < ng) ? d[e] : 0.f; }
                else if (mat == 1) { float o[4];
#pragma unroll
                    for (int e = 0; e < 4; ++e) o[e] = (!zero && ng < mg + e) ? d[e] : 0.f;
                    v2u w; w.x = pk2(o[0], o[1]); w.y = pk2(o[2], o[3]); *(LAS v2u*)(LBF(O_NAK) + ng * P40 + mg) = w; }
                else { float o[4];
#pragma unroll
                    for (int e = 0; e < 4; ++e) o[e] = (!zero && mg + e <= ng) ? d[e] : 0.f;
                    v2u w; w.x = pk2(o[0], o[1]); w.y = pk2(o[2], o[3]); *(LAS v2u*)(LBF(O_NN) + ng * P72 + (mat == 3 ? 32 : 0) + mg) = w; }
            }
        }
        WTICK(1);
        LDS_BARRIER();
        WTICK(6);
        if (wave < 2) {
            int ln_ = lane; asm volatile("" : "+v"(ln_));
            const int q = ln_ & 3, r = 16 * wave + (ln_ >> 2);
            float T8[8];
#pragma unroll
            for (int e = 0; e < 8; ++e) T8[e] = 0.f;
#pragma unroll
            for (int t = 0; t < 32; ++t) {
                const f32x4 ma = *(const LAS f32x4*)(lb + O_NABT + ((t * 4 + q) * 8) * 4), mb = *(const LAS f32x4*)(lb + O_NABT + ((t * 4 + q) * 8 + 4) * 4);
                float p = ((T8[0] * ma[0] + T8[1] * ma[1]) + (T8[2] * ma[2] + T8[3] * ma[3])) + ((T8[4] * mb[0] + T8[5] * mb[1]) + (T8[6] * mb[2] + T8[7] * mb[3]));
                p += dpp_mov<0xB1>(p); p += dpp_mov<0x4E>(p);
                p += (r == t) ? 1.f : 0.f;
                T8[t >> 2] = (q == (t & 3)) ? p : T8[t >> 2];
            }
#pragma unroll
            for (int e = 0; e < 8; ++e) LBF(O_TT)[(4 * e + q) * P40 + r] = (bf16)f2bf(T8[e]);
        }
        WTICK(2);
        LDS_BARRIER();
        WTICK(6);
        f32x4 ua[2], ya[2];
        if (wave < 4) {
            STAGE_IDS();
            const int jt = wave; const bf16x8 af = *(const LAS bf16x8*)(LBF(O_ATT) + (16 * jt + fr) * P40 + 8 * fq);
#pragma unroll
            for (int nt = 0; nt < 2; ++nt) { const f32x4 d = __builtin_amdgcn_mfma_f32_16x16x32_bf16(af, *(const LAS bf16x8*)(LBF(O_TT) + (16 * nt + fr) * P40 + 8 * fq), (f32x4){0.f, 0.f, 0.f, 0.f}, 0, 0, 0);
                v2u w; w.x = pk2(d[0], d[1]); w.y = pk2(d[2], d[3]); *(LAS v2u*)(LBF(O_PQ) + (16 * nt + fr) * P72 + 16 * jt + 4 * fq) = w;
#pragma unroll
                for (int e = 0; e < 4; ++e) LBF(O_P1)[(16 * jt + 4 * fq + e) * P40 + 16 * nt + fr] = (bf16)((e & 1) ? ((e < 2 ? w.x : w.y) >> 16) : ((e < 2 ? w.x : w.y) & 0xffffu)); }
            LDS_WAIT();
            const bf16x8 pf_ = *(const LAS bf16x8*)(LBF(O_P1) + (16 * jt + fr) * P40 + 8 * fq);
#pragma unroll
            for (int nt = 0; nt < 2; ++nt) { const v2u rr = *(const LAS v2u*)(LBF(O_RT) + (16 * nt + fr) * P72 + 16 * jt + 4 * fq);
                const f32x4 d = __builtin_amdgcn_mfma_f32_16x16x32_bf16(pf_, *(const LAS bf16x8*)(LBF(O_NN) + (16 * nt + fr) * P72 + 8 * fq), (f32x4){bflo(rr.x), bfhi(rr.x), bflo(rr.y), bfhi(rr.y)}, 0, 0, 0);
                v2u w; w.x = pk2(d[0], d[1]); w.y = pk2(d[2], d[3]); *(LAS v2u*)(LBF(O_PQ) + (32 + 16 * nt + fr) * P72 + 16 * jt + 4 * fq) = w; }
        } else {
            STAGE_IDS();
            const int it = wave - 4;
#pragma unroll
            for (int ms = 0; ms < 2; ++ms) { const bf16x8 af = *(const LAS bf16x8*)(LBF(O_NAK) + (16 * ms + fr) * P40 + 8 * fq);
#pragma unroll
                for (int nt = 0; nt < 2; ++nt) { const f32x4 d = __builtin_amdgcn_mfma_f32_16x16x32_bf16(af, *(const LAS bf16x8*)(LBF(O_TT) + (16 * nt + fr) * P40 + 8 * fq), (f32x4){0.f, 0.f, 0.f, 0.f}, 0, 0, 0);
                    v2u w; w.x = pk2(d[0], d[1]); w.y = pk2(d[2], d[3]); *(LAS v2u*)(LBF(O_W2T) + (16 * nt + fr) * P40 + 16 * ms + 4 * fq) = w; } }
            LDS_WAIT();
            const bf16x8 vf_ = *(const LAS bf16x8*)(LBF(O_UV0) + (16 * it + fr) * P72 + 32 + 8 * fq);
#pragma unroll
            for (int mt = 0; mt < 2; ++mt) { ua[mt] = __builtin_amdgcn_mfma_f32_16x16x32_bf16(*(const LAS bf16x8*)(LBF(O_W2T) + (16 * mt + fr) * P40 + 8 * fq), vf_, (f32x4){0.f, 0.f, 0.f, 0.f}, 0, 0, 0);
                v2u w; w.x = pk2(ua[mt][0], ua[mt][1]); w.y = pk2(ua[mt][2], ua[mt][3]); *(LAS v2u*)(LBF(O_UV0) + (16 * it + fr) * P72 + 16 * mt + 4 * fq) = w; }
            LDS_WAIT();
#pragma unroll
            for (int mt = 0; mt < 2; ++mt) { ya[mt] = (f32x4){0.f, 0.f, 0.f, 0.f};
#pragma unroll
                for (int ks = 0; ks < 2; ++ks) ya[mt] = __builtin_amdgcn_mfma_f32_16x16x32_bf16(*(const LAS bf16x8*)(LBF(O_NN) + (16 * mt + fr) * P72 + 32 * ks + 8 * fq), *(const LAS bf16x8*)(LBF(O_UV0) + (16 * it + fr) * P72 + 32 * ks + 8 * fq), ya[mt], 0, 0, 0); }
        }
        WTICK(3);
        LDS_BARRIER();
        WTICK(6);
        if (wave >= 4) {
            STAGE_IDS();
            const int it = wave - 4; bf16x8 sf[2];
#pragma unroll
            for (int ks = 0; ks < 2; ++ks) sf[ks] = *(const LAS bf16x8*)(LBF(O_S) + (16 * it + fr) * P72 + 32 * ks + 8 * fq);
#pragma unroll
            for (int mt = 0; mt < 4; ++mt) { f32x4 acc = mt < 2 ? ua[mt & 1] : ya[mt & 1];
#pragma unroll
                for (int ks = 0; ks < 2; ++ks) acc = __builtin_amdgcn_mfma_f32_16x16x32_bf16(*(const LAS bf16x8*)(LBF(O_PQ) + (16 * mt + fr) * P72 + 32 * ks + 8 * fq), sf[ks], acc, 0, 0, 0);
                if (mt < 2) { v2u w; w.x = pk2(acc[0], acc[1]); w.y = pk2(acc[2], acc[3]); *(LAS v2u*)(LBF(O_UV) + (16 * it + fr) * P72 + 16 * mt + 4 * fq) = w; }
                else {
#pragma unroll
                    for (int e = 0; e < 4; ++e) ((LAS float*)(lb + O_YB))[(16 * (mt - 2) + 4 * fq + e) * 64 + 16 * it + fr] = acc[e]; } }
        }
        WTICK(4);
        LDS_BARRIER();
        WTICK(6);
        {
            STAGE_IDS();
            const int jt = wave >> 1; const f32x4 g4 = *(const LAS f32x4*)(lb + O_GC + (16 * jt + 4 * fq) * 4);
            bf16x8 af[2];
#pragma unroll
            for (int ks = 0; ks < 2; ++ks) af[ks] = *(const LAS bf16x8*)(LBF(O_BKT) + (16 * jt + fr) * P72 + 32 * ks + 8 * fq);
#pragma unroll
            for (int q = 0; q < 2; ++q) { const int it = 2 * (wave & 1) + q; sacc[q] = sacc[q] * g4;
#pragma unroll
                for (int ks = 0; ks < 2; ++ks) sacc[q] = __builtin_amdgcn_mfma_f32_16x16x32_bf16(af[ks], *(const LAS bf16x8*)(LBF(O_UV) + (16 * it + fr) * P72 + 32 * ks + 8 * fq), sacc[q], 0, 0, 0);
                v2u w; w.x = pk2(sacc[q][0], sacc[q][1]); w.y = pk2(sacc[q][2], sacc[q][3]); *(LAS v2u*)(LBF(O_S) + (16 * it + fr) * P72 + 16 * jt + 4 * fq) = w; }
            v2u gnext = (v2u){0u, 0u};
            { const int tn = (c + 1) * CT + et; if (tn < L) gnext = *(const GAS v2u*)(GG + (row0 + tn) * D + cbase + ei4); }
            if (c + 1 < NCH) W32_STORE();
            if (c + 2 < NCH) W32_LOAD(c + 2);
            {   const int t = et, i4 = ei4, tt = c * CT + t;
                const f32x4 y4 = *(const LAS f32x4*)(lb + O_YB + (t * 64 + i4) * 4);
                const f32x4 rk4 = *(const LAS f32x4*)(lb + O_CST + i4 * 4), lw4 = *(const LAS f32x4*)(lb + O_CST + (64 + i4) * 4), lb4 = *(const LAS f32x4*)(lb + O_CST + (128 + i4) * 4);
                const v2u r2 = *(const LAS v2u*)(LBF(O_EPI) + 0 * 2048 + t * 64 + i4), k2 = *(const LAS v2u*)(LBF(O_EPI) + 1 * 2048 + t * 64 + i4), v2 = *(const LAS v2u*)(LBF(O_EPI) + 2 * 2048 + t * 64 + i4);
                float s1 = (y4.x + y4.y) + (y4.z + y4.w), s3 = (bflo(r2.x) * bflo(k2.x) * rk4.x + bfhi(r2.x) * bfhi(k2.x) * rk4.y) + (bflo(r2.y) * bflo(k2.y) * rk4.z + bfhi(r2.y) * bfhi(k2.y) * rk4.w);
                s1 = sum16(s1); s3 = sum16(s3);
                const float mean = s1 * (1.f / 64.f); const f32x4 d4 = y4 - mean; float s2 = (d4.x * d4.x + d4.y * d4.y) + (d4.z * d4.z + d4.w * d4.w);
                s2 = sum16(s2);
                const float rstd = rsqrtf(s2 * (1.f / 64.f) + 64e-5f);
                if (tt < L && !dry) { const v2u g2 = gpre;
                    const float o0 = (d4.x * rstd * lw4.x + lb4.x + s3 * bflo(v2.x)) * bflo(g2.x), o1 = (d4.y * rstd * lw4.y + lb4.y + s3 * bfhi(v2.x)) * bfhi(g2.x);
                    const float o2 = (d4.z * rstd * lw4.z + lb4.z + s3 * bflo(v2.y)) * bflo(g2.y), o3 = (d4.w * rstd * lw4.w + lb4.w + s3 * bfhi(v2.y)) * bfhi(g2.y);
                    v2u w; w.x = pk2(o0, o1); w.y = pk2(o2, o3); *(GAS v2u*)(GG + (row0 + tt) * D + cbase + i4) = w; } }
            gpre = gnext;
        }
        WTICK(5);
        LDS_BARRIER();
        WTICK(6);
    }
#undef LBF
#undef W32_LOAD
#undef W32_STORE
#undef STAGE_IDS
}
}
namespace fk {
__global__ void __launch_bounds__(NT, 2) mega(Args args) {
    extern __shared__ __attribute__((aligned(16))) unsigned char lds_raw[];
    Frame F;
    F.lds = (LAS unsigned char*)lds_raw; F.MISC = (volatile LAS unsigned*)(F.lds + MISC_OFF);
    F.tid = threadIdx.x; F.lane = F.tid & 63; F.wave = __builtin_amdgcn_readfirstlane(F.tid >> 6);
    F.G = gridDim.x; F.c = blockIdx.x; F.vc = (F.G % 8 == 0) ? (int)(blockIdx.x % 8) * (F.G / 8) + (int)(blockIdx.x / 8) : (int)blockIdx.x; F.ws = args.ws; F.ctl = (unsigned*)(args.ws + WS_CTL);
    for (int u = F.tid; u < 256; u += NT) F.MISC[u] = 0u;
    __syncthreads();
    XcdBarrier bar = xcd_barrier_post(F.ctl + CW_BAR + args.li * XCD_BAR_WORDS, F.MISC + 8);
    const int lo = args.ph_lo, hi = args.ph_hi;
#define IN(k) (lo <= (k) && (k) < hi)
#if defined(PROBE) && PROBE
#define REP(grp) for (int rep_ = 0, nrep_ = (args.rep_group == (grp)) ? args.rep_n : 1; rep_ < nrep_; ++rep_)
#define DRY (rep_ + 1 < nrep_ ? 1 : 0)
#else
#define REP(grp)
#define DRY 0
#endif
#if (defined(WSTAMP) && WSTAMP) || (defined(WST16) && WST16)
    unsigned long long wacc_ = 0ull;
#define WACC (&wacc_)
#else
#define WACC nullptr
#endif
#if defined(STAMP) && STAMP
    unsigned long long tacc = 0ull, tlast = __builtin_amdgcn_s_memrealtime();
#define TICK(cls) do { const unsigned long long tn_ = __builtin_amdgcn_s_memrealtime(); if ((STAMP_SEL >> (cls)) & 1) tacc += tn_ - tlast; tlast = tn_; } while (0)
#define SEAM(k) do { TICK(ptype_); if ((k) + 1 < hi) { xcd_barrier(bar); } TICK(20); } while (0)
#define PT(ty) const int ptype_ = (ty)
#else
#define TICK(cls)
#define PT(ty)
#define SEAM(k) do { if ((k) + 1 < hi) { REP(8) xcd_barrier(bar); } } while (0)
#endif
    if (IN(0)) { PT(0); REP(5) { prologue_ab(F, args); prologue_rw(F, args); } SEAM(0); }
    for (int l = 0; l < 4; ++l) {
        const int pb = 1 + 20 * l; const int has_o = (args.comb && l > 0) ? 1 : 0;
        unsigned char* wsl = F.ws; asm volatile("" : "+s"(wsl));
        if ((l & 1) == 0) {
            const int j = l >> 1; unsigned char* wm = wsl + WS_WMIX + (size_t)j * WM_AB_STRIDE; unsigned char* act = wsl + WS_ACT;
            if (IN(pb + 0)) { PT(1); REP(3) pass_norm(F, args.in[2] + l * D, has_o, (bf16*)(act + B_HN)); SEAM(pb + 0); }
            if (IN(pb + 1)) { PT(2);
                DenseSched S{(const char*)(act + B_HN), (const char*)(wm + WM_WIN), 2048, 2048, 16, TP / 256, 6, F.G, F.vc};
                EpiBf16 E{(bf16*)(act + B_Z), 1536};
                REP(1) gemm_stream<EpiBf16, DenseSched, false>(F.lds + RING_OFF, S, E);
                phase_done(F, F.ctl + CW_DONE + 64 * (2 * l)); moe_conv_drain(F, args, l, F.ctl + CW_DONE + 64 * (2 * l));
                SEAM(pb + 1);
            }
            if (IN(pb + 2)) { PT(3);
                REP(4) for (int u = F.c; u < 512; u += F.G) { if (u < 256) lru_unit(F, args, j, u >> 5, (u >> 2) & 7, u & 3); else s5_unit(F, j, (u - 256) >> 5, (u - 256) & 31); }
                SEAM(pb + 2);
            }
            if (IN(pb + 3)) { PT(4);
                DenseSched S{(const char*)(act + B_YS), (const char*)(wm + WM_WGLU), 1024, 1024, 8, TP / 256, 2, F.G, F.vc};
                EpiGlu E{(const bf16*)(act + B_YS), (bf16*)(act + B_CAT), args.in[18] + j * 512, (float*)(act + B_SSA)};
                REP(1) gemm_stream<EpiGlu, DenseSched, false>(F.lds + RING_OFF, S, E);
                phase_done(F, F.ctl + CW_DONE + 64 * (2 * l + 1)); moe_conv_drain(F, args, l, F.ctl + CW_DONE + 64 * (2 * l + 1));
                SEAM(pb + 3);
            }
            if (IN(pb + 4)) { PT(5); REP(3) pass_abnorm(F, args.in[7] + j * 512, args.in[8] + j * 512, DRY); SEAM(pb + 4); }
            if (IN(pb + 5)) { PT(6);
                DenseSched S{(const char*)(act + B_CAT), (const char*)(wm + WM_WOUT), 2048, 2048, 16, TP / 256 - 1, 4, F.G, F.vc};
                EpiResid E{(float*)(wsl + WS_H), (const bf16*)(wsl + WS_O), has_o, 0};
                REP(1) { E.dry = DRY; gemm_stream<EpiResid, DenseSched, false>(F.lds + RING_OFF, S, E); resid_tail(F, (const bf16*)(act + B_CAT), (const bf16*)(wm + WM_WOUT), has_o, DRY); }
                SEAM(pb + 5);
            }
        }
        if ((l & 1) == 1) {
            const int j = l >> 1; unsigned char* wm = wsl + WS_WMIX + WM_RW + (size_t)j * WM_RW_STRIDE; unsigned char* act = wsl + WS_ACT;
            if (IN(pb + 0)) { PT(7); REP(3) pass_rwin(F, args.in[2] + l * D, args.in[26] + (size_t)j * 6 * D, has_o); SEAM(pb + 0); }
            if (IN(pb + 1)) { PT(8);
                RwSched S{(const char*)act, (const char*)wm, j == 0 ? 1 : 2, F.G, F.vc};
                EpiRw E{(bf16*)(act + R_R), (bf16*)(act + R_K), j == 0 ? (bf16*)(wsl + WS_VF) : (bf16*)(act + R_V), (bf16*)(act + R_L1)};
                REP(1) gemm_stream<EpiRw, RwSched, false>(F.lds + RING_OFF, S, E);
                SEAM(pb + 1);
            }
            if (IN(pb + 2)) { PT(9); REP(6) for (int u = F.c; u < 256; u += F.G) rw_prep_unit(F, args, j, u >> 4, u & 15, DRY); SEAM(pb + 2); }
            if (IN(pb + 3)) { PT(10); REP(2) for (int u = F.c; u < 128; u += F.G) wkv_chunk_unit(F, args, j, u >> 4, u & 15, DRY, WACC); if (F.c >= 128) moe_conv_drain(F, args, l, nullptr); SEAM(pb + 3); }
            if (IN(pb + 4)) { PT(11);
                DenseSched S{(const char*)(act + R_HN), (const char*)(wm + RW_WO), 2048, 2048, 16, TP / 256 - 1, 4, F.G, F.vc};
                EpiResid E{(float*)(wsl + WS_H), (const bf16*)(wsl + WS_O), has_o, 0};
                REP(1) { E.dry = DRY; gemm_stream<EpiResid, DenseSched, false>(F.lds + RING_OFF, S, E); resid_tail(F, (const bf16*)(act + R_HN), (const bf16*)(wm + RW_WO), has_o, DRY); }
                SEAM(pb + 4);
            }
        }
        if (IN(pb + 10)) { PT(13); REP(3) moe_route(F, args, l, DRY); moe_conv_drain(F, args, l, nullptr); SEAM(pb + 10); }
        if (IN(pb + 11)) { PT(14);
            REP(7) moe_tables(F, l);
            MoeSched S{F.MISC + 64, (const char*)(wsl + WS_ACT + A_XN), (const char*)(wsl + WS_WMOE), (const int*)(wsl + WS_ACT + A_LIST), 2048, 2048, 16, F.G, F.vc, 1};
            EpiSwiglu E{(bf16*)(wsl + WS_ACT + A_HID), (const float*)(wsl + WS_ACT + A_LISTW)};
            REP(1) gemm_stream<EpiSwiglu, MoeSched, true>(F.lds + RING_OFF, S, E);
            SEAM(pb + 11);
        }
        if (IN(pb + 12)) { PT(15);
            REP(7) moe_tables(F, l);
            MoeSched S{F.MISC + 64, (const char*)(wsl + WS_ACT + A_HID), (const char*)(wsl + WS_WMOE + (size_t)16 * 1024 * 1024 * 2), nullptr, 1024, 1024, 8, F.G, F.vc, 0};
            EpiScatter E{(bf16*)(wsl + WS_O), (const int*)(wsl + WS_ACT + A_LISTD)};
            REP(1) gemm_stream<EpiScatter, MoeSched, false>(F.lds + RING_OFF, S, E);
            SEAM(pb + 12);
        }
    }
    if (IN(90)) { REP(3) pass_final(F, args.in[4], args.out); TICK(16); }
#if (defined(WSTAMP) && WSTAMP) || (defined(WST16) && WST16)
    if (blockIdx.x == 0 && threadIdx.x == 0) { const unsigned long long t0_ = __builtin_amdgcn_s_memrealtime(); while (__builtin_amdgcn_s_memrealtime() - t0_ < wacc_ * (unsigned long long)(WSTAMP_AMP)) __builtin_amdgcn_s_sleep(8); }
#endif
#if defined(STAMP) && STAMP
    if (blockIdx.x == 0 && threadIdx.x == 0) { const unsigned long long t0_ = __builtin_amdgcn_s_memrealtime(); while (__builtin_amdgcn_s_memrealtime() - t0_ < tacc * (unsigned long long)(STAMP_AMP)) __builtin_amdgcn_s_sleep(8); }
#endif
#undef IN
#undef SEAM
}
}
extern "C" void kernel_launch(void* const* d_in, const int* in_sizes, int n_in, void* d_out, int out_size, void* d_ws, size_t ws_size, hipStream_t stream) {
    using namespace fk;
    static int grid = 0;
    if (grid == 0) {
        int dev = 0, cus = 0;
        if (ws_size < WS_END || n_in != 54) { fprintf(stderr, "kernel_launch: bad sizes (ws %zu)\n", ws_size); grid = -1; return; }
        if (hipGetDevice(&dev) != hipSuccess || hipDeviceGetAttribute(&cus, hipDeviceAttributeMultiprocessorCount, dev) != hipSuccess) { grid = -1; return; }
        if (hipFuncSetAttribute((const void*)mega, hipFuncAttributeMaxDynamicSharedMemorySize, LDS_BYTES) != hipSuccess) { fprintf(stderr, "hipFuncSetAttribute failed\n"); grid = -1; return; }
        int per_cu = 0; (void)hipOccupancyMaxActiveBlocksPerMultiprocessor(&per_cu, (const void*)mega, NT, LDS_BYTES); (void)hipGetLastError();
        grid = cus;
    }
    if (grid < 0) return;
    unsigned char* ws = (unsigned char*)d_ws;
    (void)hipMemsetAsync(ws + WS_CTL, 0, CTL_ZERO_BYTES, stream);
    Args a{}; for (int i = 0; i < 54; ++i) a.in[i] = (const float*)d_in[i]; a.out = (float*)d_out; a.ws = ws; a.comb = 1;
    a.ph_lo = 0; a.ph_hi = 91; a.li = 0;
#if defined(PROBE) && PROBE
    a.rep_group = PROBE_GROUP; a.rep_n = PROBE_N;
#endif
    hipLaunchKernelGGL(mega, dim3(grid), dim3(NT), LDS_BYTES, stream, a);
}
```
